# Optimizing an MI355X kernel written in HIP

```python
import jax, jax.numpy as jnp
from jax import lax
import numpy as np

D_MODEL = 1024
BATCH = 8
SEQ = 2048
DEPTH = 2
DEC_BATCH = 128
DEC_SEQ = 1
PAST_LEN = 16384
PAGE_SIZE = 128

N_META = 16
N_MIXERS = 2
N_RET_LAYERS = (DEPTH + 1) // 2
N_CONV_LAYERS = DEPTH // 2
RET_HEADS = 4
RET_DK = D_MODEL // RET_HEADS
RET_DV = 2 * RET_DK
RET_VDIM = RET_HEADS * RET_DV
RET_IN = 2 * D_MODEL + 2 * RET_VDIM
RET_CHUNK = 128
ROPE_BASE = 10000.0
CONV_DIM = D_MODEL
CONV_WIDTH = 3
D_FF = 2816
FFN_CONV_WIDTH = 3
NORM_EPS = 1e-6
GN_EPS = 1e-6

kernel_name = "retnet_shortconv_convffn_decoder_step"


def rms_norm(x, g):
    xf = x.astype(jnp.float32)
    y = xf * lax.rsqrt(jnp.mean(xf * xf, axis=-1, keepdims=True) + NORM_EPS)
    return (y * g.astype(jnp.float32)).astype(x.dtype)


def rotary(x, pos):
    d = x.shape[-1]
    inv = 1.0 / (ROPE_BASE ** jnp.linspace(0.0, 1.0, d // 2, dtype=jnp.float32))
    ang = pos.astype(jnp.float32)[:, None] * inv[None, :]
    cos = jnp.cos(ang)[None, :, None, :]
    sin = jnp.sin(ang)[None, :, None, :]
    xf = x.astype(jnp.float32).reshape(x.shape[:-1] + (d // 2, 2))
    x1, x2 = xf[..., 0], xf[..., 1]
    out = jnp.stack([x1 * cos - x2 * sin, x1 * sin + x2 * cos], axis=-1)
    return out.reshape(x.shape).astype(x.dtype)


def retention_log_decay():
    return jnp.log(1.0 - 2.0 ** (-5.0 - jnp.arange(RET_HEADS, dtype=jnp.float32)))


def retention_chunk(q, k, v, s_prev, log_gamma):
    L = q.shape[2]
    n = jnp.arange(L, dtype=jnp.float32)
    diff = n[:, None] - n[None, :]
    causal = diff >= 0
    lg = log_gamma[:, None, None]
    decay_mask = jnp.where(causal[None], jnp.exp(lg * jnp.where(causal, diff, 0.0)[None]), 0.0)
    scores = jnp.einsum('bhnd,bhmd->bhnm', q, k) * decay_mask[None].astype(q.dtype)
    inner = jnp.einsum('bhnm,bhme->bhne', scores, v)
    cross_decay = jnp.exp(log_gamma[:, None] * (n[None, :] + 1.0))
    cross = jnp.einsum('bhnd,bhde->bhne', q, s_prev.astype(q.dtype)) * cross_decay[None, :, :, None].astype(q.dtype)
    k_decay = jnp.exp(log_gamma[:, None] * (L - 1.0 - n[None, :]))
    kv = jnp.einsum('bhmd,bhme->bhde', k * k_decay[None, :, :, None].astype(k.dtype), v)
    s_new = jnp.exp(log_gamma * L)[None, :, None, None] * s_prev + kv
    return inner + cross, s_new.astype(s_prev.dtype)


def retention_sequence(q, k, v, s0, lead):
    lg = retention_log_decay()
    B, H, T, _ = q.shape
    o_lead, s = retention_chunk(q[:, :, :lead], k[:, :, :lead], v[:, :, :lead], s0, lg)
    nc = (T - lead) // RET_CHUNK
    if nc == 0:
        return o_lead, s

    def blocks(t):
        return t[:, :, lead:].reshape(B, H, nc, RET_CHUNK, t.shape[-1]).transpose(2, 0, 1, 3, 4)

    def step(carry, blk):
        qc, kc, vc = blk
        o, carry = retention_chunk(qc, kc, vc, carry, lg)
        return carry, o

    s, o_rest = lax.scan(step, s, (blocks(q), blocks(k), blocks(v)))
    o_rest = o_rest.transpose(1, 2, 0, 3, 4).reshape(B, H, nc * RET_CHUNK, RET_DV)
    return jnp.concatenate([o_lead, o_rest], axis=2), s


def retention_mixer(h, pos, s0, w_in, w_out, lead):
    B, T, _ = h.shape
    proj = h @ w_in
    q, k, v, g = jnp.split(proj, [D_MODEL, 2 * D_MODEL, 2 * D_MODEL + RET_VDIM], axis=-1)
    q = rotary(q.reshape(B, T, RET_HEADS, RET_DK), pos)
    k = rotary(k.reshape(B, T, RET_HEADS, RET_DK), pos) * (RET_DK ** -0.5)
    v = v.reshape(B, T, RET_HEADS, RET_DV)
    q, k, v = (t.transpose(0, 2, 1, 3) for t in (q, k, v))
    o, s = retention_sequence(q, k, v, s0, lead)
    of = o.astype(jnp.float32)
    mu = jnp.mean(of, axis=-1, keepdims=True)
    var = jnp.mean(jnp.square(of - mu), axis=-1, keepdims=True)
    o = ((of - mu) * lax.rsqrt(var + GN_EPS)).astype(h.dtype)
    o = o.transpose(0, 2, 1, 3).reshape(B, T, RET_VDIM)
    return (jax.nn.silu(g) * o) @ w_out, s


def dwconv_valid(ext, w):
    W = w.shape[0]
    T = ext.shape[1] - W + 1
    acc = ext[:, 0:T] * w[0]
    for j in range(1, W):
        acc = acc + ext[:, j:j + T] * w[j]
    return acc


def shortconv_mixer(h, conv_state, w_in, conv_w, w_out):
    bg, cg, xin = jnp.split(h @ w_in, 3, axis=-1)
    u = cg * xin
    ext = jnp.concatenate([conv_state.astype(u.dtype), u], axis=1)
    y = dwconv_valid(ext, conv_w)
    return (bg * y) @ w_out, ext[:, -(CONV_WIDTH - 1):]


def conv_ffn(h, ffn_state, w_in, conv_w, conv_b, w_down):
    up, gate = jnp.split(h @ w_in, 2, axis=-1)
    ext = jnp.concatenate([ffn_state.astype(up.dtype), up], axis=1)
    a = dwconv_valid(ext, conv_w) + conv_b
    return (jax.nn.silu(a) * gate) @ w_down, ext[:, -(FFN_CONV_WIDTH - 1):]


def trunk(x, pos, lead, ret_states, conv_states, ffn_states, norm_mix, norm_ffn, norm_final,
          w_ret_in, w_ret_out, w_sc_in, w_sc_conv, w_sc_out, w_ffn_in, w_ffn_conv, b_ffn_conv, w_ffn_out):
    new_ret, new_conv, new_ffn = [], [], []
    for i in range(DEPTH):
        h = rms_norm(x, norm_mix[i])
        if i % N_MIXERS == 0:
            r = i // N_MIXERS
            m, s = retention_mixer(h, pos, ret_states[r], w_ret_in[r], w_ret_out[r], lead)
            new_ret.append(s)
        else:
            c = i // N_MIXERS
            m, s = shortconv_mixer(h, conv_states[c], w_sc_in[c], w_sc_conv[c], w_sc_out[c])
            new_conv.append(s)
        x = x + m
        h = rms_norm(x, norm_ffn[i])
        f, s = conv_ffn(h, ffn_states[i], w_ffn_in[i], w_ffn_conv[i], b_ffn_conv[i], w_ffn_out[i])
        new_ffn.append(s)
        x = x + f
    return rms_norm(x, norm_final), jnp.stack(new_ret), jnp.stack(new_conv), jnp.stack(new_ffn)


def setup_inputs(seed: int = 0) -> dict:
    key = jax.random.key(seed)
    ks = jax.random.split(key, 20)
    nrm = jax.random.normal
    f32 = jnp.float32
    return {
        "x_prompt": nrm(ks[0], (BATCH, SEQ, D_MODEL), f32),
        "x_sample": nrm(ks[1], (DEC_BATCH, DEC_SEQ, D_MODEL), f32),
        "state_ret": 0.05 * nrm(ks[2], (N_RET_LAYERS, DEC_BATCH, RET_HEADS, RET_DK, RET_DV), f32),
        "state_conv": nrm(ks[3], (N_CONV_LAYERS, DEC_BATCH, CONV_WIDTH - 1, CONV_DIM), f32),
        "state_ffn": nrm(ks[4], (DEPTH, DEC_BATCH, FFN_CONV_WIDTH - 1, D_FF), f32),
        "meta_tokens": nrm(ks[5], (N_META, D_MODEL), f32),
        "norm_mix": 1.0 + 0.05 * nrm(ks[6], (DEPTH, D_MODEL), f32),
        "norm_ffn": 1.0 + 0.05 * nrm(ks[7], (DEPTH, D_MODEL), f32),
        "norm_final": 1.0 + 0.05 * nrm(ks[8], (D_MODEL,), f32),
        "w_ret_in": nrm(ks[9], (N_RET_LAYERS, D_MODEL, RET_IN), f32) * D_MODEL ** -0.5,
        "w_ret_out": nrm(ks[10], (N_RET_LAYERS, RET_VDIM, D_MODEL), f32) * RET_VDIM ** -0.5,
        "w_sc_in": nrm(ks[11], (N_CONV_LAYERS, D_MODEL, 3 * CONV_DIM), f32) * D_MODEL ** -0.5,
        "w_sc_conv": nrm(ks[12], (N_CONV_LAYERS, CONV_WIDTH, CONV_DIM), f32) * CONV_WIDTH ** -0.5,
        "w_sc_out": nrm(ks[13], (N_CONV_LAYERS, CONV_DIM, D_MODEL), f32) * CONV_DIM ** -0.5,
        "w_ffn_in": nrm(ks[14], (DEPTH, D_MODEL, 2 * D_FF), f32) * D_MODEL ** -0.5,
        "w_ffn_conv": nrm(ks[15], (DEPTH, FFN_CONV_WIDTH, D_FF), f32) * FFN_CONV_WIDTH ** -0.5,
        "b_ffn_conv": 0.02 * nrm(ks[16], (DEPTH, D_FF), f32),
        "w_ffn_out": nrm(ks[17], (DEPTH, D_FF, D_MODEL), f32) * D_FF ** -0.5,
    }


def reference(x_prompt, x_sample, state_ret, state_conv, state_ffn, meta_tokens, norm_mix, norm_ffn,
              norm_final, w_ret_in, w_ret_out, w_sc_in, w_sc_conv, w_sc_out, w_ffn_in, w_ffn_conv,
              b_ffn_conv, w_ffn_out):
    weights = (norm_mix, norm_ffn, norm_final, w_ret_in, w_ret_out, w_sc_in, w_sc_conv, w_sc_out,
               w_ffn_in, w_ffn_conv, b_ffn_conv, w_ffn_out)
    B, S, _ = x_prompt.shape
    dt = x_prompt.dtype
    meta = jnp.broadcast_to(meta_tokens.astype(dt)[None], (B, N_META, D_MODEL))
    xp = jnp.concatenate([meta, x_prompt], axis=1)
    pos_p = jnp.arange(N_META + S, dtype=jnp.int32)
    zr = jnp.zeros((N_RET_LAYERS, B, RET_HEADS, RET_DK, RET_DV), dt)
    zc = jnp.zeros((N_CONV_LAYERS, B, CONV_WIDTH - 1, CONV_DIM), dt)
    zf = jnp.zeros((DEPTH, B, FFN_CONV_WIDTH - 1, D_FF), dt)
    yp, ret_p, conv_p, ffn_p = trunk(xp, pos_p, N_META, zr, zc, zf, *weights)
    y_prompt = yp[:, N_META:]
    Ts = x_sample.shape[1]
    pos_s = PAST_LEN + jnp.arange(Ts, dtype=jnp.int32)
    y_sample, ret_s, conv_s, ffn_s = trunk(x_sample, pos_s, Ts, state_ret, state_conv, state_ffn, *weights)
    return (y_prompt, y_sample, ret_p, ret_s, conv_p, conv_s, ffn_p, ffn_s)
```

```cpp
#include <hip/hip_runtime.h>
#include <hip/hip_cooperative_groups.h>
#include <cstdio>
#include <cstdint>
namespace cg = cooperative_groups;
__device__ __forceinline__ int launder_tid() { int t = (int)threadIdx.x; asm volatile("" : "+v"(t)); return t; }
#define TIDX launder_tid()

namespace pg8 {
#define PG8_LAS __attribute__((address_space(3)))
typedef unsigned short bf16_t;
typedef short bf16x8 __attribute__((ext_vector_type(8)));
typedef float f32x4 __attribute__((ext_vector_type(4)));
typedef unsigned u32x4 __attribute__((ext_vector_type(4)));
constexpr int BM = 256, BK = 64, HALF = 128, HTB = HALF * BK * 2  , STAGE_BYTES = 8 * HTB, NXCD = 8, WGM = 8;

__host__ __device__ __forceinline__ int lds_byte(int r, int c) { const int st = (r >> 4) * 2 + (c >> 5), rr = r & 15, cc = c & 31, ob = rr * 64 + cc * 2; return st * 1024 + (ob ^ (((ob >> 9) & 1) << 5)); }
__host__ __device__ __forceinline__ void stage_rc(int b, int& R, int& C) { const int st = b / 1024, sb = b % 1024, swz = sb ^ (((sb >> 9) & 1) << 5); R = (st >> 1) * 16 + swz / 64; C = (st & 1) * 32 + (swz % 64) / 2; }
__host__ __device__ __forceinline__ int perm32(int rho) { const int n = rho >> 4, i = rho & 15; return 8 * (i >> 2) + 4 * n + (i & 3); }

struct Unit { int pm, pn, idx; };
struct Gemm { const bf16_t* A; const bf16_t* Bt; int M, N, K; };

struct StaticOrder {
    int nM, nN, nwg, G, c;
    __host__ __device__ void init(int M, int N, int G_, int c_) { nM = M / BM; nN = N / BM; nwg = nM * nN; G = G_; c = c_; }
    __host__ __device__ bool next(int i, Unit& u) const {
        const long L = (long)i * G + c; if (L >= nwg) return false;
        int wgid = (int)L; { const int q = nwg / NXCD, r = nwg % NXCD, xcd = wgid % NXCD, off = wgid / NXCD; wgid = (xcd < r ? xcd * (q + 1) : r * (q + 1) + (xcd - r) * q) + off; }
        const int nig = WGM * nN, gid = wgid / nig, fm = gid * WGM, gsz = (nM - fm) < WGM ? (nM - fm) : WGM;
        u.pm = fm + ((wgid % nig) % gsz); u.pn = (wgid % nig) / gsz; u.idx = i; return true;
    }
    __host__ __device__ bool at(long L, Unit& u) const {
        if (L >= nwg) return false;
        int wgid = (int)L; { const int q = nwg / NXCD, r = nwg % NXCD, xcd = wgid % NXCD, off = wgid / NXCD; wgid = (xcd < r ? xcd * (q + 1) : r * (q + 1) + (xcd - r) * q) + off; }
        const int nig = WGM * nN, gid = wgid / nig, fm = gid * WGM, gsz = (nM - fm) < WGM ? (nM - fm) : WGM;
        u.pm = fm + ((wgid % nig) % gsz); u.pn = (wgid % nig) / gsz; return true;
    }
    __device__ __forceinline__ void a_ready(const Unit&) const {}
    __device__ __forceinline__ void done(const Unit&) const {}
};
__device__ __forceinline__ unsigned cvt_pk_bf16(float lo, float hi) { unsigned r; asm volatile("v_cvt_pk_bf16_f32 %0, %1, %2" : "=v"(r) : "v"(lo), "v"(hi)); return r; }

template <class Epi, class Sched, bool ALIGN_EPI = false, bool SP2 = false>
__device__ __forceinline__ void gemm_phase(PG8_LAS unsigned char* lds, const Gemm g, const Sched& S, const Epi& E) {
    const int tid = TIDX, wid = __builtin_amdgcn_readfirstlane(tid >> 6), lane = tid & 63, wr = wid >> 2, wc = wid & 3, fr = lane & 15, fq = lane >> 4;
    const int K = g.K, nt = K / BK;
    unsigned voffA[2], voffB[2];
#pragma unroll
    for (int i = 0; i < 2; ++i) { int R, C; stage_rc(tid * 16 + i * 8192, R, C); const int Rb = Epi::PERM ? ((R & ~31) + perm32(R & 31)) : R;
        voffA[i] = (unsigned)(R * K + C) * 2u; voffB[i] = (unsigned)(Rb * K + C) * 2u; }
    const size_t kstep = (size_t)(BK * 2);
    const size_t hstep = (size_t)HALF * K * 2;
    const size_t tstep = 2 * hstep;
    const unsigned ldsw = (unsigned)wid * 1024u;
    const int aoff = lds_byte(wr * 64 + fr, fq * 8), boff = lds_byte(wc * 32 + fr, fq * 8);
#define PG8_SA(b, h) (((b) * 2 + (h)) * HTB)
#define PG8_SB(b, h) ((4 + (b) * 2 + (h)) * HTB)
#define PG8_STAGE(bufoff, gbase, voff) do { _Pragma("unroll") for (int _i = 0; _i < 2; ++_i) \
        __builtin_amdgcn_global_load_lds((const unsigned*)((const char*)(gbase) + (voff)[_i]), (PG8_LAS unsigned*)(lds + (bufoff) + ldsw + _i * 8192), 16, 0, 0); } while (0)
#define PG8_LDA(dst, b, h) do { _Pragma("unroll") for (int m = 0; m < 4; ++m) _Pragma("unroll") for (int k = 0; k < 2; ++k) dst[m][k] = *(const PG8_LAS bf16x8*)(lds + PG8_SA(b, h) + aoff + m * 2048 + k * 1024); } while (0)
#define PG8_LDB(dst, b, h) do { _Pragma("unroll") for (int n = 0; n < 2; ++n) _Pragma("unroll") for (int k = 0; k < 2; ++k) dst[n][k] = *(const PG8_LAS bf16x8*)(lds + PG8_SB(b, h) + boff + n * 2048 + k * 1024); } while (0)
#define PG8_MMA(ai, bj, At, Bt) do { __builtin_amdgcn_s_setprio(1); _Pragma("unroll") for (int m = 0; m < 4; ++m) _Pragma("unroll") for (int n = 0; n < 2; ++n) _Pragma("unroll") for (int k = 0; k < 2; ++k) \
        acc[ai][bj][m][n] = __builtin_amdgcn_mfma_f32_16x16x32_bf16(Bt[n][k], At[m][k], acc[ai][bj][m][n], 0, 0, 0); __builtin_amdgcn_s_setprio(0); } while (0)
#define PG8_WAIT_V(n) asm volatile("s_waitcnt vmcnt(" #n ")" ::: "memory")
#define PG8_WAIT_L(n) asm volatile("s_waitcnt lgkmcnt(" #n ")" ::: "memory")
#define PG8_BAR __builtin_amdgcn_s_barrier()
#define PG8_SCHED __builtin_amdgcn_sched_barrier(0)
    Unit cur, nxt; int ui = 0;
    if (!S.next(0, cur)) return;
    f32x4 acc[2][2][4][2];
#pragma unroll
    for (int a = 0; a < 2; ++a)
#pragma unroll
        for (int b = 0; b < 2; ++b)
#pragma unroll
            for (int m = 0; m < 4; ++m)
#pragma unroll
                for (int n = 0; n < 2; ++n) acc[a][b][m][n] = (f32x4){0.f, 0.f, 0.f, 0.f};
    bf16x8 At[4][2], B0[2][2], B1[2][2];
    const char* cA = (const char*)g.A + (size_t)cur.pm * tstep; const char* cB = (const char*)g.Bt + (size_t)cur.pn * tstep;
    S.a_ready(cur);
    if constexpr (SP2) {
        PG8_STAGE(PG8_SB(0, 0), cB, voffB); PG8_STAGE(PG8_SB(0, 1), cB + hstep, voffB); PG8_STAGE(PG8_SA(0, 0), cA, voffA); PG8_STAGE(PG8_SA(0, 1), cA + hstep, voffA);
        if (wr == 1) PG8_BAR;
        PG8_WAIT_V(2); PG8_BAR;
        PG8_STAGE(PG8_SB(1, 0), cB + kstep, voffB); PG8_STAGE(PG8_SA(1, 0), cA + kstep, voffA); PG8_STAGE(PG8_SB(1, 1), cB + hstep + kstep, voffB);
        PG8_WAIT_V(6); PG8_BAR;
    } else {
        PG8_STAGE(PG8_SB(0, 0), cB, voffB); PG8_STAGE(PG8_SA(0, 0), cA, voffA); PG8_STAGE(PG8_SB(0, 1), cB + hstep, voffB); PG8_STAGE(PG8_SA(0, 1), cA + hstep, voffA);
        if (wr == 1) PG8_BAR;
        PG8_WAIT_V(4); PG8_BAR;
        PG8_STAGE(PG8_SB(1, 0), cB + kstep, voffB); PG8_STAGE(PG8_SA(1, 0), cA + kstep, voffA); PG8_STAGE(PG8_SB(1, 1), cB + hstep + kstep, voffB);
        PG8_WAIT_V(6); PG8_BAR;
    }
    for (;;) {
        const bool has_next = S.next(ui + 1, nxt);
        const char* nA = has_next ? (const char*)g.A + (size_t)nxt.pm * tstep : cA; const char* nB = has_next ? (const char*)g.Bt + (size_t)nxt.pn * tstep : cB;
        for (int t = 0; t < nt; t += 2) {
            const bool last = (t == nt - 2);
            const char* a1 = cA + (size_t)(t + 1) * kstep;
            const char* a2 = last ? nA : cA + (size_t)(t + 2) * kstep; const char* b2 = last ? nB : cB + (size_t)(t + 2) * kstep;
            const char* a3 = a2 + kstep; const char* b3 = b2 + kstep;
            if (last && has_next) S.a_ready(nxt);
            if constexpr (SP2) {
            PG8_LDB(B0, 0, 0); PG8_LDB(B1, 0, 1); PG8_SCHED; PG8_LDA(At, 0, 0); PG8_STAGE(PG8_SA(1, 1), a1 + hstep, voffA);
            PG8_WAIT_V(8); PG8_WAIT_L(0); PG8_BAR; PG8_MMA(0, 0, At, B0); PG8_MMA(0, 1, At, B1); PG8_BAR; PG8_SCHED;
            PG8_LDA(At, 0, 1); PG8_STAGE(PG8_SB(0, 0), b2, voffB); PG8_STAGE(PG8_SB(0, 1), b2 + hstep, voffB); PG8_STAGE(PG8_SA(0, 0), a2, voffA);
            PG8_WAIT_V(8); PG8_WAIT_L(0); PG8_BAR; PG8_MMA(1, 0, At, B0); PG8_MMA(1, 1, At, B1); PG8_BAR; PG8_SCHED;
            PG8_LDB(B0, 1, 0); PG8_LDB(B1, 1, 1); PG8_SCHED; PG8_LDA(At, 1, 0); PG8_STAGE(PG8_SA(0, 1), a2 + hstep, voffA);
            PG8_WAIT_V(8); PG8_WAIT_L(0); PG8_BAR; PG8_MMA(0, 0, At, B0); PG8_MMA(0, 1, At, B1); PG8_BAR; PG8_SCHED;
            PG8_LDA(At, 1, 1); PG8_STAGE(PG8_SB(1, 0), b3, voffB); PG8_STAGE(PG8_SB(1, 1), b3 + hstep, voffB); PG8_STAGE(PG8_SA(1, 0), a3, voffA);
            PG8_WAIT_V(8); PG8_WAIT_L(0); PG8_BAR; PG8_MMA(1, 0, At, B0); PG8_MMA(1, 1, At, B1); PG8_BAR; PG8_SCHED;
            } else {
            PG8_LDB(B0, 0, 0); PG8_SCHED; PG8_LDA(At, 0, 0); PG8_STAGE(PG8_SA(1, 1), a1 + hstep, voffA);
            PG8_WAIT_L(8); PG8_BAR; PG8_WAIT_L(0); PG8_MMA(0, 0, At, B0); PG8_BAR; PG8_SCHED;
            PG8_LDB(B1, 0, 1); PG8_STAGE(PG8_SB(0, 0), b2, voffB);
            PG8_BAR; PG8_WAIT_L(0); PG8_MMA(0, 1, At, B1); PG8_BAR;
            PG8_LDA(At, 0, 1); PG8_STAGE(PG8_SA(0, 0), a2, voffA);
            PG8_BAR; PG8_WAIT_L(0); PG8_MMA(1, 0, At, B0); PG8_BAR; PG8_SCHED;
            PG8_STAGE(PG8_SB(0, 1), b2 + hstep, voffB);
            PG8_WAIT_V(6); PG8_BAR; PG8_MMA(1, 1, At, B1); PG8_BAR;
            PG8_LDB(B0, 1, 0); PG8_SCHED; PG8_LDA(At, 1, 0); PG8_STAGE(PG8_SA(0, 1), a2 + hstep, voffA);
            PG8_WAIT_L(8); PG8_BAR; PG8_WAIT_L(0); PG8_MMA(0, 0, At, B0); PG8_BAR; PG8_SCHED;
            PG8_LDB(B1, 1, 1); PG8_STAGE(PG8_SB(1, 0), b3, voffB);
            PG8_BAR; PG8_WAIT_L(0); PG8_MMA(0, 1, At, B1); PG8_BAR;
            PG8_LDA(At, 1, 1); PG8_STAGE(PG8_SA(1, 0), a3, voffA);
            PG8_BAR; PG8_WAIT_L(0); PG8_MMA(1, 0, At, B0); PG8_BAR; PG8_SCHED;
            PG8_STAGE(PG8_SB(1, 1), b3 + hstep, voffB);
            PG8_WAIT_V(6); PG8_BAR; PG8_MMA(1, 1, At, B1); PG8_BAR;
            }
        }
        if constexpr (ALIGN_EPI) { if (wr == 0) PG8_BAR; }
        if constexpr (!Epi::AFTER_DRAIN) { E(acc, cur, wr, wc, fr, fq); S.done(cur); }
        if (!has_next) break;
#pragma unroll
        for (int a = 0; a < 2; ++a)
#pragma unroll
            for (int b = 0; b < 2; ++b)
#pragma unroll
                for (int m = 0; m < 4; ++m)
#pragma unroll
                    for (int n = 0; n < 2; ++n) acc[a][b][m][n] = (f32x4){0.f, 0.f, 0.f, 0.f};
        cur = nxt; cA = nA; cB = nB; ++ui;
        if constexpr (ALIGN_EPI) { if (wr == 1) PG8_BAR; }
    }
    PG8_WAIT_V(0);
    if constexpr (!ALIGN_EPI) { if (wr == 0) PG8_BAR; }
    PG8_BAR;
    if constexpr (Epi::AFTER_DRAIN) { E.fused(acc, cur, wr, wc, fr, fq, lds, wid, lane); S.done(cur); }
#undef PG8_SA
#undef PG8_SB
#undef PG8_STAGE
#undef PG8_LDA
#undef PG8_LDB
#undef PG8_MMA
#undef PG8_WAIT_V
#undef PG8_WAIT_L
#undef PG8_BAR
#undef PG8_SCHED
}
}

#define LAS __attribute__((address_space(3)))
typedef unsigned short bf16_t;
typedef short bf16x8 __attribute__((ext_vector_type(8)));
typedef short s16x4 __attribute__((ext_vector_type(4)));
typedef float f32x4 __attribute__((ext_vector_type(4)));
typedef float f32x2 __attribute__((ext_vector_type(2)));
typedef unsigned u32x4 __attribute__((ext_vector_type(4)));
typedef unsigned u32x2 __attribute__((ext_vector_type(2)));

constexpr int DM = 1024, MROWS = 16640, NPR = 16384, META0 = 16496, SAMP0 = 16512, DFF = 2816, RIN = 6144, VD = 2048;
constexpr int LDS_BYTES = 143360;
constexpr size_t OUT_YP = 0, OUT_YS = 16777216, OUT_RETP = 16908288, OUT_RETS = 21102592, OUT_CONVP = 88211456, OUT_CONVS = 88227840, OUT_FFNP = 88489984, OUT_FFNS = 88580096;
constexpr size_t WS_X = 0;
constexpr size_t WS_H = WS_X + (size_t)MROWS * DM * 4;
constexpr size_t WS_PROJ = WS_H + (size_t)MROWS * DM * 2;
constexpr size_t WS_O = WS_PROJ + (size_t)MROWS * RIN * 2;
constexpr size_t HALO_N = (size_t)260 * 2 * DFF;
constexpr size_t WS_Y = WS_O + (size_t)MROWS * VD * 2;
constexpr size_t WS_Y0 = WS_Y + (size_t)MROWS * DFF * 2;
constexpr size_t WS_STATS = WS_Y0 + (size_t)MROWS * VD * 2;
constexpr size_t WS_SS = WS_STATS + (size_t)MROWS * 32 * 8;
constexpr size_t WS_ROPE = WS_SS + (size_t)5 * MROWS * 16 * 4;
constexpr size_t WS_WRI = WS_ROPE + (size_t)2065 * 128 * 8;
constexpr size_t WS_WRO = WS_WRI + (size_t)RIN * DM * 2;
constexpr size_t WS_WSI = WS_WRO + (size_t)DM * VD * 2;
constexpr size_t WS_WSO = WS_WSI + (size_t)3072 * DM * 2;
constexpr size_t WS_WFI = WS_WSO + (size_t)DM * DM * 2;
constexpr size_t WS_WFO = WS_WFI + (size_t)2 * 2 * DFF * DM * 2;
constexpr size_t WS_BAR = WS_WFO + (size_t)2 * DM * DFF * 2;
constexpr size_t WS_END = WS_BAR + 16384;

struct Params {
    const float* in[18];
    float* out;
    unsigned char* ws;
    int ph_lo, ph_hi;
};
enum { I_XP = 0, I_XS, I_SRET, I_SCONV, I_SFFN, I_META, I_NMIX, I_NFFN, I_NFIN, I_WRI, I_WRO, I_WSI, I_WSC, I_WSO, I_WFI, I_WFC, I_BFC, I_WFO };

__device__ __forceinline__ float bflo(unsigned w) { return __uint_as_float(w << 16); }
__device__ __forceinline__ float bfhi(unsigned w) { return __uint_as_float(w & 0xffff0000u); }
__device__ __forceinline__ unsigned pk2(float lo, float hi) { unsigned r; asm("v_cvt_pk_bf16_f32 %0, %1, %2" : "=v"(r) : "v"(lo), "v"(hi)); return r; }
__device__ __forceinline__ float silu_f(float x) { return x * __builtin_amdgcn_rcpf(1.0f + __expf(-x)); }
__device__ __forceinline__ float wave_sum(float v) {
#pragma unroll
    for (int o = 1; o < 64; o <<= 1) v += __shfl_xor(v, o);
    return v;
}
__device__ __forceinline__ float rstd_of(const float* p16) {
    const f32x4 a = *(const f32x4*)p16, b = *(const f32x4*)(p16 + 4), c = *(const f32x4*)(p16 + 8), d = *(const f32x4*)(p16 + 12);
    const float ss = ((a.x + a.y) + (a.z + a.w)) + ((b.x + b.y) + (b.z + b.w)) + ((c.x + c.y) + (c.z + c.w)) + ((d.x + d.y) + (d.z + d.w));
    return 1.0f / sqrtf(ss * (1.0f / DM) + 1e-6f); }
__device__ __forceinline__ int pos_index(int row) { if (row < NPR) return 16 + (row & 2047); if (row < SAMP0) { const int j = row - META0; return j < 0 ? 0 : j; } return 2064; }
__device__ __forceinline__ void unpack8(const u32x4 w, float (&f)[8]) { f[0] = bflo(w.x); f[1] = bfhi(w.x); f[2] = bflo(w.y); f[3] = bfhi(w.y); f[4] = bflo(w.z); f[5] = bfhi(w.z); f[6] = bflo(w.w); f[7] = bfhi(w.w); }
__device__ __forceinline__ u32x4 pack8(const float (&f)[8]) { u32x4 w; w.x = pk2(f[0], f[1]); w.y = pk2(f[2], f[3]); w.z = pk2(f[4], f[5]); w.w = pk2(f[6], f[7]); return w; }
__device__ __forceinline__ void load8f(const float* p, float (&f)[8]) { const f32x4 a = *(const f32x4*)p, b = *(const f32x4*)(p + 4); f[0] = a.x; f[1] = a.y; f[2] = a.z; f[3] = a.w; f[4] = b.x; f[5] = b.y; f[6] = b.z; f[7] = b.w; }
__device__ __forceinline__ void store8f(float* p, const float (&f)[8]) { *(f32x4*)p = (f32x4){f[0], f[1], f[2], f[3]}; *(f32x4*)(p + 4) = (f32x4){f[4], f[5], f[6], f[7]}; }

#define XB_TMO      128
#define XB_XCNT(j)  (256  + 64 * (j))
#define XB_XSUB(j)  (1280 + 64 * (j))
#define XB_XGEN(j)  (2304 + 64 * (j))
#define XB_TOP      3328
#define XB_TOPGEN   3392
#define XCD_BAR_WORDS 3456
#define XB_SPIN_CAP (1u << 18)

__device__ __forceinline__ unsigned xb_ld(unsigned* p)              { return __hip_atomic_load(p, __ATOMIC_RELAXED, __HIP_MEMORY_SCOPE_AGENT); }
__device__ __forceinline__ unsigned xb_add(unsigned* p, unsigned v) { return __hip_atomic_fetch_add(p, v, __ATOMIC_RELAXED, __HIP_MEMORY_SCOPE_AGENT); }
__device__ __forceinline__ unsigned xb_xcc_id() { return (unsigned)__builtin_amdgcn_s_getreg((3 << 11) | 20) & 0xFu; }
#define XB_SPIN(cond, bar) do { unsigned _sp = 0; while (cond) { __builtin_amdgcn_s_sleep(1); \
    if ((++_sp & 255u) == 0u) { if (xb_ld(&(bar)[XB_TMO])) break; if (_sp > XB_SPIN_CAP) { atomicAdd(&(bar)[XB_TMO], 1u); break; } } } } while (0)

struct XcdBarrier {
    unsigned* bar; unsigned x;
    volatile LAS unsigned* st;
};

__device__ __forceinline__ XcdBarrier xcd_barrier_post(unsigned* bar, volatile LAS unsigned* st) {
    XcdBarrier b; b.bar = bar; b.x = xb_xcc_id(); b.st = st;
    if (TIDX == 0) (void)xb_add(&bar[XB_XCNT(b.x)], 1u);
    return b;
}
__device__ __forceinline__ void xcd_barrier_complete(unsigned* bar, unsigned x, unsigned& nloc, unsigned& nx) {
    const unsigned G = gridDim.x * gridDim.y * gridDim.z;
    unsigned sum, cnt, mine, sp = 0u;
    for (;;) {
        sum = 0u; cnt = 0u; mine = 0u;
#pragma unroll
        for (unsigned j = 0; j < 16; ++j) { const unsigned c = xb_ld(&bar[XB_XCNT(j)]); sum += c; cnt += (c > 0u) ? 1u : 0u; mine = (j == x) ? c : mine; }
        if (sum == G) break;
        __builtin_amdgcn_s_sleep(1);
        if ((++sp & 255u) == 0u) { if (xb_ld(&bar[XB_TMO])) break; if (sp > XB_SPIN_CAP) { atomicAdd(&bar[XB_TMO], 1u); break; } }
    }
    nloc = mine > 0u ? mine : 1u; nx = cnt > 0u ? cnt : 1u;
}

__device__ __forceinline__ void xcd_barrier(const XcdBarrier& b) {
    asm volatile("s_waitcnt vmcnt(0)" ::: "memory");
    __syncthreads();
    if (TIDX == 0) {
        unsigned* bar = b.bar;
        __builtin_amdgcn_s_waitcnt(0);
        unsigned nloc = b.st[0], nx = b.st[1];
        if (nloc == 0u) { xcd_barrier_complete(bar, b.x, nloc, nx); b.st[0] = nloc; b.st[1] = nx; }
        const unsigned old = xb_add(&bar[XB_XSUB(b.x)], 1u);
        const unsigned gen = old / nloc;
        if (old + 1u == (gen + 1u) * nloc) {
            __builtin_amdgcn_fence(__ATOMIC_RELEASE, "agent");
            asm volatile("s_waitcnt vmcnt(0)" ::: "memory");
            const unsigned og = xb_add(&bar[XB_TOP], 1u);
            const unsigned tg = og / nx;
            if (og + 1u == (tg + 1u) * nx) xb_add(&bar[XB_TOPGEN], 1u);
            else XB_SPIN(xb_ld(&bar[XB_TOPGEN]) == tg, bar);
            __builtin_amdgcn_fence(__ATOMIC_ACQUIRE, "agent");
            xb_add(&bar[XB_XGEN(b.x)], 1u);
            asm volatile("s_waitcnt vmcnt(0)" ::: "memory");
        } else {
            XB_SPIN(xb_ld(&bar[XB_XGEN(b.x)]) == gen, bar);
            __builtin_amdgcn_fence(__ATOMIC_ACQUIRE, "agent");
            asm volatile("s_waitcnt vmcnt(0)" ::: "memory");
        }
    }
    __syncthreads();
}

struct EpiRetIn {
    static constexpr bool PERM = true, AFTER_DRAIN = false;
    bf16_t* O; const float* rope; const float* rt;
    __device__ __forceinline__ void operator()(const f32x4 (&acc)[2][2][4][2], const pg8::Unit& u, int wr, int wc, int fr, int fq) const {
        const int row0 = u.pm * 256 + wr * 64 + fr, colt = u.pn * 256 + wc * 32 + 8 * fq;
        const int kind = u.pn < 4 ? 0 : (u.pn < 8 ? 1 : (u.pn < 16 ? 2 : 3));
        const float* rtu = rt + u.idx * 256 + wr * 64 + fr;
#pragma unroll
        for (int ai = 0; ai < 2; ++ai) {
            float rs[4];
#pragma unroll
            for (int m = 0; m < 4; ++m) rs[m] = rtu[ai * 128 + m * 16];
            if (kind <= 1) {
                f32x4 cs[4][2][2];
#pragma unroll
                for (int m = 0; m < 4; ++m) { const float* rp = rope + ((size_t)pos_index(row0 + ai * 128 + m * 16) * 128 + wc * 16 + 4 * fq) * 2;
#pragma unroll
                    for (int bj = 0; bj < 2; ++bj) { cs[m][bj][0] = *(const f32x4*)(rp + bj * 128); cs[m][bj][1] = *(const f32x4*)(rp + bj * 128 + 4); } }
#pragma unroll
                for (int m = 0; m < 4; ++m) {
                    bf16_t* rowp = O + (size_t)(row0 + ai * 128 + m * 16) * RIN + colt;
                    const float sc = kind == 1 ? 0.0625f * rs[m] : rs[m];
#pragma unroll
                    for (int bj = 0; bj < 2; ++bj) {
                        const f32x4 c0 = cs[m][bj][0], c1 = cs[m][bj][1];
                        const f32x4 v0 = acc[ai][bj][m][0] * sc, v1 = acc[ai][bj][m][1] * sc;
                        u32x4 w;
                        w.x = pk2(v0.x * c0.x - v0.y * c0.y, v0.x * c0.y + v0.y * c0.x);
                        w.y = pk2(v0.z * c0.z - v0.w * c0.w, v0.z * c0.w + v0.w * c0.z);
                        w.z = pk2(v1.x * c1.x - v1.y * c1.y, v1.x * c1.y + v1.y * c1.x);
                        w.w = pk2(v1.z * c1.z - v1.w * c1.w, v1.z * c1.w + v1.w * c1.z);
                        *(u32x4*)(rowp + bj * 128) = w;
                    }
                }
            } else {
#pragma unroll
                for (int m = 0; m < 4; ++m) {
                    bf16_t* rowp = O + (size_t)(row0 + ai * 128 + m * 16) * RIN + colt;
#pragma unroll
                    for (int bj = 0; bj < 2; ++bj) {
                        f32x4 v0 = acc[ai][bj][m][0] * rs[m], v1 = acc[ai][bj][m][1] * rs[m];
                        u32x4 w; w.x = pk2(v0.x, v0.y); w.y = pk2(v0.z, v0.w); w.z = pk2(v1.x, v1.y); w.w = pk2(v1.z, v1.w);
                        *(u32x4*)(rowp + bj * 128) = w;
                    }
                }
            }
        }
    }
};
struct EpiBf16 {
    static constexpr bool PERM = true, AFTER_DRAIN = false;
    bf16_t* O; int ldc; const float* rt;
    __device__ __forceinline__ void operator()(const f32x4 (&acc)[2][2][4][2], const pg8::Unit& u, int wr, int wc, int fr, int fq) const {
        const int row0 = u.pm * 256 + wr * 64 + fr, colt = u.pn * 256 + wc * 32 + 8 * fq;
#pragma unroll
        for (int ai = 0; ai < 2; ++ai)
#pragma unroll
            for (int m = 0; m < 4; ++m) {
                bf16_t* rowp = O + (size_t)(row0 + ai * 128 + m * 16) * ldc + colt;
                const float rs = rt[u.idx * 256 + ai * 128 + wr * 64 + m * 16 + fr];
#pragma unroll
                for (int bj = 0; bj < 2; ++bj) {
                    const f32x4 v0 = acc[ai][bj][m][0] * rs, v1 = acc[ai][bj][m][1] * rs;
                    u32x4 w; w.x = pk2(v0.x, v0.y); w.y = pk2(v0.z, v0.w); w.z = pk2(v1.x, v1.y); w.w = pk2(v1.z, v1.w);
                    *(u32x4*)(rowp + bj * 128) = w;
                }
            }
    }
};
struct EpiFfn {
    static constexpr bool PERM = true, AFTER_DRAIN = false;
    bf16_t* Y; const float* rt; float* halo; const float* cw; const float* cb; const float* sin_; float* outs;
    __device__ __forceinline__ void operator()(const f32x4 (&acc)[2][2][4][2], const pg8::Unit& u, int wr, int wc, int fr, int fq) const {
        const int src1 = (fq << 4) | ((fr + 15) & 15), src2 = (fq << 4) | ((fr + 14) & 15);
        const int chb = 128 * u.pn + 32 * wc + 8 * fq;
        const float* rtu = rt + u.idx * 256 + wr * 64 + fr;
        f32x4 cwv[2][4];
#pragma unroll
        for (int n = 0; n < 2; ++n) { const unsigned cho = (unsigned)(chb + 4 * n) * 4u;
            cwv[n][0] = *(const f32x4*)((const char*)cw + cho); cwv[n][1] = *(const f32x4*)((const char*)(cw + DFF) + cho); cwv[n][2] = *(const f32x4*)((const char*)(cw + 2 * DFF) + cho); cwv[n][3] = *(const f32x4*)((const char*)cb + cho); }
#pragma unroll
        for (int ai = 0; ai < 2; ++ai) {
            float rs[4];
#pragma unroll
            for (int m = 0; m < 4; ++m) rs[m] = rtu[ai * 128 + m * 16];
            const bool sample = (u.pm == 64) && (ai == 1);
            const int row0 = u.pm * 256 + ai * 128 + wr * 64 + fr, strip = (u.pm * 256 + ai * 128 + wr * 64) >> 6;
            if (!sample) {
                f32x4 q1[2], q2[2];
#pragma unroll
                for (int n = 0; n < 2; ++n) { q1[n] = (f32x4){0.f, 0.f, 0.f, 0.f}; q2[n] = q1[n]; }
#pragma unroll
                for (int m = 0; m < 4; ++m) {
                    u32x2 wv[2];
#pragma unroll
                    for (int n = 0; n < 2; ++n) {
                        const int ch = chb + 4 * n;
                        const f32x4 up = acc[ai][0][m][n] * rs[m];
                        f32x4 a1, a2, p1, p2;
#pragma unroll
                        for (int t = 0; t < 4; ++t) { a1[t] = __shfl(up[t], src1); a2[t] = __shfl(up[t], src2); p1[t] = fr >= 1 ? a1[t] : q1[n][t]; p2[t] = fr >= 2 ? a2[t] : q2[n][t]; }
                        q1[n] = a1; q2[n] = a2;
                        const f32x4 g = acc[ai][1][m][n] * rs[m];
                        const f32x4 a = cwv[n][0] * p2 + cwv[n][1] * p1 + cwv[n][2] * up + cwv[n][3];
                        wv[n].x = pk2(silu_f(a.x) * g.x, silu_f(a.y) * g.y); wv[n].y = pk2(silu_f(a.z) * g.z, silu_f(a.w) * g.w);
                        if (m == 0 && fr < 2) { const unsigned ho = (unsigned)((strip * 2 + fr) * DFF + ch) * 4u; *(f32x4*)((char*)halo + ho) = up; *(f32x4*)((char*)(halo + HALO_N) + ho) = g; }
                        if (m == 3 && fr >= 14) *(f32x4*)((char*)(halo + 2 * HALO_N) + (unsigned)((strip * 2 + (fr - 14)) * DFF + ch) * 4u) = up;
                    }
                    if (m > 0 || fr >= 2) *(u32x4*)((char*)Y + (unsigned)((row0 + m * 16) * DFF + chb) * 2u) = (u32x4){wv[0].x, wv[0].y, wv[1].x, wv[1].y};
                }
            } else {
#pragma unroll
                for (int m = 0; m < 4; ++m) {
                    const int b = wr * 64 + m * 16 + fr;
                    u32x2 wv[2];
#pragma unroll
                    for (int n = 0; n < 2; ++n) {
                        const int ch = chb + 4 * n;
                        const f32x4 upv = acc[ai][0][m][n] * rs[m], g = acc[ai][1][m][n] * rs[m];
                        const unsigned so = (unsigned)(b * 2 * DFF + ch) * 4u;
                        const f32x4 s0 = *(const f32x4*)((const char*)sin_ + so), s1 = *(const f32x4*)((const char*)(sin_ + DFF) + so);
                        const f32x4 a = cwv[n][0] * s0 + cwv[n][1] * s1 + cwv[n][2] * upv + cwv[n][3];
                        wv[n].x = pk2(silu_f(a.x) * g.x, silu_f(a.y) * g.y); wv[n].y = pk2(silu_f(a.z) * g.z, silu_f(a.w) * g.w);
                        *(f32x4*)((char*)outs + so) = s1; *(f32x4*)((char*)(outs + DFF) + so) = upv;
                    }
                    *(u32x4*)((char*)Y + (unsigned)((SAMP0 + b) * DFF + chb) * 2u) = (u32x4){wv[0].x, wv[0].y, wv[1].x, wv[1].y};
                }
            }
            asm volatile("" ::: "memory");
        }
    }
};
struct EpiSc {
    static constexpr bool PERM = true, AFTER_DRAIN = false;
    bf16_t* O; const float* rt;
    __device__ __forceinline__ void operator()(const f32x4 (&acc)[2][2][4][2], const pg8::Unit& u, int wr, int wc, int fr, int fq) const {
        const int row0 = u.pm * 256 + wr * 64 + fr;
        const float* rtu = rt + u.idx * 256 + wr * 64 + fr;
        if (u.pn < 4) {
            const int colt = u.pn * 256 + wc * 32 + 8 * fq;
#pragma unroll
            for (int ai = 0; ai < 2; ++ai)
#pragma unroll
                for (int m = 0; m < 4; ++m) {
                    bf16_t* rowp = O + (size_t)(row0 + ai * 128 + m * 16) * (2 * DM) + colt;
                    const float rs = rtu[ai * 128 + m * 16];
#pragma unroll
                    for (int bj = 0; bj < 2; ++bj) {
                        const f32x4 v0 = acc[ai][bj][m][0] * rs, v1 = acc[ai][bj][m][1] * rs;
                        u32x4 w; w.x = pk2(v0.x, v0.y); w.y = pk2(v0.z, v0.w); w.z = pk2(v1.x, v1.y); w.w = pk2(v1.z, v1.w);
                        *(u32x4*)(rowp + bj * 128) = w;
                    }
                }
        } else {
            const int ch0 = DM + 128 * (u.pn - 4) + wc * 32 + 8 * fq;
#pragma unroll
            for (int ai = 0; ai < 2; ++ai)
#pragma unroll
                for (int m = 0; m < 4; ++m) {
                    const float rs = rtu[ai * 128 + m * 16], r2 = rs * rs;
                    const f32x4 v0 = acc[ai][0][m][0] * acc[ai][1][m][0] * r2, v1 = acc[ai][0][m][1] * acc[ai][1][m][1] * r2;
                    u32x4 w; w.x = pk2(v0.x, v0.y); w.y = pk2(v0.z, v0.w); w.z = pk2(v1.x, v1.y); w.w = pk2(v1.z, v1.w);
                    *(u32x4*)(O + (size_t)(row0 + ai * 128 + m * 16) * (2 * DM) + ch0) = w;
                }
        }
    }
};
struct EpiResid {
    static constexpr bool PERM = true, AFTER_DRAIN = false;
    bf16_t* H; float* ssn;
    __device__ __forceinline__ void operator()(const f32x4 (&acc)[2][2][4][2], const pg8::Unit& u, int wr, int wc, int fr, int fq) const {
        const int row0 = u.pm * 256 + wr * 64 + fr, col0 = u.pn * 256 + wc * 32 + 8 * fq;
#pragma unroll
        for (int ai = 0; ai < 2; ++ai) {
            u32x4 xv[4][2];
#pragma unroll
            for (int m = 0; m < 4; ++m) { const bf16_t* rowp = H + (size_t)(row0 + ai * 128 + m * 16) * DM + col0;
#pragma unroll
                for (int bj = 0; bj < 2; ++bj) xv[m][bj] = *(const u32x4*)(rowp + bj * 128); }
#pragma unroll
            for (int m = 0; m < 4; ++m) {
                const int row = row0 + ai * 128 + m * 16;
                bf16_t* hp = H + (size_t)row * DM + col0;
                float sq = 0.f;
#pragma unroll
                for (int bj = 0; bj < 2; ++bj) { const u32x4 xw = xv[m][bj];
                    const f32x4 v0 = (f32x4){bflo(xw.x), bfhi(xw.x), bflo(xw.y), bfhi(xw.y)} + acc[ai][bj][m][0], v1 = (f32x4){bflo(xw.z), bfhi(xw.z), bflo(xw.w), bfhi(xw.w)} + acc[ai][bj][m][1];
                    sq += ((v0.x * v0.x + v0.y * v0.y) + (v0.z * v0.z + v0.w * v0.w)) + ((v1.x * v1.x + v1.y * v1.y) + (v1.z * v1.z + v1.w * v1.w));
                    u32x4 w; w.x = pk2(v0.x, v0.y); w.y = pk2(v0.z, v0.w); w.z = pk2(v1.x, v1.y); w.w = pk2(v1.z, v1.w); *(u32x4*)(hp + bj * 128) = w; }
                sq += __shfl_xor(sq, 16); sq += __shfl_xor(sq, 32);
                if (fq == 0) ssn[(size_t)row * 16 + u.pn * 4 + wc] = sq;
            }
            asm volatile("" ::: "memory");
        }
    }
};
__device__ __forceinline__ void ffnfix_strips(const Params& p, int layer, int s_lo, int s_hi) {
    bf16_t* Y = (bf16_t*)(p.ws + WS_Y); const float* HUF = (const float*)(p.ws + WS_O); const float* HGF = HUF + HALO_N; const float* HUL = HUF + 2 * HALO_N;
    const float* cw = p.in[I_WFC] + (size_t)layer * 3 * DFF; const float* cb = p.in[I_BFC] + (size_t)layer * DFF;
    constexpr int CG = DFF / 8;
    const int total = (s_hi - s_lo) * 2 * CG;
    for (int idx = TIDX; idx < total; idx += 512) {
        const int it = idx / CG, c = (idx - it * CG) * 8;
        const int s_ = s_lo + (it >> 1), i = it & 1, sp = (s_ < 256 && (s_ & 31) == 0) ? 257 : (s_ > 0 ? s_ - 1 : 0);
        float u0[8], u1[8], u2[8], gt[8], w0[8], w1[8], w2[8], bb[8], y[8];
        load8f(HUF + ((size_t)s_ * 2 + i) * DFF + c, u0); load8f(HGF + ((size_t)s_ * 2 + i) * DFF + c, gt);
        if (i == 0) { load8f(HUL + ((size_t)sp * 2 + 1) * DFF + c, u1); load8f(HUL + ((size_t)sp * 2 + 0) * DFF + c, u2); }
        else { load8f(HUF + ((size_t)s_ * 2 + 0) * DFF + c, u1); load8f(HUL + ((size_t)sp * 2 + 1) * DFF + c, u2); }
        load8f(cw + c, w0); load8f(cw + DFF + c, w1); load8f(cw + 2 * DFF + c, w2); load8f(cb + c, bb);
#pragma unroll
        for (int k = 0; k < 8; ++k) { const float a = w0[k] * u2[k] + w1[k] * u1[k] + w2[k] * u0[k] + bb[k]; y[k] = silu_f(a) * gt[k]; }
        *(u32x4*)(Y + (size_t)(64 * s_ + i) * DFF + c) = pack8(y);
    }
}
__device__ __forceinline__ void ffn_state_prompt(const Params& p, int layer, int b) {
    const float* HUL = (const float*)(p.ws + WS_O) + 2 * HALO_N; float* outp = p.out + OUT_FFNP + (size_t)layer * 8 * 2 * DFF;
    for (int idx = TIDX; idx < 2 * (DFF / 8); idx += 512) { const int i = idx / (DFF / 8), c = (idx - i * (DFF / 8)) * 8;
        float v[8]; load8f(HUL + ((size_t)(32 * b + 31) * 2 + i) * DFF + c, v); store8f(outp + ((size_t)b * 2 + i) * DFF + c, v); }
}
__device__ __forceinline__ void wg_arrive(unsigned* cnt) {
    asm volatile("s_waitcnt vmcnt(0)" ::: "memory");
    __syncthreads();
    if (TIDX == 0) { __builtin_amdgcn_fence(__ATOMIC_RELEASE, "agent"); asm volatile("s_waitcnt vmcnt(0)" ::: "memory"); (void)xb_add(cnt, 1u); }
}
__device__ __forceinline__ void poll_ge(unsigned* cnt, unsigned target) {
    unsigned sp = 0u;
    while ((unsigned)__builtin_amdgcn_readfirstlane(xb_ld(cnt)) < target) { __builtin_amdgcn_s_sleep(2); if (++sp > (1u << 16)) break; }
    __builtin_amdgcn_fence(__ATOMIC_ACQUIRE, "agent");
    asm volatile("s_waitcnt vmcnt(0)" ::: "memory");
}
__device__ __forceinline__ void wg_wait(unsigned* cnt, unsigned target) {
    if (TIDX < 64) poll_ge(cnt, target);
    __syncthreads();
}
struct OneUnit {
    int pm, pn;
    __device__ __forceinline__ bool next(int i, pg8::Unit& u) const { if (i != 0) return false; u.pm = pm; u.pn = pn; u.idx = 0; return true; }
    __device__ __forceinline__ void a_ready(const pg8::Unit&) const {}
    __device__ __forceinline__ void done(const pg8::Unit&) const {}
};
struct TailOrder {
    pg8::StaticOrder so; int nmain, nN, c; unsigned* cntB; float* rt; const float* ss;
    __device__ __forceinline__ void init(int N, int c_, unsigned* cntB_, float* rt_, const float* ss_) { so.init(NPR, N, 256, c_); nmain = so.nwg; nN = N / 256; c = c_; cntB = cntB_; rt = rt_; ss = ss_; }
    __device__ __forceinline__ bool next(int i, pg8::Unit& u) const {
        const int total = nmain + nN, jf = total >> 8, rem = total & 255;
        long L;
        if (c >= 252) { L = (long)(i + 2) * 256 + c; if (L >= total) return false; }
        else if (i < jf || (i == jf && c < rem)) L = (long)i * 256 + c;
        else if (i == jf && c < rem + 8) { const int hh = c - rem; L = (long)(hh >> 2) * 256 + 252 + (hh & 3); }
        else return false;
        if (L < nmain) so.at(L, u); else { u.pm = 64; u.pn = (int)(L - nmain); }
        u.idx = i; return true;
    }
    __device__ __forceinline__ void a_ready(const pg8::Unit& u) const {
        if (u.pm == 64) {
            if (TIDX < 64) poll_ge(cntB, 4u);
            asm volatile("" ::: "memory"); __builtin_amdgcn_s_barrier(); asm volatile("" ::: "memory");
            if (TIDX < 256) rt[u.idx * 256 + TIDX] = rstd_of(ss + (size_t)(64 * 256 + TIDX) * 16);
        }
    }
    __device__ __forceinline__ void done(const pg8::Unit&) const {}
};
__device__ __forceinline__ void run_resid_gemm(const Params& p, int fix_layer, LAS unsigned char* lds, const bf16_t* A, const bf16_t* Bt, int K, bf16_t* H, float* ssn, unsigned* cntA, unsigned* cntB) {
    EpiResid E{H, ssn};
    { pg8::Gemm g{A, Bt, NPR, DM, K}; pg8::StaticOrder S; S.init(NPR, DM, (int)gridDim.x, (int)blockIdx.x);
      if (fix_layer >= 0) { pg8::Unit u0; if (S.next(0, u0)) ffnfix_strips(p, fix_layer, 4 * u0.pm, 4 * u0.pm + 4); if ((int)blockIdx.x < 8) ffn_state_prompt(p, fix_layer, (int)blockIdx.x);
                            asm volatile("s_waitcnt vmcnt(0)" ::: "memory"); __syncthreads(); }
      pg8::gemm_phase<EpiResid, pg8::StaticOrder, false, true>(lds, g, S, E); }
    wg_arrive(cntA);
    if ((int)blockIdx.x >= 252) {
        if (fix_layer >= 0) { ffnfix_strips(p, fix_layer, 256, 258); asm volatile("s_waitcnt vmcnt(0)" ::: "memory"); __syncthreads(); }
        pg8::Gemm g{A, Bt, MROWS, DM, K}; OneUnit S1{64, (int)blockIdx.x - 252}; pg8::gemm_phase<EpiResid, OneUnit, false, true>(lds, g, S1, E);
        wg_arrive(cntB);
    }
    wg_wait(cntA, gridDim.x);
}
template <class Epi> __device__ __forceinline__ void run_gemm_tail(LAS unsigned char* lds, const float* ss, unsigned* cntB, const bf16_t* A, const bf16_t* Bt, int N, int K, const Epi& E) {
    float* rt = (float*)((unsigned char*)lds + pg8::STAGE_BYTES);
    pg8::Gemm g{A, Bt, MROWS, N, K}; TailOrder S; S.init(N, (int)blockIdx.x, cntB, rt, ss);
    for (int i = 0;; ++i) { pg8::Unit u; if (!S.next(i, u)) break;
        if (u.pm != 64 && TIDX < 256) rt[i * 256 + TIDX] = rstd_of(ss + (size_t)(u.pm * 256 + TIDX) * 16); }
    __syncthreads();
    pg8::gemm_phase<Epi, TailOrder, true, true>(lds, g, S, E);
}
__device__ __forceinline__ void build_rstd_table(float* rt, const pg8::StaticOrder& S, const float* ss) {
    for (int i = 0;; ++i) { pg8::Unit u; if (!S.next(i, u)) break;
        if (TIDX < 256) rt[i * 256 + TIDX] = rstd_of(ss + (size_t)(u.pm * 256 + TIDX) * 16); }
    __syncthreads();
}
template <class Epi> __device__ __forceinline__ void run_gemm(LAS unsigned char* lds, const float* ss, const bf16_t* A, const bf16_t* Bt, int N, int K, const Epi& E) {
    pg8::Gemm g{A, Bt, MROWS, N, K}; pg8::StaticOrder S; S.init(MROWS, N, (int)gridDim.x, (int)blockIdx.x);
    if (ss) build_rstd_table((float*)((unsigned char*)lds + pg8::STAGE_BYTES), S, ss);
    pg8::gemm_phase<Epi, pg8::StaticOrder, true, true>(lds, g, S, E);
}

template <bool FFN_INTERLEAVE = false, bool SC_INTERLEAVE = false> __device__ __forceinline__ void transpose_item(const float* W, const float* g, int K, int N, bf16_t* WT, float* scr, int item, int lane) {
    const int nblk = N / 32, kb = item / nblk, nb = item - kb * nblk, k0 = 64 * kb, n0 = 32 * nb;
    const int d0 = SC_INTERLEAVE ? (n0 < DM ? n0 : (n0 < 2 * DM ? DM + ((n0 - DM) >> 7) * 256 + ((n0 - DM) & 127) : DM + ((n0 - 2 * DM) >> 7) * 256 + 128 + ((n0 - 2 * DM) & 127))) : !FFN_INTERLEAVE ? n0 : (n0 < DFF ? (n0 >> 7) * 256 + (n0 & 127) : ((n0 - DFF) >> 7) * 256 + 128 + ((n0 - DFF) & 127));
#pragma unroll 8
    for (int i = 0; i < 32; ++i) { const int kk = 2 * i + (lane >> 5); const float gg = g ? g[k0 + kk] : 1.0f; scr[kk * 33 + (lane & 31)] = W[(size_t)(k0 + kk) * N + n0 + (lane & 31)] * gg; }
    asm volatile("s_waitcnt lgkmcnt(0)" ::: "memory");
    const int c = lane & 7;
#pragma unroll
    for (int j = 0; j < 4; ++j) { const int n = (lane >> 3) + 8 * j; const float* s = scr + (8 * c) * 33 + n;
        u32x4 o; o.x = pk2(s[0 * 33], s[1 * 33]); o.y = pk2(s[2 * 33], s[3 * 33]); o.z = pk2(s[4 * 33], s[5 * 33]); o.w = pk2(s[6 * 33], s[7 * 33]);
        *(u32x4*)(WT + (size_t)(d0 + n) * K + k0 + 8 * c) = o; }
    asm volatile("s_waitcnt lgkmcnt(0)" ::: "memory");
}
__device__ __forceinline__ void sincos_d(double r, float& c, float& s) {
    const double r2 = r * r;
    double sc = 1.0, ss = 1.0;
#pragma unroll
    for (int k = 14; k >= 1; --k) { sc = 1.0 - sc * r2 * (1.0 / (double)((2 * k - 1) * (2 * k))); ss = 1.0 - ss * r2 * (1.0 / (double)((2 * k) * (2 * k + 1))); }
    c = (float)sc; s = (float)(ss * r);
}
__device__ __forceinline__ void prep_rows(const Params& p) {
    bf16_t* H = (bf16_t*)(p.ws + WS_H); float* SS = (float*)(p.ws + WS_SS);
    const int lane = TIDX & 63, gw = blockIdx.x * 8 + (TIDX >> 6), NW = gridDim.x * 8;
    for (int row = gw; row < MROWS; row += NW) {
        f32x4 v[4];
        const float* src = row < NPR ? p.in[I_XP] + (size_t)row * DM : (row >= SAMP0 ? p.in[I_XS] + (size_t)(row - SAMP0) * DM : (row >= META0 ? p.in[I_META] + (size_t)(row - META0) * DM : nullptr));
#pragma unroll
        for (int j = 0; j < 4; ++j) v[j] = src ? *(const f32x4*)(src + lane * 4 + 256 * j) : (f32x4){0.f, 0.f, 0.f, 0.f};
        float ss = 0.f;
#pragma unroll
        for (int j = 0; j < 4; ++j) {
            u32x2 w; w.x = pk2(v[j].x, v[j].y); w.y = pk2(v[j].z, v[j].w); *(u32x2*)(H + (size_t)row * DM + lane * 4 + 256 * j) = w;
            ss += (v[j].x * v[j].x + v[j].y * v[j].y) + (v[j].z * v[j].z + v[j].w * v[j].w); }
        ss = wave_sum(ss);
        if (lane < 16) SS[(size_t)row * 16 + lane] = lane == 0 ? ss : 0.f;
    }
}
__device__ __forceinline__ void phase_final(const Params& p, unsigned* cntB) {
    const bf16_t* H = (const bf16_t*)(p.ws + WS_H); const float* SS = (const float*)(p.ws + WS_SS) + (size_t)4 * MROWS * 16; const float* g = p.in[I_NFIN];
    for (int idx = blockIdx.x * 512 + TIDX; idx < NPR * 128; idx += gridDim.x * 512) {
        const int row = idx >> 7, c = (idx & 127) * 8;
        const float rs = rstd_of(SS + (size_t)row * 16);
        float v[8], gv[8]; unpack8(*(const u32x4*)(H + (size_t)row * DM + c), v); load8f(g + c, gv);
#pragma unroll
        for (int k = 0; k < 8; ++k) v[k] = v[k] * rs * gv[k];
        store8f(p.out + OUT_YP + (size_t)row * DM + c, v);
    }
    wg_wait(cntB, 4u);
    for (int idx = blockIdx.x * 512 + TIDX; idx < 128 * 128; idx += gridDim.x * 512) {
        const int r = idx >> 7, c = (idx & 127) * 8, row = SAMP0 + r;
        const float rs = rstd_of(SS + (size_t)row * 16);
        float v[8], gv[8]; unpack8(*(const u32x4*)(H + (size_t)row * DM + c), v); load8f(g + c, gv);
#pragma unroll
        for (int k = 0; k < 8; ++k) v[k] = v[k] * rs * gv[k];
        store8f(p.out + OUT_YS + (size_t)r * DM + c, v);
    }
}
template <int SET> __device__ __forceinline__ void transpose_set(const Params& p, unsigned char* shm, int first) {
    const int lane = TIDX & 63, wave = TIDX >> 6;
    if ((int)blockIdx.x < first) return;
    const int gw = ((int)blockIdx.x - first) * 8 + wave, NW = ((int)gridDim.x - first) * 8;
    float* scr = (float*)(shm + wave * 8704);
    constexpr int I0 = 16 * 192, I1 = 32 * 32, I2 = 16 * 96, I3 = 16 * 32, I4 = 16 * 176, I5 = 44 * 32;
    constexpr int NIT = SET == 0 ? I0 : (SET == 1 ? I1 + I4 : (SET == 2 ? I5 + I2 + I3 : I4 + I5));
    for (int it = gw; it < NIT; it += NW) {
        int r = it;
        if (SET == 0) { transpose_item(p.in[I_WRI], p.in[I_NMIX], DM, RIN, (bf16_t*)(p.ws + WS_WRI), scr, r, lane); }
        else if (SET == 1) {
            if (r < I1) { transpose_item(p.in[I_WRO], nullptr, VD, DM, (bf16_t*)(p.ws + WS_WRO), scr, r, lane); continue; } r -= I1;
            transpose_item<true>(p.in[I_WFI], p.in[I_NFFN], DM, 2 * DFF, (bf16_t*)(p.ws + WS_WFI), scr, r, lane);
        } else if (SET == 2) {
            if (r < I5) { transpose_item(p.in[I_WFO], nullptr, DFF, DM, (bf16_t*)(p.ws + WS_WFO), scr, r, lane); continue; } r -= I5;
            if (r < I2) { transpose_item<false, true>(p.in[I_WSI], p.in[I_NMIX] + DM, DM, 3072, (bf16_t*)(p.ws + WS_WSI), scr, r, lane); continue; } r -= I2;
            transpose_item(p.in[I_WSO], nullptr, DM, DM, (bf16_t*)(p.ws + WS_WSO), scr, r, lane);
        } else {
            if (r < I4) { transpose_item<true>(p.in[I_WFI] + (size_t)DM * 2 * DFF, p.in[I_NFFN] + DM, DM, 2 * DFF, (bf16_t*)(p.ws + WS_WFI) + (size_t)2 * DFF * DM, scr, r, lane); continue; } r -= I4;
            transpose_item(p.in[I_WFO] + (size_t)DFF * DM, nullptr, DFF, DM, (bf16_t*)(p.ws + WS_WFO) + (size_t)DM * DFF, scr, r, lane);
        }
    }
}
__device__ __forceinline__ void phase_prep(const Params& p, unsigned char* shm) {
    transpose_set<0>(p, shm, 0);
    float* rope = (float*)(p.ws + WS_ROPE);
    for (int i = blockIdx.x * 512 + TIDX; i < 2065 * 128; i += gridDim.x * 512) {
        const int pi = i >> 7, fi = i & 127; const double pos = pi == 2064 ? 16384.0 : (double)pi;
        const double y = -(double)fi * 0.10462765653188542;
        const double nn = rint(y), f = (y - nn) * 0.6931471805599453;
        double e = 1.0;
#pragma unroll
        for (int k = 18; k >= 1; --k) e = 1.0 + e * f * (1.0 / (double)k);
        const double inv = e / (double)(1 << (int)(-nn));
        const double ang = pos * inv; const double kk = rint(ang * 0.15915494309189535); const double rr = ang - kk * 6.283185307179586;
        float c, s; sincos_d(rr, c, s);
        *(f32x2*)(rope + (size_t)i * 2) = (f32x2){c, s};
    }
    prep_rows(p);
}

#define TR_READ2(r0, r1, base, OFF0, OFF1) asm volatile("ds_read_b64_tr_b16 %0, %2 offset:%3\n\tds_read_b64_tr_b16 %1, %2 offset:%4" : "=&v"(r0), "=&v"(r1) : "v"(base), "i"(OFF0), "i"(OFF1) : "memory")
#define MFMA16(a, b, c) __builtin_amdgcn_mfma_f32_16x16x32_bf16((a), (b), (c), 0, 0, 0)
__device__ __forceinline__ bf16x8 cat4(s16x4 a, s16x4 b) { return __builtin_shufflevector(a, b, 0, 1, 2, 3, 4, 5, 6, 7); }

__device__ __forceinline__ void retention_prompt(const Params& p, unsigned char* shm, int item) {
    const int b = item >> 5, h = (item >> 3) & 3, dvb = item & 7;
    const int tid = TIDX, w = __builtin_amdgcn_readfirstlane(tid >> 6), lane = tid & 63, fr = lane & 15, fq = lane >> 4, tq = (lane & 15) >> 2, tp = lane & 3;
    const bf16_t* PROJ = (const bf16_t*)(p.ws + WS_PROJ); bf16_t* O = (bf16_t*)(p.ws + WS_O); f32x2* STATS = (f32x2*)(p.ws + WS_STATS);
    constexpr int KRS = 528, VRS = 144, OFF_V = 128 * KRS, OFF_VS = OFF_V + 128 * VRS, OFF_ST = OFF_VS + 128 * VRS;
    unsigned char* Kl = shm; unsigned char* Vl = shm + OFF_V; unsigned char* Vs = shm + OFF_VS; unsigned char* Stl = shm + OFF_ST;
    const unsigned lbase = (unsigned)(size_t)shm;
    const float lg2 = h == 0 ? -0.04580368961312479f : (h == 1 ? -0.02272007650008353f : (h == 2 ? -0.011315313227834146f : -0.005646563141142063f));
    const float g128 = __builtin_amdgcn_exp2f(lg2 * 128.0f);
    f32x4 sacc[2][4];
#pragma unroll
    for (int j = 0; j < 2; ++j)
#pragma unroll
        for (int eb = 0; eb < 4; ++eb) sacc[j][eb] = (f32x4){0.f, 0.f, 0.f, 0.f};
    const int nloc = 16 * w + fr;
    const unsigned trV_in = lbase + OFF_V + (4 * fq + tq) * VRS + 8 * tp, trV_up = lbase + OFF_VS + (8 * fq + tq) * VRS + 8 * tp, trK_up = lbase + (8 * fq + tq) * KRS + 64 * w + 8 * tp;
    const unsigned koff = (unsigned)((tid >> 5) * RIN + (tid & 31) * 8) * 2u, voff = (unsigned)((tid >> 3) * RIN + (tid & 7) * 8) * 2u, qoff = (unsigned)(nloc * RIN + fq * 8) * 2u;
    u32x4 kpre[8], vpre[2]; bf16x8 qf[8];
    {
        const char* base = (const char*)(PROJ + (size_t)NPR * RIN);
#pragma unroll
        for (int i = 0; i < 8; ++i) kpre[i] = *(const u32x4*)(base + (size_t)(1024 + h * 256 + i * 16 * RIN) * 2 + koff);
#pragma unroll
        for (int i = 0; i < 2; ++i) vpre[i] = *(const u32x4*)(base + (size_t)(2048 + h * 512 + dvb * 64 + i * 64 * RIN) * 2 + voff);
#pragma unroll
        for (int ks = 0; ks < 8; ++ks) qf[ks] = *(const bf16x8*)(base + (size_t)(h * 256 + ks * 32) * 2 + qoff);
    }
    for (int c = -1; c < 16; ++c) {
        float lg2c = lg2; asm volatile("" : "+v"(lg2c));
        const int rowbase = c < 0 ? NPR : b * 2048 + c * 128;
        const char* nbase = (const char*)(PROJ + (size_t)(b * 2048 + (c + 1) * 128) * RIN);
        __syncthreads();
#pragma unroll
        for (int i = 0; i < 8; ++i) { const int ch = tid + 512 * i, r = ch >> 5, cc = ch & 31; *(u32x4*)(Kl + r * KRS + cc * 16) = kpre[i]; }
#pragma unroll
        for (int i = 0; i < 2; ++i) { const int ch = tid + 512 * i, r = ch >> 3, cc = ch & 7;
            *(u32x4*)(Vl + r * VRS + cc * 16) = vpre[i];
            const float kd = __builtin_amdgcn_exp2f(lg2c * (float)(127 - r));
            float f[8]; unpack8(vpre[i], f);
#pragma unroll
            for (int k = 0; k < 8; ++k) f[k] *= kd;
            *(u32x4*)(Vs + r * VRS + cc * 16) = pack8(f); }
#pragma unroll
        for (int j = 0; j < 2; ++j)
#pragma unroll
            for (int eb = 0; eb < 4; ++eb) { u32x2 wv; wv.x = pk2(sacc[j][eb].x, sacc[j][eb].y); wv.y = pk2(sacc[j][eb].z, sacc[j][eb].w);
                *(u32x2*)(Stl + (16 * eb + fr) * KRS + (16 * (2 * w + j) + 4 * fq) * 2) = wv; }
        if (c < 15) {
#pragma unroll
            for (int i = 0; i < 8; ++i) kpre[i] = *(const u32x4*)(nbase + (size_t)(1024 + h * 256 + i * 16 * RIN) * 2 + koff);
#pragma unroll
            for (int i = 0; i < 2; ++i) vpre[i] = *(const u32x4*)(nbase + (size_t)(2048 + h * 512 + dvb * 64 + i * 64 * RIN) * 2 + voff);
        }
        __syncthreads();
        f32x4 oacc[4];
#pragma unroll
        for (int eb = 0; eb < 4; ++eb) {
            oacc[eb] = (f32x4){0.f, 0.f, 0.f, 0.f};
            if (c >= 0) {
#pragma unroll
            for (int ks = 0; ks < 8; ++ks) { const bf16x8 sf = *(const bf16x8*)(Stl + (16 * eb + fr) * KRS + (ks * 32 + fq * 8) * 2); oacc[eb] = MFMA16(sf, qf[ks], oacc[eb]); }
            }
        }
        const float cd = __builtin_amdgcn_exp2f(lg2c * (float)(nloc + 1));
#pragma unroll
        for (int eb = 0; eb < 4; ++eb) oacc[eb] = oacc[eb] * cd;
        __builtin_amdgcn_sched_barrier(0);
#pragma unroll
        for (int s = 0; s < 4; ++s) {
            if (2 * s <= w && (c >= 0 || s == 3)) {
                f32x4 p0 = (f32x4){0.f, 0.f, 0.f, 0.f}, p1 = (f32x4){0.f, 0.f, 0.f, 0.f};
#pragma unroll
                for (int ks = 0; ks < 8; ++ks) {
                    const bf16x8 k0 = *(const bf16x8*)(Kl + (32 * s + fr) * KRS + (ks * 32 + fq * 8) * 2), k1 = *(const bf16x8*)(Kl + (32 * s + 16 + fr) * KRS + (ks * 32 + fq * 8) * 2);
                    p0 = MFMA16(k0, qf[ks], p0); p1 = MFMA16(k1, qf[ks], p1);
                }
                float v[8];
#pragma unroll
                for (int t = 0; t < 4; ++t) { const int d0 = nloc - (32 * s + 4 * fq + t), d1 = d0 - 16;
                    v[t] = d0 >= 0 ? p0[t] * __builtin_amdgcn_exp2f(lg2c * (float)d0) : 0.f;
                    v[4 + t] = d1 >= 0 ? p1[t] * __builtin_amdgcn_exp2f(lg2c * (float)d1) : 0.f; }
                const u32x4 wv = pack8(v); const bf16x8 pf = __builtin_bit_cast(bf16x8, wv);
                s16x4 r[4][2];
#pragma unroll
                for (int eb = 0; eb < 4; ++eb) {
                    TR_READ2(r[eb][0], r[eb][1], trV_in, 32 * s * VRS + 32 * eb, (32 * s + 16) * VRS + 32 * eb);
                }
                asm volatile("s_waitcnt lgkmcnt(0)" : "+v"(r[0][0]), "+v"(r[0][1]), "+v"(r[1][0]), "+v"(r[1][1]), "+v"(r[2][0]), "+v"(r[2][1]), "+v"(r[3][0]), "+v"(r[3][1]) :: "memory");
#pragma unroll
                for (int eb = 0; eb < 4; ++eb) oacc[eb] = MFMA16(cat4(r[eb][0], r[eb][1]), pf, oacc[eb]);
            }
            __builtin_amdgcn_sched_barrier(0);
        }
        asm volatile("" ::: "memory");
        if (c < 15) {
#pragma unroll
            for (int ks = 0; ks < 8; ++ks) qf[ks] = *(const bf16x8*)(nbase + (size_t)(h * 256 + ks * 32) * 2 + qoff);
        }
        if (c >= 0 || b == 0) {
            float s1 = 0.f, s2 = 0.f;
#pragma unroll
            for (int eb = 0; eb < 4; ++eb) {
                const f32x4 o = oacc[eb];
                s1 += (o.x + o.y) + (o.z + o.w); s2 += (o.x * o.x + o.y * o.y) + (o.z * o.z + o.w * o.w);
                u32x2 wv; wv.x = pk2(o.x, o.y); wv.y = pk2(o.z, o.w);
                *(u32x2*)(O + (size_t)(rowbase + nloc) * VD + h * 512 + dvb * 64 + 16 * eb + 4 * fq) = wv;
            }
            s1 += __shfl_xor(s1, 16); s1 += __shfl_xor(s1, 32); s2 += __shfl_xor(s2, 16); s2 += __shfl_xor(s2, 32);
            if (fq == 0) STATS[((size_t)(rowbase + nloc) * 4 + h) * 8 + dvb] = (f32x2){s1, s2};
        }
#pragma unroll
        for (int j = 0; j < 2; ++j)
#pragma unroll
            for (int eb = 0; eb < 4; ++eb) sacc[j][eb] = sacc[j][eb] * g128;
        {
            s16x4 kr[2][2][2], vr[2][4][2];
#define UPD_ISSUE(bf, s_) do { _Pragma("unroll") for (int j = 0; j < 2; ++j) TR_READ2(kr[bf][j][0], kr[bf][j][1], trK_up, 32 * (s_) * KRS + 32 * j, (32 * (s_) + 4) * KRS + 32 * j); \
                               _Pragma("unroll") for (int eb = 0; eb < 4; ++eb) TR_READ2(vr[bf][eb][0], vr[bf][eb][1], trV_up, 32 * (s_) * VRS + 32 * eb, (32 * (s_) + 4) * VRS + 32 * eb); } while (0)
            UPD_ISSUE(0, 0);
#pragma unroll
            for (int s = 0; s < 4; ++s) {
                const int cb_ = s & 1;
                asm volatile("s_waitcnt lgkmcnt(0)" : "+v"(kr[cb_][0][0]), "+v"(kr[cb_][0][1]), "+v"(kr[cb_][1][0]), "+v"(kr[cb_][1][1]), "+v"(vr[cb_][0][0]), "+v"(vr[cb_][0][1]), "+v"(vr[cb_][1][0]), "+v"(vr[cb_][1][1]), "+v"(vr[cb_][2][0]), "+v"(vr[cb_][2][1]), "+v"(vr[cb_][3][0]), "+v"(vr[cb_][3][1]) :: "memory");
                if (s < 3) UPD_ISSUE(cb_ ^ 1, s + 1);
#pragma unroll
                for (int j = 0; j < 2; ++j)
#pragma unroll
                    for (int eb = 0; eb < 4; ++eb) sacc[j][eb] = MFMA16(cat4(kr[cb_][j][0], kr[cb_][j][1]), cat4(vr[cb_][eb][0], vr[cb_][eb][1]), sacc[j][eb]);
                __builtin_amdgcn_sched_barrier(0);
            }
#undef UPD_ISSUE
        }
    }
    float* RP = p.out + OUT_RETP + (size_t)(b * 4 + h) * 256 * 512;
#pragma unroll
    for (int j = 0; j < 2; ++j)
#pragma unroll
        for (int eb = 0; eb < 4; ++eb) {
            const int d0 = 16 * (2 * w + j) + 4 * fq, e = dvb * 64 + 16 * eb + fr;
            RP[(size_t)(d0 + 0) * 512 + e] = sacc[j][eb].x; RP[(size_t)(d0 + 1) * 512 + e] = sacc[j][eb].y; RP[(size_t)(d0 + 2) * 512 + e] = sacc[j][eb].z; RP[(size_t)(d0 + 3) * 512 + e] = sacc[j][eb].w;
        }
}
__device__ __forceinline__ void retention_sample(const Params& p, unsigned char* shm, int item) {
    const int b = item >> 2, h = item & 3, row = SAMP0 + b, tid = TIDX, lane = tid & 63, w = tid >> 6;
    const bf16_t* PROJ = (const bf16_t*)(p.ws + WS_PROJ); bf16_t* O = (bf16_t*)(p.ws + WS_O); f32x2* STATS = (f32x2*)(p.ws + WS_STATS);
    float* qs = (float*)shm; float* ks = qs + 256; float* red = ks + 256; float* opart = red + 32;
    const float gamma = 1.0f - (h == 0 ? 0.03125f : (h == 1 ? 0.015625f : (h == 2 ? 0.0078125f : 0.00390625f)));
    const bf16_t* prow = PROJ + (size_t)row * RIN;
    __syncthreads();
    if (tid < 256) {
        const float q = __uint_as_float((unsigned)prow[h * 256 + tid] << 16), k = __uint_as_float((unsigned)prow[1024 + h * 256 + tid] << 16);
        qs[tid] = q; ks[tid] = k;
        const float pr = wave_sum(q * k);
        if (lane == 0) red[w] = pr;
    }
    __syncthreads();
    const float qk = (red[0] + red[1]) + (red[2] + red[3]);
    const int e4 = (tid & 127) * 4, dsub = tid >> 7;
    const u32x2 vw = *(const u32x2*)(prow + 2048 + h * 512 + e4);
    const f32x4 v4 = (f32x4){bflo(vw.x), bfhi(vw.x), bflo(vw.y), bfhi(vw.y)};
    const float* Sp = p.in[I_SRET] + (size_t)(b * 4 + h) * 256 * 512 + e4;
    float* Sn = p.out + OUT_RETS + (size_t)(b * 4 + h) * 256 * 512 + e4;
    f32x4 oa = (f32x4){0.f, 0.f, 0.f, 0.f};
    f32x4 cur[16], nxt[16];
#pragma unroll
    for (int j = 0; j < 16; ++j) cur[j] = __builtin_nontemporal_load((const f32x4*)(Sp + (size_t)(dsub + 4 * j) * 512));
#pragma unroll
    for (int bt = 0; bt < 4; ++bt) {
        if (bt < 3) {
#pragma unroll
            for (int j = 0; j < 16; ++j) nxt[j] = __builtin_nontemporal_load((const f32x4*)(Sp + (size_t)(dsub + 4 * (16 * (bt + 1) + j)) * 512));
        }
#pragma unroll
        for (int j = 0; j < 16; ++j) {
            const int d = dsub + 4 * (16 * bt + j);
            const float qd = qs[d], kd = ks[d];
            oa = oa + cur[j] * qd;
            const f32x4 sn = cur[j] * gamma + v4 * kd;
            __builtin_nontemporal_store(sn, (f32x4*)(Sn + (size_t)d * 512));
        }
#pragma unroll
        for (int j = 0; j < 16; ++j) cur[j] = nxt[j];
    }
    *(f32x4*)(opart + dsub * 512 + e4) = oa;
    __syncthreads();
    const float ve = __uint_as_float((unsigned)prow[2048 + h * 512 + tid] << 16);
    const float o = gamma * ((opart[tid] + opart[512 + tid]) + (opart[1024 + tid] + opart[1536 + tid])) + qk * ve;
    O[(size_t)row * VD + h * 512 + tid] = (bf16_t)(pk2(o, 0.f) & 0xffffu);
    const float s1 = wave_sum(o), s2 = wave_sum(o * o);
    if (lane == 0) { red[8 + w] = s1; red[16 + w] = s2; }
    __syncthreads();
    if (tid < 8) {
        float a = 0.f, c = 0.f;
        if (tid == 0) {
#pragma unroll
            for (int i = 0; i < 8; ++i) { a += red[8 + i]; c += red[16 + i]; }
        }
        STATS[((size_t)row * 4 + h) * 8 + tid] = (f32x2){a, c};
    }
}
__device__ __forceinline__ void phase_retention(const Params& p, unsigned char* shm) {
    const bool stream_first = ((blockIdx.x >> 3) & 1) != 0;
    if (stream_first) { for (int item = blockIdx.x; item < 512; item += gridDim.x) retention_sample(p, shm, item); }
    __syncthreads();
    for (int item = blockIdx.x; item < 256; item += gridDim.x) retention_prompt(p, shm, item);
    __syncthreads();
    if (!stream_first) { for (int item = blockIdx.x; item < 512; item += gridDim.x) retention_sample(p, shm, item); }
}
__device__ __forceinline__ void phase_gatenorm(const Params& p) {
    const bf16_t* PROJ = (const bf16_t*)(p.ws + WS_PROJ); const bf16_t* O = (const bf16_t*)(p.ws + WS_O); const float* STATS = (const float*)(p.ws + WS_STATS); bf16_t* Y = (bf16_t*)(p.ws + WS_Y0);
    const int lane = TIDX & 63, gw = blockIdx.x * 8 + (TIDX >> 6), NW = gridDim.x * 8;
    for (int it0 = gw * 4; it0 < MROWS * 4; it0 += NW * 4) {
        u32x4 ow[4], gwv[4]; f32x4 sa[4], sb[4], sc[4], sd[4];
#pragma unroll
        for (int q = 0; q < 4; ++q) { const int it = it0 + q, row = it >> 2, h = it & 3; const float* st = STATS + (size_t)it * 16;
            sa[q] = *(const f32x4*)st; sb[q] = *(const f32x4*)(st + 4); sc[q] = *(const f32x4*)(st + 8); sd[q] = *(const f32x4*)(st + 12);
            ow[q] = *(const u32x4*)(O + (size_t)row * VD + h * 512 + lane * 8); gwv[q] = *(const u32x4*)(PROJ + (size_t)row * RIN + 4096 + h * 512 + lane * 8); }
#pragma unroll
        for (int q = 0; q < 4; ++q) { const int it = it0 + q, row = it >> 2, h = it & 3;
            const float s1 = (sa[q].x + sa[q].z) + (sb[q].x + sb[q].z) + (sc[q].x + sc[q].z) + (sd[q].x + sd[q].z), s2 = (sa[q].y + sa[q].w) + (sb[q].y + sb[q].w) + (sc[q].y + sc[q].w) + (sd[q].y + sd[q].w);
            const float mu = s1 * (1.0f / 512.0f); float var = s2 * (1.0f / 512.0f) - mu * mu; var = var > 0.f ? var : 0.f;
            const float rstd = 1.0f / sqrtf(var + 1e-6f);
            float of[8], gf[8], y[8]; unpack8(ow[q], of); unpack8(gwv[q], gf);
#pragma unroll
            for (int k = 0; k < 8; ++k) y[k] = silu_f(gf[k]) * ((of[k] - mu) * rstd);
            *(u32x4*)(Y + (size_t)row * VD + h * 512 + lane * 8) = pack8(y); }
    }
}
__device__ __forceinline__ void prev_rows(int row, int& p1, int& p2) {
    if (row < NPR) { const int t = row & 2047; p1 = t >= 1 ? row - 1 : SAMP0 - 1; p2 = t >= 2 ? row - 2 : (t == 1 ? SAMP0 - 1 : SAMP0 - 2); }
    else { p1 = row - 1; p2 = row - 2; }
}
__device__ __forceinline__ void seg_rows(int seg, int& r0, int& h1, int& h2) {
    if (seg < 2048) { r0 = seg * 8; if ((r0 & 2047) == 0) { h1 = SAMP0 - 1; h2 = SAMP0 - 2; } else { h1 = r0 - 1; h2 = r0 - 2; } }
    else { r0 = META0 + (seg - 2048) * 8; if (seg == 2048) { h1 = -1; h2 = -1; } else { h1 = r0 - 1; h2 = r0 - 2; } }
}
constexpr int NSEG = 2050;
__device__ __forceinline__ void phase_scconv(const Params& p) {
    const bf16_t* SC = (const bf16_t*)(p.ws + WS_PROJ); bf16_t* Y = (bf16_t*)(p.ws + WS_Y0);
    const float* cw = p.in[I_WSC]; const float* sin_ = p.in[I_SCONV];
    float* outp = p.out + OUT_CONVP; float* outs = p.out + OUT_CONVS;
    constexpr int CG = DM / 8, LD = 2 * DM;
    const int total = (NSEG + 128) * CG;
    for (int idx = blockIdx.x * 512 + TIDX; idx < total; idx += gridDim.x * 512) {
        const int seg = idx / CG, c = (idx - seg * CG) * 8;
        float w0[8], w1[8], w2[8], u1[8], u2[8];
        load8f(cw + c, w0); load8f(cw + DM + c, w1); load8f(cw + 2 * DM + c, w2);
        if (seg >= NSEG) {
            const int b = seg - NSEG, row = SAMP0 + b; float u0[8], bg[8], y[8];
            unpack8(*(const u32x4*)(SC + (size_t)row * LD + c), bg); unpack8(*(const u32x4*)(SC + (size_t)row * LD + DM + c), u0);
            load8f(sin_ + ((size_t)b * 2 + 1) * DM + c, u1); load8f(sin_ + ((size_t)b * 2 + 0) * DM + c, u2);
            store8f(outs + ((size_t)b * 2 + 0) * DM + c, u1); store8f(outs + ((size_t)b * 2 + 1) * DM + c, u0);
#pragma unroll
            for (int k = 0; k < 8; ++k) y[k] = bg[k] * (w0[k] * u2[k] + w1[k] * u1[k] + w2[k] * u0[k]);
            *(u32x4*)(Y + (size_t)row * DM + c) = pack8(y);
            continue;
        }
        int r0, h1, h2; seg_rows(seg, r0, h1, h2);
        u32x4 bw[8], uw[8];
#pragma unroll
        for (int i = 0; i < 8; ++i) { bw[i] = *(const u32x4*)(SC + (size_t)(r0 + i) * LD + c); uw[i] = *(const u32x4*)(SC + (size_t)(r0 + i) * LD + DM + c); }
        if (h1 >= 0) { unpack8(*(const u32x4*)(SC + (size_t)h1 * LD + DM + c), u1); unpack8(*(const u32x4*)(SC + (size_t)h2 * LD + DM + c), u2); }
        else {
#pragma unroll
            for (int k = 0; k < 8; ++k) { u1[k] = 0.f; u2[k] = 0.f; } }
#pragma unroll
        for (int i = 0; i < 8; ++i) {
            float u0[8], bg[8], y[8]; unpack8(bw[i], bg); unpack8(uw[i], u0);
#pragma unroll
            for (int k = 0; k < 8; ++k) { y[k] = bg[k] * (w0[k] * u2[k] + w1[k] * u1[k] + w2[k] * u0[k]); u2[k] = u1[k]; u1[k] = u0[k]; }
            *(u32x4*)(Y + (size_t)(r0 + i) * DM + c) = pack8(y);
            if (i >= 6 && seg < 2048 && (seg & 255) == 255) store8f(outp + ((size_t)(seg >> 8) * 2 + (i - 6)) * DM + c, u0);
        }
    }
}

constexpr int NPH = 15;
__global__ __launch_bounds__(512, 2) void fwd_megakernel(Params p) {
    extern __shared__ __attribute__((aligned(16))) unsigned char shm[];
    LAS unsigned char* lds = (LAS unsigned char*)shm;
    cg::grid_group grid = cg::this_grid();
    const bf16_t* H = (const bf16_t*)(p.ws + WS_H); const bf16_t* Y = (const bf16_t*)(p.ws + WS_Y);
    bf16_t* PROJ = (bf16_t*)(p.ws + WS_PROJ);
#define PH_BEGIN(k) if (p.ph_lo <= (k) && (k) < p.ph_hi) {
#define PH_END(k) if ((k) + 1 < p.ph_hi) xcd_barrier(xb); }
    float* SS = (float*)(p.ws + WS_SS); bf16_t* Hw = (bf16_t*)(p.ws + WS_H);
    volatile LAS unsigned* xst = (volatile LAS unsigned*)(lds + LDS_BYTES - 16);
    if (TIDX == 0) { xst[0] = 0u; xst[1] = 0u; }
    __syncthreads();
    const XcdBarrier xb = xcd_barrier_post((unsigned*)(p.ws + WS_BAR), xst);
    if (p.ph_hi < 0) grid.sync();
    unsigned* HC = (unsigned*)(p.ws + WS_BAR) + 3520;
    const bf16_t* Y0 = (const bf16_t*)(p.ws + WS_Y0);
#define PH_NOBAR(k) }
    PH_BEGIN(0) phase_prep(p, shm); PH_END(0)
    PH_BEGIN(1) { EpiRetIn E{PROJ, (const float*)(p.ws + WS_ROPE), (const float*)(shm + pg8::STAGE_BYTES)}; run_gemm(lds, SS, H, (const bf16_t*)(p.ws + WS_WRI), RIN, DM, E);
                  transpose_set<1>(p, shm, 24); transpose_set<2>(p, shm, 24); transpose_set<3>(p, shm, 24); } PH_END(1)
    PH_BEGIN(2) phase_retention(p, shm); PH_END(2)
    PH_BEGIN(3) phase_gatenorm(p); PH_END(3)
    PH_BEGIN(4) run_resid_gemm(p, -1, lds, Y0, (const bf16_t*)(p.ws + WS_WRO), VD, Hw, SS + (size_t)MROWS * 16, HC, HC + 64); PH_NOBAR(4)
    PH_BEGIN(5) { EpiFfn E{(bf16_t*)(p.ws + WS_Y), (const float*)(shm + pg8::STAGE_BYTES), (float*)(p.ws + WS_O), p.in[I_WFC], p.in[I_BFC], p.in[I_SFFN], p.out + OUT_FFNS}; run_gemm_tail(lds, SS + (size_t)MROWS * 16, HC + 64, H, (const bf16_t*)(p.ws + WS_WFI), 2 * DFF, DM, E); } PH_END(5)
    PH_BEGIN(7) run_resid_gemm(p, 0, lds, Y, (const bf16_t*)(p.ws + WS_WFO), DFF, Hw, SS + (size_t)2 * MROWS * 16, HC + 128, HC + 192); PH_NOBAR(7)
    PH_BEGIN(8) { EpiSc E{PROJ, (const float*)(shm + pg8::STAGE_BYTES)}; run_gemm_tail(lds, SS + (size_t)2 * MROWS * 16, HC + 192, H, (const bf16_t*)(p.ws + WS_WSI), 3 * DM, DM, E); } PH_END(8)
    PH_BEGIN(9) phase_scconv(p); PH_END(9)
    PH_BEGIN(10) run_resid_gemm(p, -1, lds, Y0, (const bf16_t*)(p.ws + WS_WSO), DM, Hw, SS + (size_t)3 * MROWS * 16, HC + 256, HC + 320); PH_NOBAR(10)
    PH_BEGIN(11) { EpiFfn E{(bf16_t*)(p.ws + WS_Y), (const float*)(shm + pg8::STAGE_BYTES), (float*)(p.ws + WS_O), p.in[I_WFC] + 3 * DFF, p.in[I_BFC] + DFF, p.in[I_SFFN] + (size_t)128 * 2 * DFF, p.out + OUT_FFNS + (size_t)128 * 2 * DFF}; run_gemm_tail(lds, SS + (size_t)3 * MROWS * 16, HC + 320, H, (const bf16_t*)(p.ws + WS_WFI) + (size_t)2 * DFF * DM, 2 * DFF, DM, E); } PH_END(11)
    PH_BEGIN(13) run_resid_gemm(p, 1, lds, Y, (const bf16_t*)(p.ws + WS_WFO) + (size_t)DM * DFF, DFF, Hw, SS + (size_t)4 * MROWS * 16, HC + 384, HC + 448); PH_NOBAR(13)
    PH_BEGIN(14) phase_final(p, HC + 448); PH_END(14)
}

extern "C" void kernel_launch(void* const* d_in, const int* in_sizes, int n_in, void* d_out, int out_size, void* d_ws, size_t ws_size, hipStream_t stream) {
    static int grid = 0;
    if (grid == 0) {
        if (n_in != 18 || ws_size < WS_END) { fprintf(stderr, "kernel_launch: unexpected n_in %d or ws_size %zu (< %zu)\n", n_in, ws_size, (size_t)WS_END); grid = -1; return; }
        int dev = 0, cus = 0, per_cu = 0;
        hipGetDevice(&dev); hipDeviceGetAttribute(&cus, hipDeviceAttributeMultiprocessorCount, dev);
        if (hipFuncSetAttribute((const void*)fwd_megakernel, hipFuncAttributeMaxDynamicSharedMemorySize, LDS_BYTES) != hipSuccess) fprintf(stderr, "kernel_launch: hipFuncSetAttribute failed\n");
        if (hipOccupancyMaxActiveBlocksPerMultiprocessor(&per_cu, (const void*)fwd_megakernel, 512, LDS_BYTES) != hipSuccess || per_cu < 1) { fprintf(stderr, "kernel_launch: occupancy query gave %d\n", per_cu); per_cu = 1; }
        (void)hipGetLastError();
        if (cus != 256) fprintf(stderr, "kernel_launch: note: %d CUs reported; the phase schedule is built for 256 workgroups (one per CU)\n", cus);
        grid = 256;
    }
    if (grid < 0) return;
    if (hipMemsetAsync((char*)d_ws + WS_BAR, 0, 16384, stream) != hipSuccess) fprintf(stderr, "kernel_launch: memset of barrier words failed\n");
    Params p{};
    for (int i = 0; i < 18; ++i) p.in[i] = (const float*)d_in[i];
    p.out = (float*)d_out; p.ws = (unsigned char*)d_ws; p.ph_lo = 0; p.ph_hi = NPH;
#if defined(MK_MULTI)
    for (int ph = 0; ph < NPH; ++ph) { p.ph_lo = ph; p.ph_hi = ph + 1; hipLaunchKernelGGL(fwd_megakernel, dim3(grid), dim3(512), LDS_BYTES, stream, p); }
#else
    void* args[] = {&p};
    hipError_t e = hipLaunchCooperativeKernel((const void*)fwd_megakernel, dim3(grid), dim3(512), args, LDS_BYTES, stream);
    if (e != hipSuccess) fprintf(stderr, "cooperative launch failed: %s (grid %d)\n", hipGetErrorString(e), grid);
#endif
}
```

```cpp
#include <hip/hip_runtime.h>
#include <hip/hip_cooperative_groups.h>
#include <cstdio>
#include <cstdint>
namespace cg = cooperative_groups;
__device__ __forceinline__ int launder_tid() { int t = (int)threadIdx.x; asm volatile("" : "+v"(t)); return t; }
#define TIDX launder_tid()

namespace pg8 {
#define PG8_LAS __attribute__((address_space(3)))
typedef unsigned short bf16_t;
typedef short bf16x8 __attribute__((ext_vector_type(8)));
typedef float f32x4 __attribute__((ext_vector_type(4)));
typedef unsigned u32x4 __attribute__((ext_vector_type(4)));
constexpr int BM = 256, BK = 64, HALF = 128, HTB = HALF * BK * 2  , STAGE_BYTES = 8 * HTB, NXCD = 8, WGM = 8;

__host__ __device__ __forceinline__ int lds_byte(int r, int c) { const int st = (r >> 4) * 2 + (c >> 5), rr = r & 15, cc = c & 31, ob = rr * 64 + cc * 2; return st * 1024 + (ob ^ (((ob >> 9) & 1) << 5)); }
__host__ __device__ __forceinline__ void stage_rc(int b, int& R, int& C) { const int st = b / 1024, sb = b % 1024, swz = sb ^ (((sb >> 9) & 1) << 5); R = (st >> 1) * 16 + swz / 64; C = (st & 1) * 32 + (swz % 64) / 2; }
__host__ __device__ __forceinline__ int perm32(int rho) { const int n = rho >> 4, i = rho & 15; return 8 * (i >> 2) + 4 * n + (i & 3); }

struct Unit { int pm, pn, idx; };
struct Gemm { const bf16_t* A; const bf16_t* Bt; int M, N, K; };

struct StaticOrder {
    int nM, nN, nwg, G, c;
    __host__ __device__ void init(int M, int N, int G_, int c_) { nM = M / BM; nN = N / BM; nwg = nM * nN; G = G_; c = c_; }
    __host__ __device__ bool next(int i, Unit& u) const {
        const long L = (long)i * G + c; if (L >= nwg) return false;
        int wgid = (int)L; { const int q = nwg / NXCD, r = nwg % NXCD, xcd = wgid % NXCD, off = wgid / NXCD; wgid = (xcd < r ? xcd * (q + 1) : r * (q + 1) + (xcd - r) * q) + off; }
        const int nig = WGM * nN, gid = wgid / nig, fm = gid * WGM, gsz = (nM - fm) < WGM ? (nM - fm) : WGM;
        u.pm = fm + ((wgid % nig) % gsz); u.pn = (wgid % nig) / gsz; u.idx = i; return true;
    }
    __host__ __device__ bool at(long L, Unit& u) const {
        if (L >= nwg) return false;
        int wgid = (int)L; { const int q = nwg / NXCD, r = nwg % NXCD, xcd = wgid % NXCD, off = wgid / NXCD; wgid = (xcd < r ? xcd * (q + 1) : r * (q + 1) + (xcd - r) * q) + off; }
        const int nig = WGM * nN, gid = wgid / nig, fm = gid * WGM, gsz = (nM - fm) < WGM ? (nM - fm) : WGM;
        u.pm = fm + ((wgid % nig) % gsz); u.pn = (wgid % nig) / gsz; return true;
    }
    __device__ __forceinline__ void a_ready(const Unit&) const {}
    __device__ __forceinline__ void done(const Unit&) const {}
};
__device__ __forceinline__ unsigned cvt_pk_bf16(float lo, float hi) { unsigned r; asm volatile("v_cvt_pk_bf16_f32 %0, %1, %2" : "=v"(r) : "v"(lo), "v"(hi)); return r; }

template <class Epi, class Sched, bool ALIGN_EPI = false, bool SP2 = false>
__device__ __forceinline__ void gemm_phase(PG8_LAS unsigned char* lds, const Gemm g, const Sched& S, const Epi& E) {
    const int tid = TIDX, wid = __builtin_amdgcn_readfirstlane(tid >> 6), lane = tid & 63, wr = wid >> 2, wc = wid & 3, fr = lane & 15, fq = lane >> 4;
    const int K = g.K, nt = K / BK;
    unsigned voffA[2], voffB[2];
#pragma unroll
    for (int i = 0; i < 2; ++i) { int R, C; stage_rc(tid * 16 + i * 8192, R, C); const int Rb = Epi::PERM ? ((R & ~31) + perm32(R & 31)) : R;
        voffA[i] = (unsigned)(R * K + C) * 2u; voffB[i] = (unsigned)(Rb * K + C) * 2u; }
    const size_t kstep = (size_t)(BK * 2);
    const size_t hstep = (size_t)HALF * K * 2;
    const size_t tstep = 2 * hstep;
    const unsigned ldsw = (unsigned)wid * 1024u;
    const int aoff = lds_byte(wr * 64 + fr, fq * 8), boff = lds_byte(wc * 32 + fr, fq * 8);
#define PG8_SA(b, h) (((b) * 2 + (h)) * HTB)
#define PG8_SB(b, h) ((4 + (b) * 2 + (h)) * HTB)
#define PG8_STAGE(bufoff, gbase, voff) do { _Pragma("unroll") for (int _i = 0; _i < 2; ++_i) \
        __builtin_amdgcn_global_load_lds((const unsigned*)((const char*)(gbase) + (voff)[_i]), (PG8_LAS unsigned*)(lds + (bufoff) + ldsw + _i * 8192), 16, 0, 0); } while (0)
#define PG8_LDA(dst, b, h) do { _Pragma("unroll") for (int m = 0; m < 4; ++m) _Pragma("unroll") for (int k = 0; k < 2; ++k) dst[m][k] = *(const PG8_LAS bf16x8*)(lds + PG8_SA(b, h) + aoff + m * 2048 + k * 1024); } while (0)
#define PG8_LDB(dst, b, h) do { _Pragma("unroll") for (int n = 0; n < 2; ++n) _Pragma("unroll") for (int k = 0; k < 2; ++k) dst[n][k] = *(const PG8_LAS bf16x8*)(lds + PG8_SB(b, h) + boff + n * 2048 + k * 1024); } while (0)
#define PG8_MMA(ai, bj, At, Bt) do { __builtin_amdgcn_s_setprio(1); _Pragma("unroll") for (int m = 0; m < 4; ++m) _Pragma("unroll") for (int n = 0; n < 2; ++n) _Pragma("unroll") for (int k = 0; k < 2; ++k) \
        acc[ai][bj][m][n] = __builtin_amdgcn_mfma_f32_16x16x32_bf16(Bt[n][k], At[m][k], acc[ai][bj][m][n], 0, 0, 0); __builtin_amdgcn_s_setprio(0); } while (0)
#define PG8_WAIT_V(n) asm volatile("s_waitcnt vmcnt(" #n ")" ::: "memory")
#define PG8_WAIT_L(n) asm volatile("s_waitcnt lgkmcnt(" #n ")" ::: "memory")
#define PG8_BAR __builtin_amdgcn_s_barrier()
#define PG8_SCHED __builtin_amdgcn_sched_barrier(0)
    Unit cur, nxt; int ui = 0;
    if (!S.next(0, cur)) return;
    f32x4 acc[2][2][4][2];
#pragma unroll
    for (int a = 0; a < 2; ++a)
#pragma unroll
        for (int b = 0; b < 2; ++b)
#pragma unroll
            for (int m = 0; m < 4; ++m)
#pragma unroll
                for (int n = 0; n < 2; ++n) acc[a][b][m][n] = (f32x4){0.f, 0.f, 0.f, 0.f};
    bf16x8 At[4][2], B0[2][2], B1[2][2];
    const char* cA = (const char*)g.A + (size_t)cur.pm * tstep; const char* cB = (const char*)g.Bt + (size_t)cur.pn * tstep;
    S.a_ready(cur);
    if constexpr (SP2) {
        PG8_STAGE(PG8_SB(0, 0), cB, voffB); PG8_STAGE(PG8_SB(0, 1), cB + hstep, voffB); PG8_STAGE(PG8_SA(0, 0), cA, voffA); PG8_STAGE(PG8_SA(0, 1), cA + hstep, voffA);
        if (wr == 1) PG8_BAR;
        PG8_WAIT_V(2); PG8_BAR;
        PG8_STAGE(PG8_SB(1, 0), cB + kstep, voffB); PG8_STAGE(PG8_SA(1, 0), cA + kstep, voffA); PG8_STAGE(PG8_SB(1, 1), cB + hstep + kstep, voffB);
        PG8_WAIT_V(6); PG8_BAR;
    } else {
        PG8_STAGE(PG8_SB(0, 0), cB, voffB); PG8_STAGE(PG8_SA(0, 0), cA, voffA); PG8_STAGE(PG8_SB(0, 1), cB + hstep, voffB); PG8_STAGE(PG8_SA(0, 1), cA + hstep, voffA);
        if (wr == 1) PG8_BAR;
        PG8_WAIT_V(4); PG8_BAR;
        PG8_STAGE(PG8_SB(1, 0), cB + kstep, voffB); PG8_STAGE(PG8_SA(1, 0), cA + kstep, voffA); PG8_STAGE(PG8_SB(1, 1), cB + hstep + kstep, voffB);
        PG8_WAIT_V(6); PG8_BAR;
    }
    for (;;) {
        const bool has_next = S.next(ui + 1, nxt);
        const char* nA = has_next ? (const char*)g.A + (size_t)nxt.pm * tstep : cA; const char* nB = has_next ? (const char*)g.Bt + (size_t)nxt.pn * tstep : cB;
        for (int t = 0; t < nt; t += 2) {
            const bool last = (t == nt - 2);
            const char* a1 = cA + (size_t)(t + 1) * kstep;
            const char* a2 = last ? nA : cA + (size_t)(t + 2) * kstep; const char* b2 = last ? nB : cB + (size_t)(t + 2) * kstep;
            const char* a3 = a2 + kstep; const char* b3 = b2 + kstep;
            if (last && has_next) S.a_ready(nxt);
            if constexpr (SP2) {
            PG8_LDB(B0, 0, 0); PG8_LDB(B1, 0, 1); PG8_SCHED; PG8_LDA(At, 0, 0); PG8_STAGE(PG8_SA(1, 1), a1 + hstep, voffA);
            PG8_WAIT_V(8); PG8_WAIT_L(0); PG8_BAR; PG8_MMA(0, 0, At, B0); PG8_MMA(0, 1, At, B1); PG8_BAR; PG8_SCHED;
            PG8_LDA(At, 0, 1); PG8_STAGE(PG8_SB(0, 0), b2, voffB); PG8_STAGE(PG8_SB(0, 1), b2 + hstep, voffB); PG8_STAGE(PG8_SA(0, 0), a2, voffA);
            PG8_WAIT_V(8); PG8_WAIT_L(0); PG8_BAR; PG8_MMA(1, 0, At, B0); PG8_MMA(1, 1, At, B1); PG8_BAR; PG8_SCHED;
            PG8_LDB(B0, 1, 0); PG8_LDB(B1, 1, 1); PG8_SCHED; PG8_LDA(At, 1, 0); PG8_STAGE(PG8_SA(0, 1), a2 + hstep, voffA);
            PG8_WAIT_V(8); PG8_WAIT_L(0); PG8_BAR; PG8_MMA(0, 0, At, B0); PG8_MMA(0, 1, At, B1); PG8_BAR; PG8_SCHED;
            PG8_LDA(At, 1, 1); PG8_STAGE(PG8_SB(1, 0), b3, voffB); PG8_STAGE(PG8_SB(1, 1), b3 + hstep, voffB); PG8_STAGE(PG8_SA(1, 0), a3, voffA);
            PG8_WAIT_V(8); PG8_WAIT_L(0); PG8_BAR; PG8_MMA(1, 0, At, B0); PG8_MMA(1, 1, At, B1); PG8_BAR; PG8_SCHED;
            } else {
            PG8_LDB(B0, 0, 0); PG8_SCHED; PG8_LDA(At, 0, 0); PG8_STAGE(PG8_SA(1, 1), a1 + hstep, voffA);
            PG8_WAIT_L(8); PG8_BAR; PG8_WAIT_L(0); PG8_MMA(0, 0, At, B0); PG8_BAR; PG8_SCHED;
            PG8_LDB(B1, 0, 1); PG8_STAGE(PG8_SB(0, 0), b2, voffB);
            PG8_BAR; PG8_WAIT_L(0); PG8_MMA(0, 1, At, B1); PG8_BAR;
            PG8_LDA(At, 0, 1); PG8_STAGE(PG8_SA(0, 0), a2, voffA);
            PG8_BAR; PG8_WAIT_L(0); PG8_MMA(1, 0, At, B0); PG8_BAR; PG8_SCHED;
            PG8_STAGE(PG8_SB(0, 1), b2 + hstep, voffB);
            PG8_WAIT_V(6); PG8_BAR; PG8_MMA(1, 1, At, B1); PG8_BAR;
            PG8_LDB(B0, 1, 0); PG8_SCHED; PG8_LDA(At, 1, 0); PG8_STAGE(PG8_SA(0, 1), a2 + hstep, voffA);
            PG8_WAIT_L(8); PG8_BAR; PG8_WAIT_L(0); PG8_MMA(0, 0, At, B0); PG8_BAR; PG8_SCHED;
            PG8_LDB(B1, 1, 1); PG8_STAGE(PG8_SB(1, 0), b3, voffB);
            PG8_BAR; PG8_WAIT_L(0); PG8_MMA(0, 1, At, B1); PG8_BAR;
            PG8_LDA(At, 1, 1); PG8_STAGE(PG8_SA(1, 0), a3, voffA);
            PG8_BAR; PG8_WAIT_L(0); PG8_MMA(1, 0, At, B0); PG8_BAR; PG8_SCHED;
            PG8_STAGE(PG8_SB(1, 1), b3 + hstep, voffB);
            PG8_WAIT_V(6); PG8_BAR; PG8_MMA(1, 1, At, B1); PG8_BAR;
            }
        }
        if constexpr (ALIGN_EPI) { if (wr == 0) PG8_BAR; }
        if constexpr (!Epi::AFTER_DRAIN) { E(acc, cur, wr, wc, fr, fq); S.done(cur); }
        if (!has_next) break;
#pragma unroll
        for (int a = 0; a < 2; ++a)
#pragma unroll
            for (int b = 0; b < 2; ++b)
#pragma unroll
                for (int m = 0; m < 4; ++m)
#pragma unroll
                    for (int n = 0; n < 2; ++n) acc[a][b][m][n] = (f32x4){0.f, 0.f, 0.f, 0.f};
        cur = nxt; cA = nA; cB = nB; ++ui;
        if constexpr (ALIGN_EPI) { if (wr == 1) PG8_BAR; }
    }
    PG8_WAIT_V(0);
    if constexpr (!ALIGN_EPI) { if (wr == 0) PG8_BAR; }
    PG8_BAR;
    if constexpr (Epi::AFTER_DRAIN) { E.fused(acc, cur, wr, wc, fr, fq, lds, wid, lane); S.done(cur); }
#undef PG8_SA
#undef PG8_SB
#undef PG8_STAGE
#undef PG8_LDA
#undef PG8_LDB
#undef PG8_MMA
#undef PG8_WAIT_V
#undef PG8_WAIT_L
#undef PG8_BAR
#undef PG8_SCHED
}
}

#define LAS __attribute__((address_space(3)))
typedef unsigned short bf16_t;
typedef short bf16x8 __attribute__((ext_vector_type(8)));
typedef short s16x4 __attribute__((ext_vector_type(4)));
typedef float f32x4 __attribute__((ext_vector_type(4)));
typedef float f32x2 __attribute__((ext_vector_type(2)));
typedef unsigned u32x4 __attribute__((ext_vector_type(4)));
typedef unsigned u32x2 __attribute__((ext_vector_type(2)));

constexpr int DM = 1024, MROWS = 16640, NPR = 16384, META0 = 16496, SAMP0 = 16512, DFF = 2816, RIN = 6144, VD = 2048;
constexpr int LDS_BYTES = 143360;
constexpr size_t OUT_YP = 0, OUT_YS = 16777216, OUT_RETP = 16908288, OUT_RETS = 21102592, OUT_CONVP = 88211456, OUT_CONVS = 88227840, OUT_FFNP = 88489984, OUT_FFNS = 88580096;
constexpr size_t WS_X = 0;
constexpr size_t WS_H = WS_X + (size_t)MROWS * DM * 4;
constexpr size_t WS_PROJ = WS_H + (size_t)MROWS * DM * 2;
constexpr size_t WS_O = WS_PROJ + (size_t)MROWS * RIN * 2;
constexpr size_t HALO_N = (size_t)260 * 2 * DFF;
constexpr size_t WS_Y = WS_O + (size_t)MROWS * VD * 2;
constexpr size_t WS_Y0 = WS_Y + (size_t)MROWS * DFF * 2;
constexpr size_t WS_STATS = WS_Y0 + (size_t)MROWS * VD * 2;
constexpr size_t WS_SS = WS_STATS + (size_t)MROWS * 32 * 8;
constexpr size_t WS_ROPE = WS_SS + (size_t)5 * MROWS * 16 * 4;
constexpr size_t WS_WRI = WS_ROPE + (size_t)2065 * 128 * 8;
constexpr size_t WS_WRO = WS_WRI + (size_t)RIN * DM * 2;
constexpr size_t WS_WSI = WS_WRO + (size_t)DM * VD * 2;
constexpr size_t WS_WSO = WS_WSI + (size_t)3072 * DM * 2;
constexpr size_t WS_WFI = WS_WSO + (size_t)DM * DM * 2;
constexpr size_t WS_WFO = WS_WFI + (size_t)2 * 2 * DFF * DM * 2;
constexpr size_t WS_BAR = WS_WFO + (size_t)2 * DM * DFF * 2;
constexpr size_t WS_END = WS_BAR + 16384;

struct Params {
    const float* in[18];
    float* out;
    unsigned char* ws;
    int ph_lo, ph_hi;
};
enum { I_XP = 0, I_XS, I_SRET, I_SCONV, I_SFFN, I_META, I_NMIX, I_NFFN, I_NFIN, I_WRI, I_WRO, I_WSI, I_WSC, I_WSO, I_WFI, I_WFC, I_BFC, I_WFO };

__device__ __forceinline__ float bflo(unsigned w) { return __uint_as_float(w << 16); }
__device__ __forceinline__ float bfhi(unsigned w) { return __uint_as_float(w & 0xffff0000u); }
__device__ __forceinline__ unsigned pk2(float lo, float hi) { unsigned r; asm("v_cvt_pk_bf16_f32 %0, %1, %2" : "=v"(r) : "v"(lo), "v"(hi)); return r; }
__device__ __forceinline__ float silu_f(float x) { return x * __builtin_amdgcn_rcpf(1.0f + __expf(-x)); }
__device__ __forceinline__ float wave_sum(float v) {
#pragma unroll
    for (int o = 1; o < 64; o <<= 1) v += __shfl_xor(v, o);
    return v;
}
__device__ __forceinline__ float rstd_of(const float* p16) {
    const f32x4 a = *(const f32x4*)p16, b = *(const f32x4*)(p16 + 4), c = *(const f32x4*)(p16 + 8), d = *(const f32x4*)(p16 + 12);
    const float ss = ((a.x + a.y) + (a.z + a.w)) + ((b.x + b.y) + (b.z + b.w)) + ((c.x + c.y) + (c.z + c.w)) + ((d.x + d.y) + (d.z + d.w));
    return 1.0f / sqrtf(ss * (1.0f / DM) + 1e-6f); }
__device__ __forceinline__ int pos_index(int row) { if (row < NPR) return 16 + (row & 2047); if (row < SAMP0) { const int j = row - META0; return j < 0 ? 0 : j; } return 2064; }
__device__ __forceinline__ void unpack8(const u32x4 w, float (&f)[8]) { f[0] = bflo(w.x); f[1] = bfhi(w.x); f[2] = bflo(w.y); f[3] = bfhi(w.y); f[4] = bflo(w.z); f[5] = bfhi(w.z); f[6] = bflo(w.w); f[7] = bfhi(w.w); }
__device__ __forceinline__ u32x4 pack8(const float (&f)[8]) { u32x4 w; w.x = pk2(f[0], f[1]); w.y = pk2(f[2], f[3]); w.z = pk2(f[4], f[5]); w.w = pk2(f[6], f[7]); return w; }
__device__ __forceinline__ void load8f(const float* p, float (&f)[8]) { const f32x4 a = *(const f32x4*)p, b = *(const f32x4*)(p + 4); f[0] = a.x; f[1] = a.y; f[2] = a.z; f[3] = a.w; f[4] = b.x; f[5] = b.y; f[6] = b.z; f[7] = b.w; }
__device__ __forceinline__ void store8f(float* p, const float (&f)[8]) { *(f32x4*)p = (f32x4){f[0], f[1], f[2], f[3]}; *(f32x4*)(p + 4) = (f32x4){f[4], f[5], f[6], f[7]}; }

#define XB_TMO      128
#define XB_XCNT(j)  (256  + 64 * (j))
#define XB_XSUB(j)  (1280 + 64 * (j))
#define XB_XGEN(j)  (2304 + 64 * (j))
#define XB_TOP      3328
#define XB_TOPGEN   3392
#define XCD_BAR_WORDS 3456
#define XB_SPIN_CAP (1u << 18)

__device__ __forceinline__ unsigned xb_ld(unsigned* p)              { return __hip_atomic_load(p, __ATOMIC_RELAXED, __HIP_MEMORY_SCOPE_AGENT); }
__device__ __forceinline__ unsigned xb_add(unsigned* p, unsigned v) { return __hip_atomic_fetch_add(p, v, __ATOMIC_RELAXED, __HIP_MEMORY_SCOPE_AGENT); }
__device__ __forceinline__ unsigned xb_xcc_id() { return (unsigned)__builtin_amdgcn_s_getreg((3 << 11) | 20) & 0xFu; }
#define XB_SPIN(cond, bar) do { unsigned _sp = 0; while (cond) { __builtin_amdgcn_s_sleep(1); \
    if ((++_sp & 255u) == 0u) { if (xb_ld(&(bar)[XB_TMO])) break; if (_sp > XB_SPIN_CAP) { atomicAdd(&(bar)[XB_TMO], 1u); break; } } } } while (0)

struct XcdBarrier {
    unsigned* bar; unsigned x;
    volatile LAS unsigned* st;
};

__device__ __forceinline__ XcdBarrier xcd_barrier_post(unsigned* bar, volatile LAS unsigned* st) {
    XcdBarrier b; b.bar = bar; b.x = xb_xcc_id(); b.st = st;
    if (TIDX == 0) (void)xb_add(&bar[XB_XCNT(b.x)], 1u);
    return b;
}
__device__ __forceinline__ void xcd_barrier_complete(unsigned* bar, unsigned x, unsigned& nloc, unsigned& nx) {
    const unsigned G = gridDim.x * gridDim.y * gridDim.z;
    unsigned sum, cnt, mine, sp = 0u;
    for (;;) {
        sum = 0u; cnt = 0u; mine = 0u;
#pragma unroll
        for (unsigned j = 0; j < 16; ++j) { const unsigned c = xb_ld(&bar[XB_XCNT(j)]); sum += c; cnt += (c > 0u) ? 1u : 0u; mine = (j == x) ? c : mine; }
        if (sum == G) break;
        __builtin_amdgcn_s_sleep(1);
        if ((++sp & 255u) == 0u) { if (xb_ld(&bar[XB_TMO])) break; if (sp > XB_SPIN_CAP) { atomicAdd(&bar[XB_TMO], 1u); break; } }
    }
    nloc = mine > 0u ? mine : 1u; nx = cnt > 0u ? cnt : 1u;
}

__device__ __forceinline__ void xcd_barrier(const XcdBarrier& b) {
    asm volatile("s_waitcnt vmcnt(0)" ::: "memory");
    __syncthreads();
    if (TIDX == 0) {
        unsigned* bar = b.bar;
        __builtin_amdgcn_s_waitcnt(0);
        unsigned nloc = b.st[0], nx = b.st[1];
        if (nloc == 0u) { xcd_barrier_complete(bar, b.x, nloc, nx); b.st[0] = nloc; b.st[1] = nx; }
        const unsigned old = xb_add(&bar[XB_XSUB(b.x)], 1u);
        const unsigned gen = old / nloc;
        if (old + 1u == (gen + 1u) * nloc) {
            __builtin_amdgcn_fence(__ATOMIC_RELEASE, "agent");
            asm volatile("s_waitcnt vmcnt(0)" ::: "memory");
            const unsigned og = xb_add(&bar[XB_TOP], 1u);
            const unsigned tg = og / nx;
            if (og + 1u == (tg + 1u) * nx) xb_add(&bar[XB_TOPGEN], 1u);
            else XB_SPIN(xb_ld(&bar[XB_TOPGEN]) == tg, bar);
            __builtin_amdgcn_fence(__ATOMIC_ACQUIRE, "agent");
            xb_add(&bar[XB_XGEN(b.x)], 1u);
            asm volatile("s_waitcnt vmcnt(0)" ::: "memory");
        } else {
            XB_SPIN(xb_ld(&bar[XB_XGEN(b.x)]) == gen, bar);
            __builtin_amdgcn_fence(__ATOMIC_ACQUIRE, "agent");
            asm volatile("s_waitcnt vmcnt(0)" ::: "memory");
        }
    }
    __syncthreads();
}

struct EpiRetIn {
    static constexpr bool PERM = true, AFTER_DRAIN = false;
    bf16_t* O; const float* rope; const float* rt;
    __device__ __forceinline__ void operator()(const f32x4 (&acc)[2][2][4][2], const pg8::Unit& u, int wr, int wc, int fr, int fq) const {
        const int row0 = u.pm * 256 + wr * 64 + fr, colt = u.pn * 256 + wc * 32 + 8 * fq;
        const int kind = u.pn < 4 ? 0 : (u.pn < 8 ? 1 : (u.pn < 16 ? 2 : 3));
        const float* rtu = rt + u.idx * 256 + wr * 64 + fr;
#pragma unroll
        for (int ai = 0; ai < 2; ++ai) {
            float rs[4];
#pragma unroll
            for (int m = 0; m < 4; ++m) rs[m] = rtu[ai * 128 + m * 16];
            if (kind <= 1) {
                f32x4 cs[4][2][2];
#pragma unroll
                for (int m = 0; m < 4; ++m) { const float* rp = rope + ((size_t)pos_index(row0 + ai * 128 + m * 16) * 128 + wc * 16 + 4 * fq) * 2;
#pragma unroll
                    for (int bj = 0; bj < 2; ++bj) { cs[m][bj][0] = *(const f32x4*)(rp + bj * 128); cs[m][bj][1] = *(const f32x4*)(rp + bj * 128 + 4); } }
#pragma unroll
                for (int m = 0; m < 4; ++m) {
                    bf16_t* rowp = O + (size_t)(row0 + ai * 128 + m * 16) * RIN + colt;
                    const float sc = kind == 1 ? 0.0625f * rs[m] : rs[m];
#pragma unroll
                    for (int bj = 0; bj < 2; ++bj) {
                        const f32x4 c0 = cs[m][bj][0], c1 = cs[m][bj][1];
                        const f32x4 v0 = acc[ai][bj][m][0] * sc, v1 = acc[ai][bj][m][1] * sc;
                        u32x4 w;
                        w.x = pk2(v0.x * c0.x - v0.y * c0.y, v0.x * c0.y + v0.y * c0.x);
                        w.y = pk2(v0.z * c0.z - v0.w * c0.w, v0.z * c0.w + v0.w * c0.z);
                        w.z = pk2(v1.x * c1.x - v1.y * c1.y, v1.x * c1.y + v1.y * c1.x);
                        w.w = pk2(v1.z * c1.z - v1.w * c1.w, v1.z * c1.w + v1.w * c1.z);
                        *(u32x4*)(rowp + bj * 128) = w;
                    }
                }
            } else {
#pragma unroll
                for (int m = 0; m < 4; ++m) {
                    bf16_t* rowp = O + (size_t)(row0 + ai * 128 + m * 16) * RIN + colt;
#pragma unroll
                    for (int bj = 0; bj < 2; ++bj) {
                        f32x4 v0 = acc[ai][bj][m][0] * rs[m], v1 = acc[ai][bj][m][1] * rs[m];
                        if (kind == 3) { v0 = (f32x4){silu_f(v0.x), silu_f(v0.y), silu_f(v0.z), silu_f(v0.w)}; v1 = (f32x4){silu_f(v1.x), silu_f(v1.y), silu_f(v1.z), silu_f(v1.w)}; }
                        u32x4 w; w.x = pk2(v0.x, v0.y); w.y = pk2(v0.z, v0.w); w.z = pk2(v1.x, v1.y); w.w = pk2(v1.z, v1.w);
                        *(u32x4*)(rowp + bj * 128) = w;
                    }
                }
            }
        }
    }
};
struct EpiBf16 {
    static constexpr bool PERM = true, AFTER_DRAIN = false;
    bf16_t* O; int ldc; const float* rt;
    __device__ __forceinline__ void operator()(const f32x4 (&acc)[2][2][4][2], const pg8::Unit& u, int wr, int wc, int fr, int fq) const {
        const int row0 = u.pm * 256 + wr * 64 + fr, colt = u.pn * 256 + wc * 32 + 8 * fq;
#pragma unroll
        for (int ai = 0; ai < 2; ++ai)
#pragma unroll
            for (int m = 0; m < 4; ++m) {
                bf16_t* rowp = O + (size_t)(row0 + ai * 128 + m * 16) * ldc + colt;
                const float rs = rt[u.idx * 256 + ai * 128 + wr * 64 + m * 16 + fr];
#pragma unroll
                for (int bj = 0; bj < 2; ++bj) {
                    const f32x4 v0 = acc[ai][bj][m][0] * rs, v1 = acc[ai][bj][m][1] * rs;
                    u32x4 w; w.x = pk2(v0.x, v0.y); w.y = pk2(v0.z, v0.w); w.z = pk2(v1.x, v1.y); w.w = pk2(v1.z, v1.w);
                    *(u32x4*)(rowp + bj * 128) = w;
                }
            }
    }
};
struct EpiFfn {
    static constexpr bool PERM = true, AFTER_DRAIN = false;
    bf16_t* Y; const float* rt; float* halo; const float* cw; const float* cb; const float* sin_; float* outs;
    __device__ __forceinline__ void operator()(const f32x4 (&acc)[2][2][4][2], const pg8::Unit& u, int wr, int wc, int fr, int fq) const {
        const int src1 = (fq << 4) | ((fr + 15) & 15), src2 = (fq << 4) | ((fr + 14) & 15);
        const int chb = 128 * u.pn + 32 * wc + 8 * fq;
        const float* rtu = rt + u.idx * 256 + wr * 64 + fr;
        f32x4 cwv[2][4];
#pragma unroll
        for (int n = 0; n < 2; ++n) { const unsigned cho = (unsigned)(chb + 4 * n) * 4u;
            cwv[n][0] = *(const f32x4*)((const char*)cw + cho); cwv[n][1] = *(const f32x4*)((const char*)(cw + DFF) + cho); cwv[n][2] = *(const f32x4*)((const char*)(cw + 2 * DFF) + cho); cwv[n][3] = *(const f32x4*)((const char*)cb + cho); }
#pragma unroll
        for (int ai = 0; ai < 2; ++ai) {
            float rs[4];
#pragma unroll
            for (int m = 0; m < 4; ++m) rs[m] = rtu[ai * 128 + m * 16];
            const bool sample = (u.pm == 64) && (ai == 1);
            const int row0 = u.pm * 256 + ai * 128 + wr * 64 + fr, strip = (u.pm * 256 + ai * 128 + wr * 64) >> 6;
            if (!sample) {
                f32x4 q1[2], q2[2];
#pragma unroll
                for (int n = 0; n < 2; ++n) { q1[n] = (f32x4){0.f, 0.f, 0.f, 0.f}; q2[n] = q1[n]; }
#pragma unroll
                for (int m = 0; m < 4; ++m) {
                    u32x2 wv[2];
#pragma unroll
                    for (int n = 0; n < 2; ++n) {
                        const int ch = chb + 4 * n;
                        const f32x4 up = acc[ai][0][m][n] * rs[m];
                        f32x4 a1, a2, p1, p2;
#pragma unroll
                        for (int t = 0; t < 4; ++t) { a1[t] = __shfl(up[t], src1); a2[t] = __shfl(up[t], src2); p1[t] = fr >= 1 ? a1[t] : q1[n][t]; p2[t] = fr >= 2 ? a2[t] : q2[n][t]; }
                        q1[n] = a1; q2[n] = a2;
                        const f32x4 g = acc[ai][1][m][n] * rs[m];
                        const f32x4 a = cwv[n][0] * p2 + cwv[n][1] * p1 + cwv[n][2] * up + cwv[n][3];
                        wv[n].x = pk2(silu_f(a.x) * g.x, silu_f(a.y) * g.y); wv[n].y = pk2(silu_f(a.z) * g.z, silu_f(a.w) * g.w);
                        if (m == 0 && fr < 2) { const unsigned ho = (unsigned)((strip * 2 + fr) * DFF + ch) * 4u; *(f32x4*)((char*)halo + ho) = up; *(f32x4*)((char*)(halo + HALO_N) + ho) = g; }
                        if (m == 3 && fr >= 14) *(f32x4*)((char*)(halo + 2 * HALO_N) + (unsigned)((strip * 2 + (fr - 14)) * DFF + ch) * 4u) = up;
                    }
                    if (m > 0 || fr >= 2) *(u32x4*)((char*)Y + (unsigned)((row0 + m * 16) * DFF + chb) * 2u) = (u32x4){wv[0].x, wv[0].y, wv[1].x, wv[1].y};
                }
            } else {
#pragma unroll
                for (int m = 0; m < 4; ++m) {
                    const int b = wr * 64 + m * 16 + fr;
                    u32x2 wv[2];
#pragma unroll
                    for (int n = 0; n < 2; ++n) {
                        const int ch = chb + 4 * n;
                        const f32x4 upv = acc[ai][0][m][n] * rs[m], g = acc[ai][1][m][n] * rs[m];
                        const unsigned so = (unsigned)(b * 2 * DFF + ch) * 4u;
                        const f32x4 s0 = *(const f32x4*)((const char*)sin_ + so), s1 = *(const f32x4*)((const char*)(sin_ + DFF) + so);
                        const f32x4 a = cwv[n][0] * s0 + cwv[n][1] * s1 + cwv[n][2] * upv + cwv[n][3];
                        wv[n].x = pk2(silu_f(a.x) * g.x, silu_f(a.y) * g.y); wv[n].y = pk2(silu_f(a.z) * g.z, silu_f(a.w) * g.w);
                        *(f32x4*)((char*)outs + so) = s1; *(f32x4*)((char*)(outs + DFF) + so) = upv;
                    }
                    *(u32x4*)((char*)Y + (unsigned)((SAMP0 + b) * DFF + chb) * 2u) = (u32x4){wv[0].x, wv[0].y, wv[1].x, wv[1].y};
                }
            }
            asm volatile("" ::: "memory");
        }
    }
};
struct EpiSc {
    static constexpr bool PERM = true, AFTER_DRAIN = false;
    bf16_t* O; const float* rt;
    __device__ __forceinline__ void operator()(const f32x4 (&acc)[2][2][4][2], const pg8::Unit& u, int wr, int wc, int fr, int fq) const {
        const int row0 = u.pm * 256 + wr * 64 + fr;
        const float* rtu = rt + u.idx * 256 + wr * 64 + fr;
        if (u.pn < 4) {
            const int colt = u.pn * 256 + wc * 32 + 8 * fq;
#pragma unroll
            for (int ai = 0; ai < 2; ++ai)
#pragma unroll
                for (int m = 0; m < 4; ++m) {
                    bf16_t* rowp = O + (size_t)(row0 + ai * 128 + m * 16) * (2 * DM) + colt;
                    const float rs = rtu[ai * 128 + m * 16];
#pragma unroll
                    for (int bj = 0; bj < 2; ++bj) {
                        const f32x4 v0 = acc[ai][bj][m][0] * rs, v1 = acc[ai][bj][m][1] * rs;
                        u32x4 w; w.x = pk2(v0.x, v0.y); w.y = pk2(v0.z, v0.w); w.z = pk2(v1.x, v1.y); w.w = pk2(v1.z, v1.w);
                        *(u32x4*)(rowp + bj * 128) = w;
                    }
                }
        } else {
            const int ch0 = DM + 128 * (u.pn - 4) + wc * 32 + 8 * fq;
#pragma unroll
            for (int ai = 0; ai < 2; ++ai)
#pragma unroll
                for (int m = 0; m < 4; ++m) {
                    const float rs = rtu[ai * 128 + m * 16], r2 = rs * rs;
                    const f32x4 v0 = acc[ai][0][m][0] * acc[ai][1][m][0] * r2, v1 = acc[ai][0][m][1] * acc[ai][1][m][1] * r2;
                    u32x4 w; w.x = pk2(v0.x, v0.y); w.y = pk2(v0.z, v0.w); w.z = pk2(v1.x, v1.y); w.w = pk2(v1.z, v1.w);
                    *(u32x4*)(O + (size_t)(row0 + ai * 128 + m * 16) * (2 * DM) + ch0) = w;
                }
        }
    }
};
struct EpiResid {
    static constexpr bool PERM = true, AFTER_DRAIN = false;
    bf16_t* H; float* ssn;
    __device__ __forceinline__ void operator()(const f32x4 (&acc)[2][2][4][2], const pg8::Unit& u, int wr, int wc, int fr, int fq) const {
        const int row0 = u.pm * 256 + wr * 64 + fr, col0 = u.pn * 256 + wc * 32 + 8 * fq;
#pragma unroll
        for (int ai = 0; ai < 2; ++ai) {
            u32x4 xv[4][2];
#pragma unroll
            for (int m = 0; m < 4; ++m) { const bf16_t* rowp = H + (size_t)(row0 + ai * 128 + m * 16) * DM + col0;
#pragma unroll
                for (int bj = 0; bj < 2; ++bj) xv[m][bj] = *(const u32x4*)(rowp + bj * 128); }
#pragma unroll
            for (int m = 0; m < 4; ++m) {
                const int row = row0 + ai * 128 + m * 16;
                bf16_t* hp = H + (size_t)row * DM + col0;
                float sq = 0.f;
#pragma unroll
                for (int bj = 0; bj < 2; ++bj) { const u32x4 xw = xv[m][bj];
                    const f32x4 v0 = (f32x4){bflo(xw.x), bfhi(xw.x), bflo(xw.y), bfhi(xw.y)} + acc[ai][bj][m][0], v1 = (f32x4){bflo(xw.z), bfhi(xw.z), bflo(xw.w), bfhi(xw.w)} + acc[ai][bj][m][1];
                    sq += ((v0.x * v0.x + v0.y * v0.y) + (v0.z * v0.z + v0.w * v0.w)) + ((v1.x * v1.x + v1.y * v1.y) + (v1.z * v1.z + v1.w * v1.w));
                    u32x4 w; w.x = pk2(v0.x, v0.y); w.y = pk2(v0.z, v0.w); w.z = pk2(v1.x, v1.y); w.w = pk2(v1.z, v1.w); *(u32x4*)(hp + bj * 128) = w; }
                sq += __shfl_xor(sq, 16); sq += __shfl_xor(sq, 32);
                if (fq == 0) ssn[(size_t)row * 16 + u.pn * 4 + wc] = sq;
            }
            asm volatile("" ::: "memory");
        }
    }
};
__device__ __forceinline__ void ffnfix_strips(const Params& p, int layer, int s_lo, int s_hi) {
    bf16_t* Y = (bf16_t*)(p.ws + WS_Y); const float* HUF = (const float*)(p.ws + WS_O); const float* HGF = HUF + HALO_N; const float* HUL = HUF + 2 * HALO_N;
    const float* cw = p.in[I_WFC] + (size_t)layer * 3 * DFF; const float* cb = p.in[I_BFC] + (size_t)layer * DFF;
    constexpr int CG = DFF / 8;
    const int total = (s_hi - s_lo) * 2 * CG;
    for (int idx = TIDX; idx < total; idx += 512) {
        const int it = idx / CG, c = (idx - it * CG) * 8;
        const int s_ = s_lo + (it >> 1), i = it & 1, sp = (s_ < 256 && (s_ & 31) == 0) ? 257 : (s_ > 0 ? s_ - 1 : 0);
        float u0[8], u1[8], u2[8], gt[8], w0[8], w1[8], w2[8], bb[8], y[8];
        load8f(HUF + ((size_t)s_ * 2 + i) * DFF + c, u0); load8f(HGF + ((size_t)s_ * 2 + i) * DFF + c, gt);
        if (i == 0) { load8f(HUL + ((size_t)sp * 2 + 1) * DFF + c, u1); load8f(HUL + ((size_t)sp * 2 + 0) * DFF + c, u2); }
        else { load8f(HUF + ((size_t)s_ * 2 + 0) * DFF + c, u1); load8f(HUL + ((size_t)sp * 2 + 1) * DFF + c, u2); }
        load8f(cw + c, w0); load8f(cw + DFF + c, w1); load8f(cw + 2 * DFF + c, w2); load8f(cb + c, bb);
#pragma unroll
        for (int k = 0; k < 8; ++k) { const float a = w0[k] * u2[k] + w1[k] * u1[k] + w2[k] * u0[k] + bb[k]; y[k] = silu_f(a) * gt[k]; }
        *(u32x4*)(Y + (size_t)(64 * s_ + i) * DFF + c) = pack8(y);
    }
}
__device__ __forceinline__ void ffn_state_prompt(const Params& p, int layer, int b) {
    const float* HUL = (const float*)(p.ws + WS_O) + 2 * HALO_N; float* outp = p.out + OUT_FFNP + (size_t)layer * 8 * 2 * DFF;
    for (int idx = TIDX; idx < 2 * (DFF / 8); idx += 512) { const int i = idx / (DFF / 8), c = (idx - i * (DFF / 8)) * 8;
        float v[8]; load8f(HUL + ((size_t)(32 * b + 31) * 2 + i) * DFF + c, v); store8f(outp + ((size_t)b * 2 + i) * DFF + c, v); }
}
__device__ __forceinline__ void wg_arrive(unsigned* cnt) {
    asm volatile("s_waitcnt vmcnt(0)" ::: "memory");
    __syncthreads();
    if (TIDX == 0) { __builtin_amdgcn_fence(__ATOMIC_RELEASE, "agent"); asm volatile("s_waitcnt vmcnt(0)" ::: "memory"); (void)xb_add(cnt, 1u); }
}
__device__ __forceinline__ void poll_ge(unsigned* cnt, unsigned target) {
    unsigned sp = 0u;
    while ((unsigned)__builtin_amdgcn_readfirstlane(xb_ld(cnt)) < target) { __builtin_amdgcn_s_sleep(2); if (++sp > (1u << 16)) break; }
    __builtin_amdgcn_fence(__ATOMIC_ACQUIRE, "agent");
    asm volatile("s_waitcnt vmcnt(0)" ::: "memory");
}
__device__ __forceinline__ void wg_wait(unsigned* cnt, unsigned target) {
    if (TIDX < 64) poll_ge(cnt, target);
    __syncthreads();
}
struct OneUnit {
    int pm, pn;
    __device__ __forceinline__ bool next(int i, pg8::Unit& u) const { if (i != 0) return false; u.pm = pm; u.pn = pn; u.idx = 0; return true; }
    __device__ __forceinline__ void a_ready(const pg8::Unit&) const {}
    __device__ __forceinline__ void done(const pg8::Unit&) const {}
};
struct TailOrder {
    pg8::StaticOrder so; int nmain, nN, c; unsigned* cntB; float* rt; const float* ss;
    __device__ __forceinline__ void init(int N, int c_, unsigned* cntB_, float* rt_, const float* ss_) { so.init(NPR, N, 256, c_); nmain = so.nwg; nN = N / 256; c = c_; cntB = cntB_; rt = rt_; ss = ss_; }
    __device__ __forceinline__ bool next(int i, pg8::Unit& u) const {
        const int total = nmain + nN, jf = total >> 8, rem = total & 255;
        long L;
        if (c >= 252) { L = (long)(i + 2) * 256 + c; if (L >= total) return false; }
        else if (i < jf || (i == jf && c < rem)) L = (long)i * 256 + c;
        else if (i == jf && c < rem + 8) { const int hh = c - rem; L = (long)(hh >> 2) * 256 + 252 + (hh & 3); }
        else return false;
        if (L < nmain) so.at(L, u); else { u.pm = 64; u.pn = (int)(L - nmain); }
        u.idx = i; return true;
    }
    __device__ __forceinline__ void a_ready(const pg8::Unit& u) const {
        if (u.pm == 64) {
            if (TIDX < 64) poll_ge(cntB, 4u);
            asm volatile("" ::: "memory"); __builtin_amdgcn_s_barrier(); asm volatile("" ::: "memory");
            if (TIDX < 256) rt[u.idx * 256 + TIDX] = rstd_of(ss + (size_t)(64 * 256 + TIDX) * 16);
        }
    }
    __device__ __forceinline__ void done(const pg8::Unit&) const {}
};
__device__ __forceinline__ void run_resid_gemm(const Params& p, int fix_layer, LAS unsigned char* lds, const bf16_t* A, const bf16_t* Bt, int K, bf16_t* H, float* ssn, unsigned* cntA, unsigned* cntB) {
    EpiResid E{H, ssn};
    { pg8::Gemm g{A, Bt, NPR, DM, K}; pg8::StaticOrder S; S.init(NPR, DM, (int)gridDim.x, (int)blockIdx.x);
      if (fix_layer >= 0) { pg8::Unit u0; if (S.next(0, u0)) ffnfix_strips(p, fix_layer, 4 * u0.pm, 4 * u0.pm + 4); if ((int)blockIdx.x < 8) ffn_state_prompt(p, fix_layer, (int)blockIdx.x);
                            asm volatile("s_waitcnt vmcnt(0)" ::: "memory"); __syncthreads(); }
      pg8::gemm_phase<EpiResid, pg8::StaticOrder, false, true>(lds, g, S, E); }
    wg_arrive(cntA);
    if ((int)blockIdx.x >= 252) {
        if (fix_layer >= 0) { ffnfix_strips(p, fix_layer, 256, 258); asm volatile("s_waitcnt vmcnt(0)" ::: "memory"); __syncthreads(); }
        pg8::Gemm g{A, Bt, MROWS, DM, K}; OneUnit S1{64, (int)blockIdx.x - 252}; pg8::gemm_phase<EpiResid, OneUnit, false, true>(lds, g, S1, E);
        wg_arrive(cntB);
    }
    wg_wait(cntA, gridDim.x);
}
template <class Epi> __device__ __forceinline__ void run_gemm_tail(LAS unsigned char* lds, const float* ss, unsigned* cntB, const bf16_t* A, const bf16_t* Bt, int N, int K, const Epi& E) {
    float* rt = (float*)((unsigned char*)lds + pg8::STAGE_BYTES);
    pg8::Gemm g{A, Bt, MROWS, N, K}; TailOrder S; S.init(N, (int)blockIdx.x, cntB, rt, ss);
    for (int i = 0;; ++i) { pg8::Unit u; if (!S.next(i, u)) break;
        if (u.pm != 64 && TIDX < 256) rt[i * 256 + TIDX] = rstd_of(ss + (size_t)(u.pm * 256 + TIDX) * 16); }
    __syncthreads();
    pg8::gemm_phase<Epi, TailOrder, true, true>(lds, g, S, E);
}
__device__ __forceinline__ void build_rstd_table(float* rt, const pg8::StaticOrder& S, const float* ss) {
    for (int i = 0;; ++i) { pg8::Unit u; if (!S.next(i, u)) break;
        if (TIDX < 256) rt[i * 256 + TIDX] = rstd_of(ss + (size_t)(u.pm * 256 + TIDX) * 16); }
    __syncthreads();
}
template <class Epi> __device__ __forceinline__ void run_gemm(LAS unsigned char* lds, const float* ss, const bf16_t* A, const bf16_t* Bt, int N, int K, const Epi& E) {
    pg8::Gemm g{A, Bt, MROWS, N, K}; pg8::StaticOrder S; S.init(MROWS, N, (int)gridDim.x, (int)blockIdx.x);
    if (ss) build_rstd_table((float*)((unsigned char*)lds + pg8::STAGE_BYTES), S, ss);
    pg8::gemm_phase<Epi, pg8::StaticOrder, true, true>(lds, g, S, E);
}

template <bool FFN_INTERLEAVE = false, bool SC_INTERLEAVE = false> __device__ __forceinline__ void transpose_item(const float* W, const float* g, int K, int N, bf16_t* WT, float* scr, int item, int lane) {
    const int nblk = N / 32, kb = item / nblk, nb = item - kb * nblk, k0 = 64 * kb, n0 = 32 * nb;
    const int d0 = SC_INTERLEAVE ? (n0 < DM ? n0 : (n0 < 2 * DM ? DM + ((n0 - DM) >> 7) * 256 + ((n0 - DM) & 127) : DM + ((n0 - 2 * DM) >> 7) * 256 + 128 + ((n0 - 2 * DM) & 127))) : !FFN_INTERLEAVE ? n0 : (n0 < DFF ? (n0 >> 7) * 256 + (n0 & 127) : ((n0 - DFF) >> 7) * 256 + 128 + ((n0 - DFF) & 127));
#pragma unroll 8
    for (int i = 0; i < 32; ++i) { const int kk = 2 * i + (lane >> 5); const float gg = g ? g[k0 + kk] : 1.0f; scr[kk * 33 + (lane & 31)] = W[(size_t)(k0 + kk) * N + n0 + (lane & 31)] * gg; }
    asm volatile("s_waitcnt lgkmcnt(0)" ::: "memory");
    const int c = lane & 7;
#pragma unroll
    for (int j = 0; j < 4; ++j) { const int n = (lane >> 3) + 8 * j; const float* s = scr + (8 * c) * 33 + n;
        u32x4 o; o.x = pk2(s[0 * 33], s[1 * 33]); o.y = pk2(s[2 * 33], s[3 * 33]); o.z = pk2(s[4 * 33], s[5 * 33]); o.w = pk2(s[6 * 33], s[7 * 33]);
        *(u32x4*)(WT + (size_t)(d0 + n) * K + k0 + 8 * c) = o; }
    asm volatile("s_waitcnt lgkmcnt(0)" ::: "memory");
}
__device__ __forceinline__ void sincos_d(double r, float& c, float& s) {
    const double r2 = r * r;
    double sc = 1.0, ss = 1.0;
#pragma unroll
    for (int k = 14; k >= 1; --k) { sc = 1.0 - sc * r2 * (1.0 / (double)((2 * k - 1) * (2 * k))); ss = 1.0 - ss * r2 * (1.0 / (double)((2 * k) * (2 * k + 1))); }
    c = (float)sc; s = (float)(ss * r);
}
__device__ __forceinline__ void prep_rows(const Params& p) {
    bf16_t* H = (bf16_t*)(p.ws + WS_H); float* SS = (float*)(p.ws + WS_SS);
    const int lane = TIDX & 63, gw = blockIdx.x * 8 + (TIDX >> 6), NW = gridDim.x * 8;
    for (int row0 = gw; row0 < MROWS; row0 += 4 * NW) {
        f32x4 v[4][4];
#pragma unroll
        for (int k = 0; k < 4; ++k) { const int row = row0 + k * NW;
            const float* src = row >= MROWS ? nullptr : (row < NPR ? p.in[I_XP] + (size_t)row * DM : (row >= SAMP0 ? p.in[I_XS] + (size_t)(row - SAMP0) * DM : (row >= META0 ? p.in[I_META] + (size_t)(row - META0) * DM : nullptr)));
#pragma unroll
            for (int j = 0; j < 4; ++j) v[k][j] = src ? *(const f32x4*)(src + lane * 4 + 256 * j) : (f32x4){0.f, 0.f, 0.f, 0.f}; }
#pragma unroll
        for (int k = 0; k < 4; ++k) { const int row = row0 + k * NW; if (row < MROWS) {
            float ss = 0.f;
#pragma unroll
            for (int j = 0; j < 4; ++j) {
                u32x2 w; w.x = pk2(v[k][j].x, v[k][j].y); w.y = pk2(v[k][j].z, v[k][j].w); *(u32x2*)(H + (size_t)row * DM + lane * 4 + 256 * j) = w;
                ss += (v[k][j].x * v[k][j].x + v[k][j].y * v[k][j].y) + (v[k][j].z * v[k][j].z + v[k][j].w * v[k][j].w); }
            ss = wave_sum(ss);
            if (lane < 16) SS[(size_t)row * 16 + lane] = lane == 0 ? ss : 0.f; } }
    }
}
__device__ __forceinline__ void phase_final(const Params& p, unsigned* cntB) {
    const bf16_t* H = (const bf16_t*)(p.ws + WS_H); const float* SS = (const float*)(p.ws + WS_SS) + (size_t)4 * MROWS * 16; const float* g = p.in[I_NFIN];
    for (int idx = blockIdx.x * 512 + TIDX; idx < NPR * 128; idx += gridDim.x * 512) {
        const int row = idx >> 7, c = (idx & 127) * 8;
        const float rs = rstd_of(SS + (size_t)row * 16);
        float v[8], gv[8]; unpack8(*(const u32x4*)(H + (size_t)row * DM + c), v); load8f(g + c, gv);
#pragma unroll
        for (int k = 0; k < 8; ++k) v[k] = v[k] * rs * gv[k];
        store8f(p.out + OUT_YP + (size_t)row * DM + c, v);
    }
    wg_wait(cntB, 4u);
    for (int idx = blockIdx.x * 512 + TIDX; idx < 128 * 128; idx += gridDim.x * 512) {
        const int r = idx >> 7, c = (idx & 127) * 8, row = SAMP0 + r;
        const float rs = rstd_of(SS + (size_t)row * 16);
        float v[8], gv[8]; unpack8(*(const u32x4*)(H + (size_t)row * DM + c), v); load8f(g + c, gv);
#pragma unroll
        for (int k = 0; k < 8; ++k) v[k] = v[k] * rs * gv[k];
        store8f(p.out + OUT_YS + (size_t)r * DM + c, v);
    }
}
template <int SET> __device__ __forceinline__ void transpose_set(const Params& p, unsigned char* shm, int first) {
    const int lane = TIDX & 63, wave = TIDX >> 6;
    if ((int)blockIdx.x < first) return;
    const int gw = ((int)blockIdx.x - first) * 8 + wave, NW = ((int)gridDim.x - first) * 8;
    float* scr = (float*)(shm + wave * 8704);
    constexpr int I0 = 16 * 192, I1 = 32 * 32, I2 = 16 * 96, I3 = 16 * 32, I4 = 16 * 176, I5 = 44 * 32;
    constexpr int NIT = SET == 0 ? I0 : (SET == 1 ? I1 + I4 : (SET == 2 ? I5 + I2 + I3 : I4 + I5));
    for (int it = gw; it < NIT; it += NW) {
        int r = it;
        if (SET == 0) { transpose_item(p.in[I_WRI], p.in[I_NMIX], DM, RIN, (bf16_t*)(p.ws + WS_WRI), scr, r, lane); }
        else if (SET == 1) {
            if (r < I1) { transpose_item(p.in[I_WRO], nullptr, VD, DM, (bf16_t*)(p.ws + WS_WRO), scr, r, lane); continue; } r -= I1;
            transpose_item<true>(p.in[I_WFI], p.in[I_NFFN], DM, 2 * DFF, (bf16_t*)(p.ws + WS_WFI), scr, r, lane);
        } else if (SET == 2) {
            if (r < I5) { transpose_item(p.in[I_WFO], nullptr, DFF, DM, (bf16_t*)(p.ws + WS_WFO), scr, r, lane); continue; } r -= I5;
            if (r < I2) { transpose_item<false, true>(p.in[I_WSI], p.in[I_NMIX] + DM, DM, 3072, (bf16_t*)(p.ws + WS_WSI), scr, r, lane); continue; } r -= I2;
            transpose_item(p.in[I_WSO], nullptr, DM, DM, (bf16_t*)(p.ws + WS_WSO), scr, r, lane);
        } else {
            if (r < I4) { transpose_item<true>(p.in[I_WFI] + (size_t)DM * 2 * DFF, p.in[I_NFFN] + DM, DM, 2 * DFF, (bf16_t*)(p.ws + WS_WFI) + (size_t)2 * DFF * DM, scr, r, lane); continue; } r -= I4;
            transpose_item(p.in[I_WFO] + (size_t)DFF * DM, nullptr, DFF, DM, (bf16_t*)(p.ws + WS_WFO) + (size_t)DM * DFF, scr, r, lane);
        }
    }
}
__device__ __forceinline__ void phase_prep(const Params& p, unsigned char* shm) {
    transpose_set<0>(p, shm, 0);
    float* rope = (float*)(p.ws + WS_ROPE);
    for (int i = blockIdx.x * 512 + TIDX; i < 2065 * 128; i += gridDim.x * 512) {
        const int pi = i >> 7, fi = i & 127; const double pos = pi == 2064 ? 16384.0 : (double)pi;
        const double y = -(double)fi * 0.10462765653188542;
        const double nn = rint(y), f = (y - nn) * 0.6931471805599453;
        double e = 1.0;
#pragma unroll
        for (int k = 18; k >= 1; --k) e = 1.0 + e * f * (1.0 / (double)k);
        const double inv = e / (double)(1 << (int)(-nn));
        const double ang = pos * inv; const double kk = rint(ang * 0.15915494309189535); const double rr = ang - kk * 6.283185307179586;
        float c, s; sincos_d(rr, c, s);
        *(f32x2*)(rope + (size_t)i * 2) = (f32x2){c, s};
    }
    prep_rows(p);
}

#define TR_READ2(r0, r1, base, OFF0, OFF1) asm volatile("ds_read_b64_tr_b16 %0, %2 offset:%3\n\tds_read_b64_tr_b16 %1, %2 offset:%4" : "=&v"(r0), "=&v"(r1) : "v"(base), "i"(OFF0), "i"(OFF1) : "memory")
#define MFMA16(a, b, c) __builtin_amdgcn_mfma_f32_16x16x32_bf16((a), (b), (c), 0, 0, 0)
__device__ __forceinline__ bf16x8 cat4(s16x4 a, s16x4 b) { return __builtin_shufflevector(a, b, 0, 1, 2, 3, 4, 5, 6, 7); }

__device__ __forceinline__ void retention_prompt(const Params& p, unsigned char* shm, int item) {
    const int b = item >> 5, h = (item >> 3) & 3, dvb = item & 7;
    const int tid = TIDX, w = __builtin_amdgcn_readfirstlane(tid >> 6), lane = tid & 63, fr = lane & 15, fq = lane >> 4, tq = (lane & 15) >> 2, tp = lane & 3;
    const bf16_t* PROJ = (const bf16_t*)(p.ws + WS_PROJ); bf16_t* O = (bf16_t*)(p.ws + WS_O); f32x2* STATS = (f32x2*)(p.ws + WS_STATS);
    constexpr int KRS = 528, VRS = 144, OFF_V = 128 * KRS, OFF_VS = OFF_V + 128 * VRS, OFF_ST = OFF_VS + 128 * VRS;
    unsigned char* Kl = shm; unsigned char* Vl = shm + OFF_V; unsigned char* Vs = shm + OFF_VS; unsigned char* Stl = shm + OFF_ST;
    const unsigned lbase = (unsigned)(size_t)shm;
    const float lg2 = h == 0 ? -0.04580368961312479f : (h == 1 ? -0.02272007650008353f : (h == 2 ? -0.011315313227834146f : -0.005646563141142063f));
    const float g128 = __builtin_amdgcn_exp2f(lg2 * 128.0f);
    f32x4 sacc[2][4];
#pragma unroll
    for (int j = 0; j < 2; ++j)
#pragma unroll
        for (int eb = 0; eb < 4; ++eb) sacc[j][eb] = (f32x4){0.f, 0.f, 0.f, 0.f};
    const int nloc = 16 * w + fr;
    const unsigned trV_in = lbase + OFF_V + (4 * fq + tq) * VRS + 8 * tp, trV_up = lbase + OFF_VS + (8 * fq + tq) * VRS + 8 * tp, trK_up = lbase + (8 * fq + tq) * KRS + 64 * w + 8 * tp;
    const unsigned koff = (unsigned)((tid >> 5) * RIN + (tid & 31) * 8) * 2u, voff = (unsigned)((tid >> 3) * RIN + (tid & 7) * 8) * 2u, qoff = (unsigned)(nloc * RIN + fq * 8) * 2u;
    u32x4 kpre[8], vpre[2]; bf16x8 qf[8];
    {
        const char* base = (const char*)(PROJ + (size_t)NPR * RIN);
#pragma unroll
        for (int i = 0; i < 8; ++i) kpre[i] = *(const u32x4*)(base + (size_t)(1024 + h * 256 + i * 16 * RIN) * 2 + koff);
#pragma unroll
        for (int i = 0; i < 2; ++i) vpre[i] = *(const u32x4*)(base + (size_t)(2048 + h * 512 + dvb * 64 + i * 64 * RIN) * 2 + voff);
#pragma unroll
        for (int ks = 0; ks < 8; ++ks) qf[ks] = *(const bf16x8*)(base + (size_t)(h * 256 + ks * 32) * 2 + qoff);
    }
    for (int c = -1; c < 16; ++c) {
        float lg2c = lg2; asm volatile("" : "+v"(lg2c));
        const int rowbase = c < 0 ? NPR : b * 2048 + c * 128;
        const char* nbase = (const char*)(PROJ + (size_t)(b * 2048 + (c + 1) * 128) * RIN);
        __syncthreads();
#pragma unroll
        for (int i = 0; i < 8; ++i) { const int ch = tid + 512 * i, r = ch >> 5, cc = ch & 31; *(u32x4*)(Kl + r * KRS + cc * 16) = kpre[i]; }
#pragma unroll
        for (int i = 0; i < 2; ++i) { const int ch = tid + 512 * i, r = ch >> 3, cc = ch & 7;
            *(u32x4*)(Vl + r * VRS + cc * 16) = vpre[i];
            const float kd = __builtin_amdgcn_exp2f(lg2c * (float)(127 - r));
            float f[8]; unpack8(vpre[i], f);
#pragma unroll
            for (int k = 0; k < 8; ++k) f[k] *= kd;
            *(u32x4*)(Vs + r * VRS + cc * 16) = pack8(f); }
#pragma unroll
        for (int j = 0; j < 2; ++j)
#pragma unroll
            for (int eb = 0; eb < 4; ++eb) { u32x2 wv; wv.x = pk2(sacc[j][eb].x, sacc[j][eb].y); wv.y = pk2(sacc[j][eb].z, sacc[j][eb].w);
                *(u32x2*)(Stl + (16 * eb + fr) * KRS + (16 * (2 * w + j) + 4 * fq) * 2) = wv; }
        if (c < 15) {
#pragma unroll
            for (int i = 0; i < 8; ++i) kpre[i] = *(const u32x4*)(nbase + (size_t)(1024 + h * 256 + i * 16 * RIN) * 2 + koff);
#pragma unroll
            for (int i = 0; i < 2; ++i) vpre[i] = *(const u32x4*)(nbase + (size_t)(2048 + h * 512 + dvb * 64 + i * 64 * RIN) * 2 + voff);
        }
        __syncthreads();
        f32x4 oacc[4];
#pragma unroll
        for (int eb = 0; eb < 4; ++eb) {
            oacc[eb] = (f32x4){0.f, 0.f, 0.f, 0.f};
#pragma unroll
            for (int ks = 0; ks < 8; ++ks) { const bf16x8 sf = *(const bf16x8*)(Stl + (16 * eb + fr) * KRS + (ks * 32 + fq * 8) * 2); oacc[eb] = MFMA16(sf, qf[ks], oacc[eb]); }
        }
        const float cd = __builtin_amdgcn_exp2f(lg2c * (float)(nloc + 1));
#pragma unroll
        for (int eb = 0; eb < 4; ++eb) oacc[eb] = oacc[eb] * cd;
        __builtin_amdgcn_sched_barrier(0);
#pragma unroll
        for (int s = 0; s < 4; ++s) {
            if (2 * s <= w) {
                f32x4 p0 = (f32x4){0.f, 0.f, 0.f, 0.f}, p1 = (f32x4){0.f, 0.f, 0.f, 0.f};
#pragma unroll
                for (int ks = 0; ks < 8; ++ks) {
                    const bf16x8 k0 = *(const bf16x8*)(Kl + (32 * s + fr) * KRS + (ks * 32 + fq * 8) * 2), k1 = *(const bf16x8*)(Kl + (32 * s + 16 + fr) * KRS + (ks * 32 + fq * 8) * 2);
                    p0 = MFMA16(k0, qf[ks], p0); p1 = MFMA16(k1, qf[ks], p1);
                }
                float v[8];
#pragma unroll
                for (int t = 0; t < 4; ++t) { const int d0 = nloc - (32 * s + 4 * fq + t), d1 = d0 - 16;
                    v[t] = d0 >= 0 ? p0[t] * __builtin_amdgcn_exp2f(lg2c * (float)d0) : 0.f;
                    v[4 + t] = d1 >= 0 ? p1[t] * __builtin_amdgcn_exp2f(lg2c * (float)d1) : 0.f; }
                const u32x4 wv = pack8(v); const bf16x8 pf = __builtin_bit_cast(bf16x8, wv);
                s16x4 r[4][2];
#pragma unroll
                for (int eb = 0; eb < 4; ++eb) {
                    TR_READ2(r[eb][0], r[eb][1], trV_in, 32 * s * VRS + 32 * eb, (32 * s + 16) * VRS + 32 * eb);
                }
                asm volatile("s_waitcnt lgkmcnt(0)" : "+v"(r[0][0]), "+v"(r[0][1]), "+v"(r[1][0]), "+v"(r[1][1]), "+v"(r[2][0]), "+v"(r[2][1]), "+v"(r[3][0]), "+v"(r[3][1]) :: "memory");
#pragma unroll
                for (int eb = 0; eb < 4; ++eb) oacc[eb] = MFMA16(cat4(r[eb][0], r[eb][1]), pf, oacc[eb]);
            }
            __builtin_amdgcn_sched_barrier(0);
        }
        asm volatile("" ::: "memory");
        if (c < 15) {
#pragma unroll
            for (int ks = 0; ks < 8; ++ks) qf[ks] = *(const bf16x8*)(nbase + (size_t)(h * 256 + ks * 32) * 2 + qoff);
        }
        if (c >= 0 || b == 0) {
            float s1 = 0.f, s2 = 0.f;
#pragma unroll
            for (int eb = 0; eb < 4; ++eb) {
                const f32x4 o = oacc[eb];
                s1 += (o.x + o.y) + (o.z + o.w); s2 += (o.x * o.x + o.y * o.y) + (o.z * o.z + o.w * o.w);
                u32x2 wv; wv.x = pk2(o.x, o.y); wv.y = pk2(o.z, o.w);
                *(u32x2*)(O + (size_t)(rowbase + nloc) * VD + h * 512 + dvb * 64 + 16 * eb + 4 * fq) = wv;
            }
            s1 += __shfl_xor(s1, 16); s1 += __shfl_xor(s1, 32); s2 += __shfl_xor(s2, 16); s2 += __shfl_xor(s2, 32);
            if (fq == 0) STATS[((size_t)(rowbase + nloc) * 4 + h) * 8 + dvb] = (f32x2){s1, s2};
        }
#pragma unroll
        for (int j = 0; j < 2; ++j)
#pragma unroll
            for (int eb = 0; eb < 4; ++eb) sacc[j][eb] = sacc[j][eb] * g128;
        {
            s16x4 kr[2][2][2], vr[2][4][2];
#define UPD_ISSUE(bf, s_) do { _Pragma("unroll") for (int j = 0; j < 2; ++j) TR_READ2(kr[bf][j][0], kr[bf][j][1], trK_up, 32 * (s_) * KRS + 32 * j, (32 * (s_) + 4) * KRS + 32 * j); \
                               _Pragma("unroll") for (int eb = 0; eb < 4; ++eb) TR_READ2(vr[bf][eb][0], vr[bf][eb][1], trV_up, 32 * (s_) * VRS + 32 * eb, (32 * (s_) + 4) * VRS + 32 * eb); } while (0)
            UPD_ISSUE(0, 0);
#pragma unroll
            for (int s = 0; s < 4; ++s) {
                const int cb_ = s & 1;
                asm volatile("s_waitcnt lgkmcnt(0)" : "+v"(kr[cb_][0][0]), "+v"(kr[cb_][0][1]), "+v"(kr[cb_][1][0]), "+v"(kr[cb_][1][1]), "+v"(vr[cb_][0][0]), "+v"(vr[cb_][0][1]), "+v"(vr[cb_][1][0]), "+v"(vr[cb_][1][1]), "+v"(vr[cb_][2][0]), "+v"(vr[cb_][2][1]), "+v"(vr[cb_][3][0]), "+v"(vr[cb_][3][1]) :: "memory");
                if (s < 3) UPD_ISSUE(cb_ ^ 1, s + 1);
#pragma unroll
                for (int j = 0; j < 2; ++j)
#pragma unroll
                    for (int eb = 0; eb < 4; ++eb) sacc[j][eb] = MFMA16(cat4(kr[cb_][j][0], kr[cb_][j][1]), cat4(vr[cb_][eb][0], vr[cb_][eb][1]), sacc[j][eb]);
                __builtin_amdgcn_sched_barrier(0);
            }
#undef UPD_ISSUE
        }
    }
    float* RP = p.out + OUT_RETP + (size_t)(b * 4 + h) * 256 * 512;
#pragma unroll
    for (int j = 0; j < 2; ++j)
#pragma unroll
        for (int eb = 0; eb < 4; ++eb) {
            const int d0 = 16 * (2 * w + j) + 4 * fq, e = dvb * 64 + 16 * eb + fr;
            RP[(size_t)(d0 + 0) * 512 + e] = sacc[j][eb].x; RP[(size_t)(d0 + 1) * 512 + e] = sacc[j][eb].y; RP[(size_t)(d0 + 2) * 512 + e] = sacc[j][eb].z; RP[(size_t)(d0 + 3) * 512 + e] = sacc[j][eb].w;
        }
}
__device__ __forceinline__ void retention_sample(const Params& p, unsigned char* shm, int item) {
    const int b = item >> 2, h = item & 3, row = SAMP0 + b, tid = TIDX, lane = tid & 63, w = tid >> 6;
    const bf16_t* PROJ = (const bf16_t*)(p.ws + WS_PROJ); bf16_t* O = (bf16_t*)(p.ws + WS_O); f32x2* STATS = (f32x2*)(p.ws + WS_STATS);
    float* qs = (float*)shm; float* ks = qs + 256; float* red = ks + 256; float* opart = red + 32;
    const float gamma = 1.0f - (h == 0 ? 0.03125f : (h == 1 ? 0.015625f : (h == 2 ? 0.0078125f : 0.00390625f)));
    const bf16_t* prow = PROJ + (size_t)row * RIN;
    __syncthreads();
    if (tid < 256) {
        const float q = __uint_as_float((unsigned)prow[h * 256 + tid] << 16), k = __uint_as_float((unsigned)prow[1024 + h * 256 + tid] << 16);
        qs[tid] = q; ks[tid] = k;
        const float pr = wave_sum(q * k);
        if (lane == 0) red[w] = pr;
    }
    __syncthreads();
    const float qk = (red[0] + red[1]) + (red[2] + red[3]);
    const int e4 = (tid & 127) * 4, dsub = tid >> 7;
    const u32x2 vw = *(const u32x2*)(prow + 2048 + h * 512 + e4);
    const f32x4 v4 = (f32x4){bflo(vw.x), bfhi(vw.x), bflo(vw.y), bfhi(vw.y)};
    const float* Sp = p.in[I_SRET] + (size_t)(b * 4 + h) * 256 * 512 + e4;
    float* Sn = p.out + OUT_RETS + (size_t)(b * 4 + h) * 256 * 512 + e4;
    f32x4 oa = (f32x4){0.f, 0.f, 0.f, 0.f};
    f32x4 cur[16], nxt[16];
#pragma unroll
    for (int j = 0; j < 16; ++j) cur[j] = __builtin_nontemporal_load((const f32x4*)(Sp + (size_t)(dsub + 4 * j) * 512));
#pragma unroll
    for (int bt = 0; bt < 4; ++bt) {
        if (bt < 3) {
#pragma unroll
            for (int j = 0; j < 16; ++j) nxt[j] = __builtin_nontemporal_load((const f32x4*)(Sp + (size_t)(dsub + 4 * (16 * (bt + 1) + j)) * 512));
        }
#pragma unroll
        for (int j = 0; j < 16; ++j) {
            const int d = dsub + 4 * (16 * bt + j);
            const float qd = qs[d], kd = ks[d];
            oa = oa + cur[j] * qd;
            const f32x4 sn = cur[j] * gamma + v4 * kd;
            __builtin_nontemporal_store(sn, (f32x4*)(Sn + (size_t)d * 512));
        }
#pragma unroll
        for (int j = 0; j < 16; ++j) cur[j] = nxt[j];
    }
    *(f32x4*)(opart + dsub * 512 + e4) = oa;
    __syncthreads();
    const float ve = __uint_as_float((unsigned)prow[2048 + h * 512 + tid] << 16);
    const float o = gamma * ((opart[tid] + opart[512 + tid]) + (opart[1024 + tid] + opart[1536 + tid])) + qk * ve;
    O[(size_t)row * VD + h * 512 + tid] = (bf16_t)(pk2(o, 0.f) & 0xffffu);
    const float s1 = wave_sum(o), s2 = wave_sum(o * o);
    if (lane == 0) { red[8 + w] = s1; red[16 + w] = s2; }
    __syncthreads();
    if (tid < 8) {
        float a = 0.f, c = 0.f;
        if (tid == 0) {
#pragma unroll
            for (int i = 0; i < 8; ++i) { a += red[8 + i]; c += red[16 + i]; }
        }
        STATS[((size_t)row * 4 + h) * 8 + tid] = (f32x2){a, c};
    }
}
__device__ __forceinline__ void phase_retention(const Params& p, unsigned char* shm) {
    const bool stream_first = ((blockIdx.x >> 3) & 1) != 0;
    if (stream_first) { for (int item = blockIdx.x; item < 512; item += gridDim.x) retention_sample(p, shm, item); }
    __syncthreads();
    for (int item = blockIdx.x; item < 256; item += gridDim.x) retention_prompt(p, shm, item);
    __syncthreads();
    if (!stream_first) { for (int item = blockIdx.x; item < 512; item += gridDim.x) retention_sample(p, shm, item); }
}
__device__ __forceinline__ void phase_gatenorm(const Params& p) {
    const bf16_t* PROJ = (const bf16_t*)(p.ws + WS_PROJ); const bf16_t* O = (const bf16_t*)(p.ws + WS_O); const float* STATS = (const float*)(p.ws + WS_STATS); bf16_t* Y = (bf16_t*)(p.ws + WS_Y0);
    const int lane = TIDX & 63, gw = blockIdx.x * 8 + (TIDX >> 6), NW = gridDim.x * 8;
    for (int it0 = gw * 4; it0 < MROWS * 4; it0 += NW * 4) {
        u32x4 ow[4], gwv[4]; f32x4 sa[4], sb[4], sc[4], sd[4];
#pragma unroll
        for (int q = 0; q < 4; ++q) { const int it = it0 + q, row = it >> 2, h = it & 3; const float* st = STATS + (size_t)it * 16;
            sa[q] = *(const f32x4*)st; sb[q] = *(const f32x4*)(st + 4); sc[q] = *(const f32x4*)(st + 8); sd[q] = *(const f32x4*)(st + 12);
            ow[q] = *(const u32x4*)(O + (size_t)row * VD + h * 512 + lane * 8); gwv[q] = *(const u32x4*)(PROJ + (size_t)row * RIN + 4096 + h * 512 + lane * 8); }
#pragma unroll
        for (int q = 0; q < 4; ++q) { const int it = it0 + q, row = it >> 2, h = it & 3;
            const float s1 = (sa[q].x + sa[q].z) + (sb[q].x + sb[q].z) + (sc[q].x + sc[q].z) + (sd[q].x + sd[q].z), s2 = (sa[q].y + sa[q].w) + (sb[q].y + sb[q].w) + (sc[q].y + sc[q].w) + (sd[q].y + sd[q].w);
            const float mu = s1 * (1.0f / 512.0f); float var = s2 * (1.0f / 512.0f) - mu * mu; var = var > 0.f ? var : 0.f;
            const float rstd = 1.0f / sqrtf(var + 1e-6f);
            float of[8], gf[8], y[8]; unpack8(ow[q], of); unpack8(gwv[q], gf);
#pragma unroll
            for (int k = 0; k < 8; ++k) y[k] = gf[k] * ((of[k] - mu) * rstd);
            *(u32x4*)(Y + (size_t)row * VD + h * 512 + lane * 8) = pack8(y); }
    }
}
__device__ __forceinline__ void prev_rows(int row, int& p1, int& p2) {
    if (row < NPR) { const int t = row & 2047; p1 = t >= 1 ? row - 1 : SAMP0 - 1; p2 = t >= 2 ? row - 2 : (t == 1 ? SAMP0 - 1 : SAMP0 - 2); }
    else { p1 = row - 1; p2 = row - 2; }
}
__device__ __forceinline__ void seg_rows(int seg, int& r0, int& h1, int& h2) {
    if (seg < 2048) { r0 = seg * 8; if ((r0 & 2047) == 0) { h1 = SAMP0 - 1; h2 = SAMP0 - 2; } else { h1 = r0 - 1; h2 = r0 - 2; } }
    else { r0 = META0 + (seg - 2048) * 8; if (seg == 2048) { h1 = -1; h2 = -1; } else { h1 = r0 - 1; h2 = r0 - 2; } }
}
constexpr int NSEG = 2050;
__device__ __forceinline__ void phase_scconv(const Params& p) {
    const bf16_t* SC = (const bf16_t*)(p.ws + WS_PROJ); bf16_t* Y = (bf16_t*)(p.ws + WS_Y0);
    const float* cw = p.in[I_WSC]; const float* sin_ = p.in[I_SCONV];
    float* outp = p.out + OUT_CONVP; float* outs = p.out + OUT_CONVS;
    constexpr int CG = DM / 8, LD = 2 * DM;
    const int total = (NSEG + 128) * CG;
    for (int idx = blockIdx.x * 512 + TIDX; idx < total; idx += gridDim.x * 512) {
        const int seg = idx / CG, c = (idx - seg * CG) * 8;
        float w0[8], w1[8], w2[8], u1[8], u2[8];
        load8f(cw + c, w0); load8f(cw + DM + c, w1); load8f(cw + 2 * DM + c, w2);
        if (seg >= NSEG) {
            const int b = seg - NSEG, row = SAMP0 + b; float u0[8], bg[8], y[8];
            unpack8(*(const u32x4*)(SC + (size_t)row * LD + c), bg); unpack8(*(const u32x4*)(SC + (size_t)row * LD + DM + c), u0);
            load8f(sin_ + ((size_t)b * 2 + 1) * DM + c, u1); load8f(sin_ + ((size_t)b * 2 + 0) * DM + c, u2);
            store8f(outs + ((size_t)b * 2 + 0) * DM + c, u1); store8f(outs + ((size_t)b * 2 + 1) * DM + c, u0);
#pragma unroll
            for (int k = 0; k < 8; ++k) y[k] = bg[k] * (w0[k] * u2[k] + w1[k] * u1[k] + w2[k] * u0[k]);
            *(u32x4*)(Y + (size_t)row * DM + c) = pack8(y);
            continue;
        }
        int r0, h1, h2; seg_rows(seg, r0, h1, h2);
        u32x4 bw[8], uw[8];
#pragma unroll
        for (int i = 0; i < 8; ++i) { bw[i] = *(const u32x4*)(SC + (size_t)(r0 + i) * LD + c); uw[i] = *(const u32x4*)(SC + (size_t)(r0 + i) * LD + DM + c); }
        if (h1 >= 0) { unpack8(*(const u32x4*)(SC + (size_t)h1 * LD + DM + c), u1); unpack8(*(const u32x4*)(SC + (size_t)h2 * LD + DM + c), u2); }
        else {
#pragma unroll
            for (int k = 0; k < 8; ++k) { u1[k] = 0.f; u2[k] = 0.f; } }
#pragma unroll
        for (int i = 0; i < 8; ++i) {
            float u0[8], bg[8], y[8]; unpack8(bw[i], bg); unpack8(uw[i], u0);
#pragma unroll
            for (int k = 0; k < 8; ++k) { y[k] = bg[k] * (w0[k] * u2[k] + w1[k] * u1[k] + w2[k] * u0[k]); u2[k] = u1[k]; u1[k] = u0[k]; }
            *(u32x4*)(Y + (size_t)(r0 + i) * DM + c) = pack8(y);
            if (i >= 6 && seg < 2048 && (seg & 255) == 255) store8f(outp + ((size_t)(seg >> 8) * 2 + (i - 6)) * DM + c, u0);
        }
    }
}

constexpr int NPH = 15;
__global__ __launch_bounds__(512, 2) void fwd_megakernel(Params p) {
    extern __shared__ __attribute__((aligned(16))) unsigned char shm[];
    LAS unsigned char* lds = (LAS unsigned char*)shm;
    cg::grid_group grid = cg::this_grid();
    const bf16_t* H = (const bf16_t*)(p.ws + WS_H); const bf16_t* Y = (const bf16_t*)(p.ws + WS_Y);
    bf16_t* PROJ = (bf16_t*)(p.ws + WS_PROJ);
#define PH_BEGIN(k) if (p.ph_lo <= (k) && (k) < p.ph_hi) {
#define PH_END(k) if ((k) + 1 < p.ph_hi) xcd_barrier(xb); }
    float* SS = (float*)(p.ws + WS_SS); bf16_t* Hw = (bf16_t*)(p.ws + WS_H);
    volatile LAS unsigned* xst = (volatile LAS unsigned*)(lds + LDS_BYTES - 16);
    if (TIDX == 0) { xst[0] = 0u; xst[1] = 0u; }
    __syncthreads();
    const XcdBarrier xb = xcd_barrier_post((unsigned*)(p.ws + WS_BAR), xst);
    if (p.ph_hi < 0) grid.sync();
    unsigned* HC = (unsigned*)(p.ws + WS_BAR) + 3520;
    const bf16_t* Y0 = (const bf16_t*)(p.ws + WS_Y0);
#define PH_NOBAR(k) }
    PH_BEGIN(0) phase_prep(p, shm); PH_END(0)
    PH_BEGIN(1) { EpiRetIn E{PROJ, (const float*)(p.ws + WS_ROPE), (const float*)(shm + pg8::STAGE_BYTES)}; run_gemm(lds, SS, H, (const bf16_t*)(p.ws + WS_WRI), RIN, DM, E);
                  transpose_set<1>(p, shm, 24); transpose_set<2>(p, shm, 24); transpose_set<3>(p, shm, 24); } PH_END(1)
    PH_BEGIN(2) phase_retention(p, shm); PH_END(2)
    PH_BEGIN(3) phase_gatenorm(p); PH_END(3)
    PH_BEGIN(4) run_resid_gemm(p, -1, lds, Y0, (const bf16_t*)(p.ws + WS_WRO), VD, Hw, SS + (size_t)MROWS * 16, HC, HC + 64); PH_NOBAR(4)
    PH_BEGIN(5) { EpiFfn E{(bf16_t*)(p.ws + WS_Y), (const float*)(shm + pg8::STAGE_BYTES), (float*)(p.ws + WS_O), p.in[I_WFC], p.in[I_BFC], p.in[I_SFFN], p.out + OUT_FFNS}; run_gemm_tail(lds, SS + (size_t)MROWS * 16, HC + 64, H, (const bf16_t*)(p.ws + WS_WFI), 2 * DFF, DM, E); } PH_END(5)
    PH_BEGIN(7) run_resid_gemm(p, 0, lds, Y, (const bf16_t*)(p.ws + WS_WFO), DFF, Hw, SS + (size_t)2 * MROWS * 16, HC + 128, HC + 192); PH_NOBAR(7)
    PH_BEGIN(8) { EpiSc E{PROJ, (const float*)(shm + pg8::STAGE_BYTES)}; run_gemm_tail(lds, SS + (size_t)2 * MROWS * 16, HC + 192, H, (const bf16_t*)(p.ws + WS_WSI), 3 * DM, DM, E); } PH_END(8)
    PH_BEGIN(9) phase_scconv(p); PH_END(9)
    PH_BEGIN(10) run_resid_gemm(p, -1, lds, Y0, (const bf16_t*)(p.ws + WS_WSO), DM, Hw, SS + (size_t)3 * MROWS * 16, HC + 256, HC + 320); PH_NOBAR(10)
    PH_BEGIN(11) { EpiFfn E{(bf16_t*)(p.ws + WS_Y), (const float*)(shm + pg8::STAGE_BYTES), (float*)(p.ws + WS_O), p.in[I_WFC] + 3 * DFF, p.in[I_BFC] + DFF, p.in[I_SFFN] + (size_t)128 * 2 * DFF, p.out + OUT_FFNS + (size_t)128 * 2 * DFF}; run_gemm_tail(lds, SS + (size_t)3 * MROWS * 16, HC + 320, H, (const bf16_t*)(p.ws + WS_WFI) + (size_t)2 * DFF * DM, 2 * DFF, DM, E); } PH_END(11)
    PH_BEGIN(13) run_resid_gemm(p, 1, lds, Y, (const bf16_t*)(p.ws + WS_WFO) + (size_t)DM * DFF, DFF, Hw, SS + (size_t)4 * MROWS * 16, HC + 384, HC + 448); PH_NOBAR(13)
    PH_BEGIN(14) phase_final(p, HC + 448); PH_END(14)
}

extern "C" void kernel_launch(void* const* d_in, const int* in_sizes, int n_in, void* d_out, int out_size, void* d_ws, size_t ws_size, hipStream_t stream) {
    static int grid = 0;
    if (grid == 0) {
        if (n_in != 18 || ws_size < WS_END) { fprintf(stderr, "kernel_launch: unexpected n_in %d or ws_size %zu (< %zu)\n", n_in, ws_size, (size_t)WS_END); grid = -1; return; }
        int dev = 0, cus = 0, per_cu = 0;
        hipGetDevice(&dev); hipDeviceGetAttribute(&cus, hipDeviceAttributeMultiprocessorCount, dev);
        if (hipFuncSetAttribute((const void*)fwd_megakernel, hipFuncAttributeMaxDynamicSharedMemorySize, LDS_BYTES) != hipSuccess) fprintf(stderr, "kernel_launch: hipFuncSetAttribute failed\n");
        if (hipOccupancyMaxActiveBlocksPerMultiprocessor(&per_cu, (const void*)fwd_megakernel, 512, LDS_BYTES) != hipSuccess || per_cu < 1) { fprintf(stderr, "kernel_launch: occupancy query gave %d\n", per_cu); per_cu = 1; }
        (void)hipGetLastError();
        if (cus != 256) fprintf(stderr, "kernel_launch: note: %d CUs reported; the phase schedule is built for 256 workgroups (one per CU)\n", cus);
        grid = 256;
    }
    if (grid < 0) return;
    if (hipMemsetAsync((char*)d_ws + WS_BAR, 0, 16384, stream) != hipSuccess) fprintf(stderr, "kernel_launch: memset of barrier words failed\n");
    Params p{};
    for (int i = 0; i < 18; ++i) p.in[i] = (const float*)d_in[i];
    p.out = (float*)d_out; p.ws = (unsigned char*)d_ws; p.ph_lo = 0; p.ph_hi = NPH;
#if defined(MK_MULTI)
    for (int ph = 0; ph < NPH; ++ph) { p.ph_lo = ph; p.ph_hi = ph + 1; hipLaunchKernelGGL(fwd_megakernel, dim3(grid), dim3(512), LDS_BYTES, stream, p); }
#else
    void* args[] = {&p};
    hipError_t e = hipLaunchCooperativeKernel((const void*)fwd_megakernel, dim3(grid), dim3(512), args, LDS_BYTES, stream);
    if (e != hipSuccess) fprintf(stderr, "cooperative launch failed: %s (grid %d)\n", hipGetErrorString(e), grid);
#endif
}
```

```cpp
#include <hip/hip_runtime.h>
#include <hip/hip_cooperative_groups.h>
#include <cstdio>
#include <cstdint>
namespace cg = cooperative_groups;
__device__ __forceinline__ int launder_tid() { int t = (int)threadIdx.x; asm volatile("" : "+v"(t)); return t; }
#define TIDX launder_tid()

namespace pg8 {
#define PG8_LAS __attribute__((address_space(3)))
typedef unsigned short bf16_t;
typedef short bf16x8 __attribute__((ext_vector_type(8)));
typedef float f32x4 __attribute__((ext_vector_type(4)));
typedef unsigned u32x4 __attribute__((ext_vector_type(4)));
constexpr int BM = 256, BK = 64, HALF = 128, HTB = HALF * BK * 2  , STAGE_BYTES = 8 * HTB, NXCD = 8, WGM = 8;

__host__ __device__ __forceinline__ int lds_byte(int r, int c) { const int st = (r >> 4) * 2 + (c >> 5), rr = r & 15, cc = c & 31, ob = rr * 64 + cc * 2; return st * 1024 + (ob ^ (((ob >> 9) & 1) << 5)); }
__host__ __device__ __forceinline__ void stage_rc(int b, int& R, int& C) { const int st = b / 1024, sb = b % 1024, swz = sb ^ (((sb >> 9) & 1) << 5); R = (st >> 1) * 16 + swz / 64; C = (st & 1) * 32 + (swz % 64) / 2; }
__host__ __device__ __forceinline__ int perm32(int rho) { const int n = rho >> 4, i = rho & 15; return 8 * (i >> 2) + 4 * n + (i & 3); }

struct Unit { int pm, pn, idx; };
struct Gemm { const bf16_t* A; const bf16_t* Bt; int M, N, K; };

struct StaticOrder {
    int nM, nN, nwg, G, c;
    __host__ __device__ void init(int M, int N, int G_, int c_) { nM = M / BM; nN = N / BM; nwg = nM * nN; G = G_; c = c_; }
    __host__ __device__ bool next(int i, Unit& u) const {
        const long L = (long)i * G + c; if (L >= nwg) return false;
        int wgid = (int)L; { const int q = nwg / NXCD, r = nwg % NXCD, xcd = wgid % NXCD, off = wgid / NXCD; wgid = (xcd < r ? xcd * (q + 1) : r * (q + 1) + (xcd - r) * q) + off; }
        const int nig = WGM * nN, gid = wgid / nig, fm = gid * WGM, gsz = (nM - fm) < WGM ? (nM - fm) : WGM;
        u.pm = fm + ((wgid % nig) % gsz); u.pn = (wgid % nig) / gsz; u.idx = i; return true;
    }
    __host__ __device__ bool at(long L, Unit& u) const {
        if (L >= nwg) return false;
        int wgid = (int)L; { const int q = nwg / NXCD, r = nwg % NXCD, xcd = wgid % NXCD, off = wgid / NXCD; wgid = (xcd < r ? xcd * (q + 1) : r * (q + 1) + (xcd - r) * q) + off; }
        const int nig = WGM * nN, gid = wgid / nig, fm = gid * WGM, gsz = (nM - fm) < WGM ? (nM - fm) : WGM;
        u.pm = fm + ((wgid % nig) % gsz); u.pn = (wgid % nig) / gsz; return true;
    }
    __device__ __forceinline__ void a_ready(const Unit&) const {}
    __device__ __forceinline__ void done(const Unit&) const {}
};
__device__ __forceinline__ unsigned cvt_pk_bf16(float lo, float hi) { unsigned r; asm volatile("v_cvt_pk_bf16_f32 %0, %1, %2" : "=v"(r) : "v"(lo), "v"(hi)); return r; }

template <class Epi, class Sched, bool ALIGN_EPI = false, bool SP2 = false>
__device__ __forceinline__ void gemm_phase(PG8_LAS unsigned char* lds, const Gemm g, const Sched& S, const Epi& E) {
    const int tid = TIDX, wid = __builtin_amdgcn_readfirstlane(tid >> 6), lane = tid & 63, wr = wid >> 2, wc = wid & 3, fr = lane & 15, fq = lane >> 4;
    const int K = g.K, nt = K / BK;
    unsigned voffA[2], voffB[2];
#pragma unroll
    for (int i = 0; i < 2; ++i) { int R, C; stage_rc(tid * 16 + i * 8192, R, C); const int Rb = Epi::PERM ? ((R & ~31) + perm32(R & 31)) : R;
        voffA[i] = (unsigned)(R * K + C) * 2u; voffB[i] = (unsigned)(Rb * K + C) * 2u; }
    const size_t kstep = (size_t)(BK * 2);
    const size_t hstep = (size_t)HALF * K * 2;
    const size_t tstep = 2 * hstep;
    const unsigned ldsw = (unsigned)wid * 1024u;
    const int aoff = lds_byte(wr * 64 + fr, fq * 8), boff = lds_byte(wc * 32 + fr, fq * 8);
#define PG8_SA(b, h) (((b) * 2 + (h)) * HTB)
#define PG8_SB(b, h) ((4 + (b) * 2 + (h)) * HTB)
#define PG8_STAGE(bufoff, gbase, voff) do { _Pragma("unroll") for (int _i = 0; _i < 2; ++_i) \
        __builtin_amdgcn_global_load_lds((const unsigned*)((const char*)(gbase) + (voff)[_i]), (PG8_LAS unsigned*)(lds + (bufoff) + ldsw + _i * 8192), 16, 0, 0); } while (0)
#define PG8_LDA(dst, b, h) do { _Pragma("unroll") for (int m = 0; m < 4; ++m) _Pragma("unroll") for (int k = 0; k < 2; ++k) dst[m][k] = *(const PG8_LAS bf16x8*)(lds + PG8_SA(b, h) + aoff + m * 2048 + k * 1024); } while (0)
#define PG8_LDB(dst, b, h) do { _Pragma("unroll") for (int n = 0; n < 2; ++n) _Pragma("unroll") for (int k = 0; k < 2; ++k) dst[n][k] = *(const PG8_LAS bf16x8*)(lds + PG8_SB(b, h) + boff + n * 2048 + k * 1024); } while (0)
#define PG8_MMA(ai, bj, At, Bt) do { __builtin_amdgcn_s_setprio(1); _Pragma("unroll") for (int m = 0; m < 4; ++m) _Pragma("unroll") for (int n = 0; n < 2; ++n) _Pragma("unroll") for (int k = 0; k < 2; ++k) \
        acc[ai][bj][m][n] = __builtin_amdgcn_mfma_f32_16x16x32_bf16(Bt[n][k], At[m][k], acc[ai][bj][m][n], 0, 0, 0); __builtin_amdgcn_s_setprio(0); } while (0)
#define PG8_WAIT_V(n) asm volatile("s_waitcnt vmcnt(" #n ")" ::: "memory")
#define PG8_WAIT_L(n) asm volatile("s_waitcnt lgkmcnt(" #n ")" ::: "memory")
#define PG8_BAR __builtin_amdgcn_s_barrier()
#define PG8_SCHED __builtin_amdgcn_sched_barrier(0)
    Unit cur, nxt; int ui = 0;
    if (!S.next(0, cur)) return;
    f32x4 acc[2][2][4][2];
#pragma unroll
    for (int a = 0; a < 2; ++a)
#pragma unroll
        for (int b = 0; b < 2; ++b)
#pragma unroll
            for (int m = 0; m < 4; ++m)
#pragma unroll
                for (int n = 0; n < 2; ++n) acc[a][b][m][n] = (f32x4){0.f, 0.f, 0.f, 0.f};
    bf16x8 At[4][2], B0[2][2], B1[2][2];
    const char* cA = (const char*)g.A + (size_t)cur.pm * tstep; const char* cB = (const char*)g.Bt + (size_t)cur.pn * tstep;
    S.a_ready(cur);
    if constexpr (SP2) {
        PG8_STAGE(PG8_SB(0, 0), cB, voffB); PG8_STAGE(PG8_SB(0, 1), cB + hstep, voffB); PG8_STAGE(PG8_SA(0, 0), cA, voffA); PG8_STAGE(PG8_SA(0, 1), cA + hstep, voffA);
        if (wr == 1) PG8_BAR;
        PG8_WAIT_V(2); PG8_BAR;
        PG8_STAGE(PG8_SB(1, 0), cB + kstep, voffB); PG8_STAGE(PG8_SA(1, 0), cA + kstep, voffA); PG8_STAGE(PG8_SB(1, 1), cB + hstep + kstep, voffB);
        PG8_WAIT_V(6); PG8_BAR;
    } else {
        PG8_STAGE(PG8_SB(0, 0), cB, voffB); PG8_STAGE(PG8_SA(0, 0), cA, voffA); PG8_STAGE(PG8_SB(0, 1), cB + hstep, voffB); PG8_STAGE(PG8_SA(0, 1), cA + hstep, voffA);
        if (wr == 1) PG8_BAR;
        PG8_WAIT_V(4); PG8_BAR;
        PG8_STAGE(PG8_SB(1, 0), cB + kstep, voffB); PG8_STAGE(PG8_SA(1, 0), cA + kstep, voffA); PG8_STAGE(PG8_SB(1, 1), cB + hstep + kstep, voffB);
        PG8_WAIT_V(6); PG8_BAR;
    }
    for (;;) {
        const bool has_next = S.next(ui + 1, nxt);
        const char* nA = has_next ? (const char*)g.A + (size_t)nxt.pm * tstep : cA; const char* nB = has_next ? (const char*)g.Bt + (size_t)nxt.pn * tstep : cB;
        for (int t = 0; t < nt; t += 2) {
            const bool last = (t == nt - 2);
            const char* a1 = cA + (size_t)(t + 1) * kstep;
            const char* a2 = last ? nA : cA + (size_t)(t + 2) * kstep; const char* b2 = last ? nB : cB + (size_t)(t + 2) * kstep;
            const char* a3 = a2 + kstep; const char* b3 = b2 + kstep;
            if (last && has_next) S.a_ready(nxt);
            if constexpr (SP2) {
            PG8_LDB(B0, 0, 0); PG8_LDB(B1, 0, 1); PG8_SCHED; PG8_LDA(At, 0, 0); PG8_STAGE(PG8_SA(1, 1), a1 + hstep, voffA);
            PG8_WAIT_V(8); PG8_WAIT_L(0); PG8_BAR; PG8_MMA(0, 0, At, B0); PG8_MMA(0, 1, At, B1); PG8_BAR; PG8_SCHED;
            PG8_LDA(At, 0, 1); PG8_STAGE(PG8_SB(0, 0), b2, voffB); PG8_STAGE(PG8_SB(0, 1), b2 + hstep, voffB); PG8_STAGE(PG8_SA(0, 0), a2, voffA);
            PG8_WAIT_V(8); PG8_WAIT_L(0); PG8_BAR; PG8_MMA(1, 0, At, B0); PG8_MMA(1, 1, At, B1); PG8_BAR; PG8_SCHED;
            PG8_LDB(B0, 1, 0); PG8_LDB(B1, 1, 1); PG8_SCHED; PG8_LDA(At, 1, 0); PG8_STAGE(PG8_SA(0, 1), a2 + hstep, voffA);
            PG8_WAIT_V(8); PG8_WAIT_L(0); PG8_BAR; PG8_MMA(0, 0, At, B0); PG8_MMA(0, 1, At, B1); PG8_BAR; PG8_SCHED;
            PG8_LDA(At, 1, 1); PG8_STAGE(PG8_SB(1, 0), b3, voffB); PG8_STAGE(PG8_SB(1, 1), b3 + hstep, voffB); PG8_STAGE(PG8_SA(1, 0), a3, voffA);
            PG8_WAIT_V(8); PG8_WAIT_L(0); PG8_BAR; PG8_MMA(1, 0, At, B0); PG8_MMA(1, 1, At, B1); PG8_BAR; PG8_SCHED;
            } else {
            PG8_LDB(B0, 0, 0); PG8_SCHED; PG8_LDA(At, 0, 0); PG8_STAGE(PG8_SA(1, 1), a1 + hstep, voffA);
            PG8_WAIT_L(8); PG8_BAR; PG8_WAIT_L(0); PG8_MMA(0, 0, At, B0); PG8_BAR; PG8_SCHED;
            PG8_LDB(B1, 0, 1); PG8_STAGE(PG8_SB(0, 0), b2, voffB);
            PG8_BAR; PG8_WAIT_L(0); PG8_MMA(0, 1, At, B1); PG8_BAR;
            PG8_LDA(At, 0, 1); PG8_STAGE(PG8_SA(0, 0), a2, voffA);
            PG8_BAR; PG8_WAIT_L(0); PG8_MMA(1, 0, At, B0); PG8_BAR; PG8_SCHED;
            PG8_STAGE(PG8_SB(0, 1), b2 + hstep, voffB);
            PG8_WAIT_V(6); PG8_BAR; PG8_MMA(1, 1, At, B1); PG8_BAR;
            PG8_LDB(B0, 1, 0); PG8_SCHED; PG8_LDA(At, 1, 0); PG8_STAGE(PG8_SA(0, 1), a2 + hstep, voffA);
            PG8_WAIT_L(8); PG8_BAR; PG8_WAIT_L(0); PG8_MMA(0, 0, At, B0); PG8_BAR; PG8_SCHED;
            PG8_LDB(B1, 1, 1); PG8_STAGE(PG8_SB(1, 0), b3, voffB);
            PG8_BAR; PG8_WAIT_L(0); PG8_MMA(0, 1, At, B1); PG8_BAR;
            PG8_LDA(At, 1, 1); PG8_STAGE(PG8_SA(1, 0), a3, voffA);
            PG8_BAR; PG8_WAIT_L(0); PG8_MMA(1, 0, At, B0); PG8_BAR; PG8_SCHED;
            PG8_STAGE(PG8_SB(1, 1), b3 + hstep, voffB);
            PG8_WAIT_V(6); PG8_BAR; PG8_MMA(1, 1, At, B1); PG8_BAR;
            }
        }
        if constexpr (ALIGN_EPI) { if (wr == 0) PG8_BAR; }
        if constexpr (!Epi::AFTER_DRAIN) { E(acc, cur, wr, wc, fr, fq); S.done(cur); }
        if (!has_next) break;
#pragma unroll
        for (int a = 0; a < 2; ++a)
#pragma unroll
            for (int b = 0; b < 2; ++b)
#pragma unroll
                for (int m = 0; m < 4; ++m)
#pragma unroll
                    for (int n = 0; n < 2; ++n) acc[a][b][m][n] = (f32x4){0.f, 0.f, 0.f, 0.f};
        cur = nxt; cA = nA; cB = nB; ++ui;
        if constexpr (ALIGN_EPI) { if (wr == 1) PG8_BAR; }
    }
    PG8_WAIT_V(0);
    if constexpr (!ALIGN_EPI) { if (wr == 0) PG8_BAR; }
    PG8_BAR;
    if constexpr (Epi::AFTER_DRAIN) { E.fused(acc, cur, wr, wc, fr, fq, lds, wid, lane); S.done(cur); }
#undef PG8_SA
#undef PG8_SB
#undef PG8_STAGE
#undef PG8_LDA
#undef PG8_LDB
#undef PG8_MMA
#undef PG8_WAIT_V
#undef PG8_WAIT_L
#undef PG8_BAR
#undef PG8_SCHED
}
}

#define LAS __attribute__((address_space(3)))
typedef unsigned short bf16_t;
typedef short bf16x8 __attribute__((ext_vector_type(8)));
typedef short s16x4 __attribute__((ext_vector_type(4)));
typedef float f32x4 __attribute__((ext_vector_type(4)));
typedef float f32x2 __attribute__((ext_vector_type(2)));
typedef unsigned u32x4 __attribute__((ext_vector_type(4)));
typedef unsigned u32x2 __attribute__((ext_vector_type(2)));

constexpr int DM = 1024, MROWS = 16640, NPR = 16384, META0 = 16496, SAMP0 = 16512, DFF = 2816, RIN = 6144, VD = 2048;
constexpr int LDS_BYTES = 143360;
constexpr size_t OUT_YP = 0, OUT_YS = 16777216, OUT_RETP = 16908288, OUT_RETS = 21102592, OUT_CONVP = 88211456, OUT_CONVS = 88227840, OUT_FFNP = 88489984, OUT_FFNS = 88580096;
constexpr size_t WS_X = 0;
constexpr size_t WS_H = WS_X + (size_t)MROWS * DM * 4;
constexpr size_t WS_PROJ = WS_H + (size_t)MROWS * DM * 2;
constexpr size_t WS_O = WS_PROJ + (size_t)MROWS * RIN * 2;
constexpr size_t HALO_N = (size_t)260 * 2 * DFF;
constexpr size_t WS_Y = WS_O + (size_t)MROWS * VD * 2;
constexpr size_t WS_Y0 = WS_Y + (size_t)MROWS * DFF * 2;
constexpr size_t WS_STATS = WS_Y0 + (size_t)MROWS * VD * 2;
constexpr size_t WS_SS = WS_STATS + (size_t)MROWS * 32 * 8;
constexpr size_t WS_ROPE = WS_SS + (size_t)5 * MROWS * 16 * 4;
constexpr size_t WS_WRI = WS_ROPE + (size_t)2065 * 128 * 8;
constexpr size_t WS_WRO = WS_WRI + (size_t)RIN * DM * 2;
constexpr size_t WS_WSI = WS_WRO + (size_t)DM * VD * 2;
constexpr size_t WS_WSO = WS_WSI + (size_t)3072 * DM * 2;
constexpr size_t WS_WFI = WS_WSO + (size_t)DM * DM * 2;
constexpr size_t WS_WFO = WS_WFI + (size_t)2 * 2 * DFF * DM * 2;
constexpr size_t WS_BAR = WS_WFO + (size_t)2 * DM * DFF * 2;
constexpr size_t WS_END = WS_BAR + 16384;

struct Params {
    const float* in[18];
    float* out;
    unsigned char* ws;
    int ph_lo, ph_hi;
};
enum { I_XP = 0, I_XS, I_SRET, I_SCONV, I_SFFN, I_META, I_NMIX, I_NFFN, I_NFIN, I_WRI, I_WRO, I_WSI, I_WSC, I_WSO, I_WFI, I_WFC, I_BFC, I_WFO };

__device__ __forceinline__ float bflo(unsigned w) { return __uint_as_float(w << 16); }
__device__ __forceinline__ float bfhi(unsigned w) { return __uint_as_float(w & 0xffff0000u); }
__device__ __forceinline__ unsigned pk2(float lo, float hi) { unsigned r; asm("v_cvt_pk_bf16_f32 %0, %1, %2" : "=v"(r) : "v"(lo), "v"(hi)); return r; }
__device__ __forceinline__ float silu_f(float x) { return x * __builtin_amdgcn_rcpf(1.0f + __expf(-x)); }
__device__ __forceinline__ float wave_sum(float v) {
#pragma unroll
    for (int o = 1; o < 64; o <<= 1) v += __shfl_xor(v, o);
    return v;
}
__device__ __forceinline__ float rstd_of(const float* p16) {
    const f32x4 a = *(const f32x4*)p16, b = *(const f32x4*)(p16 + 4), c = *(const f32x4*)(p16 + 8), d = *(const f32x4*)(p16 + 12);
    const float ss = ((a.x + a.y) + (a.z + a.w)) + ((b.x + b.y) + (b.z + b.w)) + ((c.x + c.y) + (c.z + c.w)) + ((d.x + d.y) + (d.z + d.w));
    return 1.0f / sqrtf(ss * (1.0f / DM) + 1e-6f); }
__device__ __forceinline__ int pos_index(int row) { if (row < NPR) return 16 + (row & 2047); if (row < SAMP0) { const int j = row - META0; return j < 0 ? 0 : j; } return 2064; }
__device__ __forceinline__ void unpack8(const u32x4 w, float (&f)[8]) { f[0] = bflo(w.x); f[1] = bfhi(w.x); f[2] = bflo(w.y); f[3] = bfhi(w.y); f[4] = bflo(w.z); f[5] = bfhi(w.z); f[6] = bflo(w.w); f[7] = bfhi(w.w); }
__device__ __forceinline__ u32x4 pack8(const float (&f)[8]) { u32x4 w; w.x = pk2(f[0], f[1]); w.y = pk2(f[2], f[3]); w.z = pk2(f[4], f[5]); w.w = pk2(f[6], f[7]); return w; }
__device__ __forceinline__ void load8f(const float* p, float (&f)[8]) { const f32x4 a = *(const f32x4*)p, b = *(const f32x4*)(p + 4); f[0] = a.x; f[1] = a.y; f[2] = a.z; f[3] = a.w; f[4] = b.x; f[5] = b.y; f[6] = b.z; f[7] = b.w; }
__device__ __forceinline__ void store8f(float* p, const float (&f)[8]) { *(f32x4*)p = (f32x4){f[0], f[1], f[2], f[3]}; *(f32x4*)(p + 4) = (f32x4){f[4], f[5], f[6], f[7]}; }

#define XB_TMO      128
#define XB_XCNT(j)  (256  + 64 * (j))
#define XB_XSUB(j)  (1280 + 64 * (j))
#define XB_XGEN(j)  (2304 + 64 * (j))
#define XB_TOP      3328
#define XB_TOPGEN   3392
#define XCD_BAR_WORDS 3456
#define XB_SPIN_CAP (1u << 18)

__device__ __forceinline__ unsigned xb_ld(unsigned* p)              { return __hip_atomic_load(p, __ATOMIC_RELAXED, __HIP_MEMORY_SCOPE_AGENT); }
__device__ __forceinline__ unsigned xb_add(unsigned* p, unsigned v) { return __hip_atomic_fetch_add(p, v, __ATOMIC_RELAXED, __HIP_MEMORY_SCOPE_AGENT); }
__device__ __forceinline__ unsigned xb_xcc_id() { return (unsigned)__builtin_amdgcn_s_getreg((3 << 11) | 20) & 0xFu; }
#define XB_SPIN(cond, bar) do { unsigned _sp = 0; while (cond) { __builtin_amdgcn_s_sleep(1); \
    if ((++_sp & 255u) == 0u) { if (xb_ld(&(bar)[XB_TMO])) break; if (_sp > XB_SPIN_CAP) { atomicAdd(&(bar)[XB_TMO], 1u); break; } } } } while (0)

struct XcdBarrier {
    unsigned* bar; unsigned x;
    volatile LAS unsigned* st;
};

__device__ __forceinline__ XcdBarrier xcd_barrier_post(unsigned* bar, volatile LAS unsigned* st) {
    XcdBarrier b; b.bar = bar; b.x = xb_xcc_id(); b.st = st;
    if (TIDX == 0) (void)xb_add(&bar[XB_XCNT(b.x)], 1u);
    return b;
}
__device__ __forceinline__ void xcd_barrier_complete(unsigned* bar, unsigned x, unsigned& nloc, unsigned& nx) {
    const unsigned G = gridDim.x * gridDim.y * gridDim.z;
    unsigned sum, cnt, mine, sp = 0u;
    for (;;) {
        sum = 0u; cnt = 0u; mine = 0u;
#pragma unroll
        for (unsigned j = 0; j < 16; ++j) { const unsigned c = xb_ld(&bar[XB_XCNT(j)]); sum += c; cnt += (c > 0u) ? 1u : 0u; mine = (j == x) ? c : mine; }
        if (sum == G) break;
        __builtin_amdgcn_s_sleep(1);
        if ((++sp & 255u) == 0u) { if (xb_ld(&bar[XB_TMO])) break; if (sp > XB_SPIN_CAP) { atomicAdd(&bar[XB_TMO], 1u); break; } }
    }
    nloc = mine > 0u ? mine : 1u; nx = cnt > 0u ? cnt : 1u;
}

__device__ __forceinline__ void xcd_barrier(const XcdBarrier& b) {
    asm volatile("s_waitcnt vmcnt(0)" ::: "memory");
    __syncthreads();
    if (TIDX == 0) {
        unsigned* bar = b.bar;
        __builtin_amdgcn_s_waitcnt(0);
        unsigned nloc = b.st[0], nx = b.st[1];
        if (nloc == 0u) { xcd_barrier_complete(bar, b.x, nloc, nx); b.st[0] = nloc; b.st[1] = nx; }
        const unsigned old = xb_add(&bar[XB_XSUB(b.x)], 1u);
        const unsigned gen = old / nloc;
        if (old + 1u == (gen + 1u) * nloc) {
            __builtin_amdgcn_fence(__ATOMIC_RELEASE, "agent");
            asm volatile("s_waitcnt vmcnt(0)" ::: "memory");
            const unsigned og = xb_add(&bar[XB_TOP], 1u);
            const unsigned tg = og / nx;
            if (og + 1u == (tg + 1u) * nx) xb_add(&bar[XB_TOPGEN], 1u);
            else XB_SPIN(xb_ld(&bar[XB_TOPGEN]) == tg, bar);
            __builtin_amdgcn_fence(__ATOMIC_ACQUIRE, "agent");
            xb_add(&bar[XB_XGEN(b.x)], 1u);
            asm volatile("s_waitcnt vmcnt(0)" ::: "memory");
        } else {
            XB_SPIN(xb_ld(&bar[XB_XGEN(b.x)]) == gen, bar);
            __builtin_amdgcn_fence(__ATOMIC_ACQUIRE, "agent");
            asm volatile("s_waitcnt vmcnt(0)" ::: "memory");
        }
    }
    __syncthreads();
}

struct EpiRetIn {
    static constexpr bool PERM = true, AFTER_DRAIN = false;
    bf16_t* O; const float* rope; const float* rt;
    __device__ __forceinline__ void operator()(const f32x4 (&acc)[2][2][4][2], const pg8::Unit& u, int wr, int wc, int fr, int fq) const {
        const int row0 = u.pm * 256 + wr * 64 + fr, colt = u.pn * 256 + wc * 32 + 8 * fq;
        const int kind = u.pn < 4 ? 0 : (u.pn < 8 ? 1 : (u.pn < 16 ? 2 : 3));
        const float* rtu = rt + u.idx * 256 + wr * 64 + fr;
#pragma unroll
        for (int ai = 0; ai < 2; ++ai) {
            float rs[4];
#pragma unroll
            for (int m = 0; m < 4; ++m) rs[m] = rtu[ai * 128 + m * 16];
            if (kind <= 1) {
                f32x4 cs[4][2][2];
#pragma unroll
                for (int m = 0; m < 4; ++m) { const float* rp = rope + ((size_t)pos_index(row0 + ai * 128 + m * 16) * 128 + wc * 16 + 4 * fq) * 2;
#pragma unroll
                    for (int bj = 0; bj < 2; ++bj) { cs[m][bj][0] = *(const f32x4*)(rp + bj * 128); cs[m][bj][1] = *(const f32x4*)(rp + bj * 128 + 4); } }
#pragma unroll
                for (int m = 0; m < 4; ++m) {
                    bf16_t* rowp = O + (size_t)(row0 + ai * 128 + m * 16) * RIN + colt;
                    const float sc = kind == 1 ? 0.0625f * rs[m] : rs[m];
#pragma unroll
                    for (int bj = 0; bj < 2; ++bj) {
                        const f32x4 c0 = cs[m][bj][0], c1 = cs[m][bj][1];
                        const f32x4 v0 = acc[ai][bj][m][0] * sc, v1 = acc[ai][bj][m][1] * sc;
                        u32x4 w;
                        w.x = pk2(v0.x * c0.x - v0.y * c0.y, v0.x * c0.y + v0.y * c0.x);
                        w.y = pk2(v0.z * c0.z - v0.w * c0.w, v0.z * c0.w + v0.w * c0.z);
                        w.z = pk2(v1.x * c1.x - v1.y * c1.y, v1.x * c1.y + v1.y * c1.x);
                        w.w = pk2(v1.z * c1.z - v1.w * c1.w, v1.z * c1.w + v1.w * c1.z);
                        *(u32x4*)(rowp + bj * 128) = w;
                    }
                }
            } else {
#pragma unroll
                for (int m = 0; m < 4; ++m) {
                    bf16_t* rowp = O + (size_t)(row0 + ai * 128 + m * 16) * RIN + colt;
#pragma unroll
                    for (int bj = 0; bj < 2; ++bj) {
                        f32x4 v0 = acc[ai][bj][m][0] * rs[m], v1 = acc[ai][bj][m][1] * rs[m];
                        if (kind == 3) { v0 = (f32x4){silu_f(v0.x), silu_f(v0.y), silu_f(v0.z), silu_f(v0.w)}; v1 = (f32x4){silu_f(v1.x), silu_f(v1.y), silu_f(v1.z), silu_f(v1.w)}; }
                        u32x4 w; w.x = pk2(v0.x, v0.y); w.y = pk2(v0.z, v0.w); w.z = pk2(v1.x, v1.y); w.w = pk2(v1.z, v1.w);
                        *(u32x4*)(rowp + bj * 128) = w;
                    }
                }
            }
        }
    }
};
struct EpiBf16 {
    static constexpr bool PERM = true, AFTER_DRAIN = false;
    bf16_t* O; int ldc; const float* rt;
    __device__ __forceinline__ void operator()(const f32x4 (&acc)[2][2][4][2], const pg8::Unit& u, int wr, int wc, int fr, int fq) const {
        const int row0 = u.pm * 256 + wr * 64 + fr, colt = u.pn * 256 + wc * 32 + 8 * fq;
#pragma unroll
        for (int ai = 0; ai < 2; ++ai)
#pragma unroll
            for (int m = 0; m < 4; ++m) {
                bf16_t* rowp = O + (size_t)(row0 + ai * 128 + m * 16) * ldc + colt;
                const float rs = rt[u.idx * 256 + ai * 128 + wr * 64 + m * 16 + fr];
#pragma unroll
                for (int bj = 0; bj < 2; ++bj) {
                    const f32x4 v0 = acc[ai][bj][m][0] * rs, v1 = acc[ai][bj][m][1] * rs;
                    u32x4 w; w.x = pk2(v0.x, v0.y); w.y = pk2(v0.z, v0.w); w.z = pk2(v1.x, v1.y); w.w = pk2(v1.z, v1.w);
                    *(u32x4*)(rowp + bj * 128) = w;
                }
            }
    }
};
struct EpiFfn {
    static constexpr bool PERM = true, AFTER_DRAIN = false;
    bf16_t* Y; const float* rt; float* halo; const float* cw; const float* cb; const float* sin_; float* outs;
    __device__ __forceinline__ void operator()(const f32x4 (&acc)[2][2][4][2], const pg8::Unit& u, int wr, int wc, int fr, int fq) const {
        const int src1 = (fq << 4) | ((fr + 15) & 15), src2 = (fq << 4) | ((fr + 14) & 15);
        const int chb = 128 * u.pn + 32 * wc + 8 * fq;
        const float* rtu = rt + u.idx * 256 + wr * 64 + fr;
        f32x4 cwv[2][4];
#pragma unroll
        for (int n = 0; n < 2; ++n) { const unsigned cho = (unsigned)(chb + 4 * n) * 4u;
            cwv[n][0] = *(const f32x4*)((const char*)cw + cho); cwv[n][1] = *(const f32x4*)((const char*)(cw + DFF) + cho); cwv[n][2] = *(const f32x4*)((const char*)(cw + 2 * DFF) + cho); cwv[n][3] = *(const f32x4*)((const char*)cb + cho); }
#pragma unroll
        for (int ai = 0; ai < 2; ++ai) {
            float rs[4];
#pragma unroll
            for (int m = 0; m < 4; ++m) rs[m] = rtu[ai * 128 + m * 16];
            const bool sample = (u.pm == 64) && (ai == 1);
            const int row0 = u.pm * 256 + ai * 128 + wr * 64 + fr, strip = (u.pm * 256 + ai * 128 + wr * 64) >> 6;
            if (!sample) {
                f32x4 q1[2], q2[2];
#pragma unroll
                for (int n = 0; n < 2; ++n) { q1[n] = (f32x4){0.f, 0.f, 0.f, 0.f}; q2[n] = q1[n]; }
#pragma unroll
                for (int m = 0; m < 4; ++m) {
                    u32x2 wv[2];
#pragma unroll
                    for (int n = 0; n < 2; ++n) {
                        const int ch = chb + 4 * n;
                        const f32x4 up = acc[ai][0][m][n] * rs[m];
                        f32x4 a1, a2, p1, p2;
#pragma unroll
                        for (int t = 0; t < 4; ++t) { a1[t] = __shfl(up[t], src1); a2[t] = __shfl(up[t], src2); p1[t] = fr >= 1 ? a1[t] : q1[n][t]; p2[t] = fr >= 2 ? a2[t] : q2[n][t]; }
                        q1[n] = a1; q2[n] = a2;
                        const f32x4 g = acc[ai][1][m][n] * rs[m];
                        const f32x4 a = cwv[n][0] * p2 + cwv[n][1] * p1 + cwv[n][2] * up + cwv[n][3];
                        wv[n].x = pk2(silu_f(a.x) * g.x, silu_f(a.y) * g.y); wv[n].y = pk2(silu_f(a.z) * g.z, silu_f(a.w) * g.w);
                        if (m == 0 && fr < 2) { const unsigned ho = (unsigned)((strip * 2 + fr) * DFF + ch) * 4u; *(f32x4*)((char*)halo + ho) = up; *(f32x4*)((char*)(halo + HALO_N) + ho) = g; }
                        if (m == 3 && fr >= 14) *(f32x4*)((char*)(halo + 2 * HALO_N) + (unsigned)((strip * 2 + (fr - 14)) * DFF + ch) * 4u) = up;
                    }
                    if (m > 0 || fr >= 2) *(u32x4*)((char*)Y + (unsigned)((row0 + m * 16) * DFF + chb) * 2u) = (u32x4){wv[0].x, wv[0].y, wv[1].x, wv[1].y};
                }
            } else {
#pragma unroll
                for (int m = 0; m < 4; ++m) {
                    const int b = wr * 64 + m * 16 + fr;
                    u32x2 wv[2];
#pragma unroll
                    for (int n = 0; n < 2; ++n) {
                        const int ch = chb + 4 * n;
                        const f32x4 upv = acc[ai][0][m][n] * rs[m], g = acc[ai][1][m][n] * rs[m];
                        const unsigned so = (unsigned)(b * 2 * DFF + ch) * 4u;
                        const f32x4 s0 = *(const f32x4*)((const char*)sin_ + so), s1 = *(const f32x4*)((const char*)(sin_ + DFF) + so);
                        const f32x4 a = cwv[n][0] * s0 + cwv[n][1] * s1 + cwv[n][2] * upv + cwv[n][3];
                        wv[n].x = pk2(silu_f(a.x) * g.x, silu_f(a.y) * g.y); wv[n].y = pk2(silu_f(a.z) * g.z, silu_f(a.w) * g.w);
                        *(f32x4*)((char*)outs + so) = s1; *(f32x4*)((char*)(outs + DFF) + so) = upv;
                    }
                    *(u32x4*)((char*)Y + (unsigned)((SAMP0 + b) * DFF + chb) * 2u) = (u32x4){wv[0].x, wv[0].y, wv[1].x, wv[1].y};
                }
            }
            asm volatile("" ::: "memory");
        }
    }
};
struct EpiSc {
    static constexpr bool PERM = true, AFTER_DRAIN = false;
    bf16_t* O; const float* rt;
    __device__ __forceinline__ void operator()(const f32x4 (&acc)[2][2][4][2], const pg8::Unit& u, int wr, int wc, int fr, int fq) const {
        const int row0 = u.pm * 256 + wr * 64 + fr;
        const float* rtu = rt + u.idx * 256 + wr * 64 + fr;
        if (u.pn < 4) {
            const int colt = u.pn * 256 + wc * 32 + 8 * fq;
#pragma unroll
            for (int ai = 0; ai < 2; ++ai)
#pragma unroll
                for (int m = 0; m < 4; ++m) {
                    bf16_t* rowp = O + (size_t)(row0 + ai * 128 + m * 16) * (2 * DM) + colt;
                    const float rs = rtu[ai * 128 + m * 16];
#pragma unroll
                    for (int bj = 0; bj < 2; ++bj) {
                        const f32x4 v0 = acc[ai][bj][m][0] * rs, v1 = acc[ai][bj][m][1] * rs;
                        u32x4 w; w.x = pk2(v0.x, v0.y); w.y = pk2(v0.z, v0.w); w.z = pk2(v1.x, v1.y); w.w = pk2(v1.z, v1.w);
                        *(u32x4*)(rowp + bj * 128) = w;
                    }
                }
        } else {
            const int ch0 = DM + 128 * (u.pn - 4) + wc * 32 + 8 * fq;
#pragma unroll
            for (int ai = 0; ai < 2; ++ai)
#pragma unroll
                for (int m = 0; m < 4; ++m) {
                    const float rs = rtu[ai * 128 + m * 16], r2 = rs * rs;
                    const f32x4 v0 = acc[ai][0][m][0] * acc[ai][1][m][0] * r2, v1 = acc[ai][0][m][1] * acc[ai][1][m][1] * r2;
                    u32x4 w; w.x = pk2(v0.x, v0.y); w.y = pk2(v0.z, v0.w); w.z = pk2(v1.x, v1.y); w.w = pk2(v1.z, v1.w);
                    *(u32x4*)(O + (size_t)(row0 + ai * 128 + m * 16) * (2 * DM) + ch0) = w;
                }
        }
    }
};
struct EpiResid {
    static constexpr bool PERM = true, AFTER_DRAIN = false;
    bf16_t* H; float* ssn;
    __device__ __forceinline__ void operator()(const f32x4 (&acc)[2][2][4][2], const pg8::Unit& u, int wr, int wc, int fr, int fq) const {
        const int row0 = u.pm * 256 + wr * 64 + fr, col0 = u.pn * 256 + wc * 32 + 8 * fq;
#pragma unroll
        for (int ai = 0; ai < 2; ++ai) {
            u32x4 xv[4][2];
#pragma unroll
            for (int m = 0; m < 4; ++m) { const bf16_t* rowp = H + (size_t)(row0 + ai * 128 + m * 16) * DM + col0;
#pragma unroll
                for (int bj = 0; bj < 2; ++bj) xv[m][bj] = *(const u32x4*)(rowp + bj * 128); }
#pragma unroll
            for (int m = 0; m < 4; ++m) {
                const int row = row0 + ai * 128 + m * 16;
                bf16_t* hp = H + (size_t)row * DM + col0;
                float sq = 0.f;
#pragma unroll
                for (int bj = 0; bj < 2; ++bj) { const u32x4 xw = xv[m][bj];
                    const f32x4 v0 = (f32x4){bflo(xw.x), bfhi(xw.x), bflo(xw.y), bfhi(xw.y)} + acc[ai][bj][m][0], v1 = (f32x4){bflo(xw.z), bfhi(xw.z), bflo(xw.w), bfhi(xw.w)} + acc[ai][bj][m][1];
                    sq += ((v0.x * v0.x + v0.y * v0.y) + (v0.z * v0.z + v0.w * v0.w)) + ((v1.x * v1.x + v1.y * v1.y) + (v1.z * v1.z + v1.w * v1.w));
                    u32x4 w; w.x = pk2(v0.x, v0.y); w.y = pk2(v0.z, v0.w); w.z = pk2(v1.x, v1.y); w.w = pk2(v1.z, v1.w); *(u32x4*)(hp + bj * 128) = w; }
                sq += __shfl_xor(sq, 16); sq += __shfl_xor(sq, 32);
                if (fq == 0) ssn[(size_t)row * 16 + u.pn * 4 + wc] = sq;
            }
            asm volatile("" ::: "memory");
        }
    }
};
__device__ __forceinline__ void ffnfix_strips(const Params& p, int layer, int s_lo, int s_hi) {
    bf16_t* Y = (bf16_t*)(p.ws + WS_Y); const float* HUF = (const float*)(p.ws + WS_O); const float* HGF = HUF + HALO_N; const float* HUL = HUF + 2 * HALO_N;
    const float* cw = p.in[I_WFC] + (size_t)layer * 3 * DFF; const float* cb = p.in[I_BFC] + (size_t)layer * DFF;
    constexpr int CG = DFF / 8;
    const int total = (s_hi - s_lo) * 2 * CG;
    for (int idx = TIDX; idx < total; idx += 512) {
        const int it = idx / CG, c = (idx - it * CG) * 8;
        const int s_ = s_lo + (it >> 1), i = it & 1, sp = (s_ < 256 && (s_ & 31) == 0) ? 257 : (s_ > 0 ? s_ - 1 : 0);
        float u0[8], u1[8], u2[8], gt[8], w0[8], w1[8], w2[8], bb[8], y[8];
        load8f(HUF + ((size_t)s_ * 2 + i) * DFF + c, u0); load8f(HGF + ((size_t)s_ * 2 + i) * DFF + c, gt);
        if (i == 0) { load8f(HUL + ((size_t)sp * 2 + 1) * DFF + c, u1); load8f(HUL + ((size_t)sp * 2 + 0) * DFF + c, u2); }
        else { load8f(HUF + ((size_t)s_ * 2 + 0) * DFF + c, u1); load8f(HUL + ((size_t)sp * 2 + 1) * DFF + c, u2); }
        load8f(cw + c, w0); load8f(cw + DFF + c, w1); load8f(cw + 2 * DFF + c, w2); load8f(cb + c, bb);
#pragma unroll
        for (int k = 0; k < 8; ++k) { const float a = w0[k] * u2[k] + w1[k] * u1[k] + w2[k] * u0[k] + bb[k]; y[k] = silu_f(a) * gt[k]; }
        *(u32x4*)(Y + (size_t)(64 * s_ + i) * DFF + c) = pack8(y);
    }
}
__device__ __forceinline__ void ffn_state_prompt(const Params& p, int layer, int b) {
    const float* HUL = (const float*)(p.ws + WS_O) + 2 * HALO_N; float* outp = p.out + OUT_FFNP + (size_t)layer * 8 * 2 * DFF;
    for (int idx = TIDX; idx < 2 * (DFF / 8); idx += 512) { const int i = idx / (DFF / 8), c = (idx - i * (DFF / 8)) * 8;
        float v[8]; load8f(HUL + ((size_t)(32 * b + 31) * 2 + i) * DFF + c, v); store8f(outp + ((size_t)b * 2 + i) * DFF + c, v); }
}
__device__ __forceinline__ void wg_arrive(unsigned* cnt) {
    asm volatile("s_waitcnt vmcnt(0)" ::: "memory");
    __syncthreads();
    if (TIDX == 0) { __builtin_amdgcn_fence(__ATOMIC_RELEASE, "agent"); asm volatile("s_waitcnt vmcnt(0)" ::: "memory"); (void)xb_add(cnt, 1u); }
}
__device__ __forceinline__ void poll_ge(unsigned* cnt, unsigned target) {
    unsigned sp = 0u;
    while ((unsigned)__builtin_amdgcn_readfirstlane(xb_ld(cnt)) < target) { __builtin_amdgcn_s_sleep(2); if (++sp > (1u << 16)) break; }
    __builtin_amdgcn_fence(__ATOMIC_ACQUIRE, "agent");
    asm volatile("s_waitcnt vmcnt(0)" ::: "memory");
}
__device__ __forceinline__ void wg_wait(unsigned* cnt, unsigned target) {
    if (TIDX < 64) poll_ge(cnt, target);
    __syncthreads();
}
struct OneUnit {
    int pm, pn;
    __device__ __forceinline__ bool next(int i, pg8::Unit& u) const { if (i != 0) return false; u.pm = pm; u.pn = pn; u.idx = 0; return true; }
    __device__ __forceinline__ void a_ready(const pg8::Unit&) const {}
    __device__ __forceinline__ void done(const pg8::Unit&) const {}
};
struct TailOrder {
    pg8::StaticOrder so; int nmain, nN, c; unsigned* cntB; float* rt; const float* ss;
    __device__ __forceinline__ void init(int N, int c_, unsigned* cntB_, float* rt_, const float* ss_) { so.init(NPR, N, 256, c_); nmain = so.nwg; nN = N / 256; c = c_; cntB = cntB_; rt = rt_; ss = ss_; }
    __device__ __forceinline__ bool next(int i, pg8::Unit& u) const {
        const int total = nmain + nN, jf = total >> 8, rem = total & 255;
        long L;
        if (c >= 252) { L = (long)(i + 2) * 256 + c; if (L >= total) return false; }
        else if (i < jf || (i == jf && c < rem)) L = (long)i * 256 + c;
        else if (i == jf && c < rem + 8) { const int hh = c - rem; L = (long)(hh >> 2) * 256 + 252 + (hh & 3); }
        else return false;
        if (L < nmain) so.at(L, u); else { u.pm = 64; u.pn = (int)(L - nmain); }
        u.idx = i; return true;
    }
    __device__ __forceinline__ void a_ready(const pg8::Unit& u) const {
        if (u.pm == 64) {
            if (TIDX < 64) poll_ge(cntB, 4u);
            asm volatile("" ::: "memory"); __builtin_amdgcn_s_barrier(); asm volatile("" ::: "memory");
            if (TIDX < 256) rt[u.idx * 256 + TIDX] = rstd_of(ss + (size_t)(64 * 256 + TIDX) * 16);
        }
    }
    __device__ __forceinline__ void done(const pg8::Unit&) const {}
};
__device__ __forceinline__ void run_resid_gemm(const Params& p, int fix_layer, LAS unsigned char* lds, const bf16_t* A, const bf16_t* Bt, int K, bf16_t* H, float* ssn, unsigned* cntA, unsigned* cntB) {
    EpiResid E{H, ssn};
    { pg8::Gemm g{A, Bt, NPR, DM, K}; pg8::StaticOrder S; S.init(NPR, DM, (int)gridDim.x, (int)blockIdx.x);
      if (fix_layer >= 0) { pg8::Unit u0; if (S.next(0, u0)) ffnfix_strips(p, fix_layer, 4 * u0.pm, 4 * u0.pm + 4); if ((int)blockIdx.x < 8) ffn_state_prompt(p, fix_layer, (int)blockIdx.x);
                            asm volatile("s_waitcnt vmcnt(0)" ::: "memory"); __syncthreads(); }
      pg8::gemm_phase<EpiResid, pg8::StaticOrder, false, true>(lds, g, S, E); }
    wg_arrive(cntA);
    if ((int)blockIdx.x >= 252) {
        if (fix_layer >= 0) { ffnfix_strips(p, fix_layer, 256, 258); asm volatile("s_waitcnt vmcnt(0)" ::: "memory"); __syncthreads(); }
        pg8::Gemm g{A, Bt, MROWS, DM, K}; OneUnit S1{64, (int)blockIdx.x - 252}; pg8::gemm_phase<EpiResid, OneUnit, false, true>(lds, g, S1, E);
        wg_arrive(cntB);
    }
    wg_wait(cntA, gridDim.x);
}
template <class Epi> __device__ __forceinline__ void run_gemm_tail(LAS unsigned char* lds, const float* ss, unsigned* cntB, const bf16_t* A, const bf16_t* Bt, int N, int K, const Epi& E) {
    float* rt = (float*)((unsigned char*)lds + pg8::STAGE_BYTES);
    pg8::Gemm g{A, Bt, MROWS, N, K}; TailOrder S; S.init(N, (int)blockIdx.x, cntB, rt, ss);
    for (int i = 0;; ++i) { pg8::Unit u; if (!S.next(i, u)) break;
        if (u.pm != 64 && TIDX < 256) rt[i * 256 + TIDX] = rstd_of(ss + (size_t)(u.pm * 256 + TIDX) * 16); }
    __syncthreads();
    pg8::gemm_phase<Epi, TailOrder, true, true>(lds, g, S, E);
}
__device__ __forceinline__ void build_rstd_table(float* rt, const pg8::StaticOrder& S, const float* ss) {
    for (int i = 0;; ++i) { pg8::Unit u; if (!S.next(i, u)) break;
        if (TIDX < 256) rt[i * 256 + TIDX] = rstd_of(ss + (size_t)(u.pm * 256 + TIDX) * 16); }
    __syncthreads();
}
template <class Epi> __device__ __forceinline__ void run_gemm(LAS unsigned char* lds, const float* ss, const bf16_t* A, const bf16_t* Bt, int N, int K, const Epi& E) {
    pg8::Gemm g{A, Bt, MROWS, N, K}; pg8::StaticOrder S; S.init(MROWS, N, (int)gridDim.x, (int)blockIdx.x);
    if (ss) build_rstd_table((float*)((unsigned char*)lds + pg8::STAGE_BYTES), S, ss);
    pg8::gemm_phase<Epi, pg8::StaticOrder, true, true>(lds, g, S, E);
}

template <bool FFN_INTERLEAVE = false, bool SC_INTERLEAVE = false> __device__ __forceinline__ void transpose_item(const float* W, const float* g, int K, int N, bf16_t* WT, float* scr, int item, int lane) {
    const int nblk = N / 32, kb = item / nblk, nb = item - kb * nblk, k0 = 64 * kb, n0 = 32 * nb;
    const int d0 = SC_INTERLEAVE ? (n0 < DM ? n0 : (n0 < 2 * DM ? DM + ((n0 - DM) >> 7) * 256 + ((n0 - DM) & 127) : DM + ((n0 - 2 * DM) >> 7) * 256 + 128 + ((n0 - 2 * DM) & 127))) : !FFN_INTERLEAVE ? n0 : (n0 < DFF ? (n0 >> 7) * 256 + (n0 & 127) : ((n0 - DFF) >> 7) * 256 + 128 + ((n0 - DFF) & 127));
#pragma unroll 8
    for (int i = 0; i < 32; ++i) { const int kk = 2 * i + (lane >> 5); const float gg = g ? g[k0 + kk] : 1.0f; scr[kk * 33 + (lane & 31)] = W[(size_t)(k0 + kk) * N + n0 + (lane & 31)] * gg; }
    asm volatile("s_waitcnt lgkmcnt(0)" ::: "memory");
    const int c = lane & 7;
#pragma unroll
    for (int j = 0; j < 4; ++j) { const int n = (lane >> 3) + 8 * j; const float* s = scr + (8 * c) * 33 + n;
        u32x4 o; o.x = pk2(s[0 * 33], s[1 * 33]); o.y = pk2(s[2 * 33], s[3 * 33]); o.z = pk2(s[4 * 33], s[5 * 33]); o.w = pk2(s[6 * 33], s[7 * 33]);
        *(u32x4*)(WT + (size_t)(d0 + n) * K + k0 + 8 * c) = o; }
    asm volatile("s_waitcnt lgkmcnt(0)" ::: "memory");
}
__device__ __forceinline__ void sincos_d(double r, float& c, float& s) {
    const double r2 = r * r;
    double sc = 1.0, ss = 1.0;
#pragma unroll
    for (int k = 14; k >= 1; --k) { sc = 1.0 - sc * r2 * (1.0 / (double)((2 * k - 1) * (2 * k))); ss = 1.0 - ss * r2 * (1.0 / (double)((2 * k) * (2 * k + 1))); }
    c = (float)sc; s = (float)(ss * r);
}
__device__ __forceinline__ void prep_rows(const Params& p) {
    bf16_t* H = (bf16_t*)(p.ws + WS_H); float* SS = (float*)(p.ws + WS_SS);
    const int lane = TIDX & 63, gw = blockIdx.x * 8 + (TIDX >> 6), NW = gridDim.x * 8;
    for (int row0 = gw; row0 < MROWS; row0 += 4 * NW) {
        f32x4 v[4][4];
#pragma unroll
        for (int k = 0; k < 4; ++k) { const int row = row0 + k * NW;
            const float* src = row >= MROWS ? nullptr : (row < NPR ? p.in[I_XP] + (size_t)row * DM : (row >= SAMP0 ? p.in[I_XS] + (size_t)(row - SAMP0) * DM : (row >= META0 ? p.in[I_META] + (size_t)(row - META0) * DM : nullptr)));
#pragma unroll
            for (int j = 0; j < 4; ++j) v[k][j] = src ? *(const f32x4*)(src + lane * 4 + 256 * j) : (f32x4){0.f, 0.f, 0.f, 0.f}; }
#pragma unroll
        for (int k = 0; k < 4; ++k) { const int row = row0 + k * NW; if (row < MROWS) {
            float ss = 0.f;
#pragma unroll
            for (int j = 0; j < 4; ++j) {
                u32x2 w; w.x = pk2(v[k][j].x, v[k][j].y); w.y = pk2(v[k][j].z, v[k][j].w); *(u32x2*)(H + (size_t)row * DM + lane * 4 + 256 * j) = w;
                ss += (v[k][j].x * v[k][j].x + v[k][j].y * v[k][j].y) + (v[k][j].z * v[k][j].z + v[k][j].w * v[k][j].w); }
            ss = wave_sum(ss);
            if (lane < 16) SS[(size_t)row * 16 + lane] = lane == 0 ? ss : 0.f; } }
    }
}
__device__ __forceinline__ void phase_final(const Params& p, unsigned* cntB) {
    const bf16_t* H = (const bf16_t*)(p.ws + WS_H); const float* SS = (const float*)(p.ws + WS_SS) + (size_t)4 * MROWS * 16; const float* g = p.in[I_NFIN];
    {
        const int S = (int)gridDim.x * 512, idx0 = blockIdx.x * 512 + TIDX, c = (idx0 & 127) * 8;
        float gv[8]; load8f(g + c, gv);
        for (int idx = idx0; idx < NPR * 128; idx += 4 * S) {
            u32x4 hv[4]; f32x4 sa[4][4];
#pragma unroll
            for (int k = 0; k < 4; ++k) { const int row = (idx + k * S) >> 7; if (row < NPR) { hv[k] = *(const u32x4*)(H + (size_t)row * DM + c);
#pragma unroll
                for (int q = 0; q < 4; ++q) sa[k][q] = *(const f32x4*)(SS + (size_t)row * 16 + 4 * q); } }
#pragma unroll
            for (int k = 0; k < 4; ++k) { const int row = (idx + k * S) >> 7; if (row < NPR) {
                const float sum = ((sa[k][0].x + sa[k][0].y) + (sa[k][0].z + sa[k][0].w)) + ((sa[k][1].x + sa[k][1].y) + (sa[k][1].z + sa[k][1].w)) + ((sa[k][2].x + sa[k][2].y) + (sa[k][2].z + sa[k][2].w)) + ((sa[k][3].x + sa[k][3].y) + (sa[k][3].z + sa[k][3].w));
                const float rs = 1.0f / sqrtf(sum * (1.0f / DM) + 1e-6f);
                float v[8]; unpack8(hv[k], v);
#pragma unroll
                for (int j = 0; j < 8; ++j) v[j] = v[j] * rs * gv[j];
                store8f(p.out + OUT_YP + (size_t)row * DM + c, v); } }
        }
    }
    wg_wait(cntB, 4u);
    for (int idx = blockIdx.x * 512 + TIDX; idx < 128 * 128; idx += gridDim.x * 512) {
        const int r = idx >> 7, c = (idx & 127) * 8, row = SAMP0 + r;
        const float rs = rstd_of(SS + (size_t)row * 16);
        float v[8], gv[8]; unpack8(*(const u32x4*)(H + (size_t)row * DM + c), v); load8f(g + c, gv);
#pragma unroll
        for (int k = 0; k < 8; ++k) v[k] = v[k] * rs * gv[k];
        store8f(p.out + OUT_YS + (size_t)r * DM + c, v);
    }
}
template <int SET> __device__ __forceinline__ void transpose_set(const Params& p, unsigned char* shm, int first) {
    const int lane = TIDX & 63, wave = TIDX >> 6;
    if ((int)blockIdx.x < first) return;
    const int gw = ((int)blockIdx.x - first) * 8 + wave, NW = ((int)gridDim.x - first) * 8;
    float* scr = (float*)(shm + wave * 8704);
    constexpr int I0 = 16 * 192, I1 = 32 * 32, I2 = 16 * 96, I3 = 16 * 32, I4 = 16 * 176, I5 = 44 * 32;
    constexpr int NIT = SET == 0 ? I0 : (SET == 1 ? I1 + I4 : (SET == 2 ? I5 + I2 + I3 : I4 + I5));
    for (int it = gw; it < NIT; it += NW) {
        int r = it;
        if (SET == 0) { transpose_item(p.in[I_WRI], p.in[I_NMIX], DM, RIN, (bf16_t*)(p.ws + WS_WRI), scr, r, lane); }
        else if (SET == 1) {
            if (r < I1) { transpose_item(p.in[I_WRO], nullptr, VD, DM, (bf16_t*)(p.ws + WS_WRO), scr, r, lane); continue; } r -= I1;
            transpose_item<true>(p.in[I_WFI], p.in[I_NFFN], DM, 2 * DFF, (bf16_t*)(p.ws + WS_WFI), scr, r, lane);
        } else if (SET == 2) {
            if (r < I5) { transpose_item(p.in[I_WFO], nullptr, DFF, DM, (bf16_t*)(p.ws + WS_WFO), scr, r, lane); continue; } r -= I5;
            if (r < I2) { transpose_item<false, true>(p.in[I_WSI], p.in[I_NMIX] + DM, DM, 3072, (bf16_t*)(p.ws + WS_WSI), scr, r, lane); continue; } r -= I2;
            transpose_item(p.in[I_WSO], nullptr, DM, DM, (bf16_t*)(p.ws + WS_WSO), scr, r, lane);
        } else {
            if (r < I4) { transpose_item<true>(p.in[I_WFI] + (size_t)DM * 2 * DFF, p.in[I_NFFN] + DM, DM, 2 * DFF, (bf16_t*)(p.ws + WS_WFI) + (size_t)2 * DFF * DM, scr, r, lane); continue; } r -= I4;
            transpose_item(p.in[I_WFO] + (size_t)DFF * DM, nullptr, DFF, DM, (bf16_t*)(p.ws + WS_WFO) + (size_t)DM * DFF, scr, r, lane);
        }
    }
}
__device__ __forceinline__ void phase_prep(const Params& p, unsigned char* shm) {
    transpose_set<0>(p, shm, 0);
    float* rope = (float*)(p.ws + WS_ROPE);
    for (int i = blockIdx.x * 512 + TIDX; i < 2065 * 128; i += gridDim.x * 512) {
        const int pi = i >> 7, fi = i & 127; const double pos = pi == 2064 ? 16384.0 : (double)pi;
        const double y = -(double)fi * 0.10462765653188542;
        const double nn = rint(y), f = (y - nn) * 0.6931471805599453;
        double e = 1.0;
#pragma unroll
        for (int k = 18; k >= 1; --k) e = 1.0 + e * f * (1.0 / (double)k);
        const double inv = e / (double)(1 << (int)(-nn));
        const double ang = pos * inv; const double kk = rint(ang * 0.15915494309189535); const double rr = ang - kk * 6.283185307179586;
        float c, s; sincos_d(rr, c, s);
        *(f32x2*)(rope + (size_t)i * 2) = (f32x2){c, s};
    }
    prep_rows(p);
}

#define TR_READ2(r0, r1, base, OFF0, OFF1) asm volatile("ds_read_b64_tr_b16 %0, %2 offset:%3\n\tds_read_b64_tr_b16 %1, %2 offset:%4" : "=&v"(r0), "=&v"(r1) : "v"(base), "i"(OFF0), "i"(OFF1) : "memory")
#define MFMA16(a, b, c) __builtin_amdgcn_mfma_f32_16x16x32_bf16((a), (b), (c), 0, 0, 0)
__device__ __forceinline__ bf16x8 cat4(s16x4 a, s16x4 b) { return __builtin_shufflevector(a, b, 0, 1, 2, 3, 4, 5, 6, 7); }

__device__ __forceinline__ void retention_prompt(const Params& p, unsigned char* shm, int item) {
    const int b = item >> 5, h = (item >> 3) & 3, dvb = item & 7;
    const int tid = TIDX, w = __builtin_amdgcn_readfirstlane(tid >> 6), lane = tid & 63, fr = lane & 15, fq = lane >> 4, tq = (lane & 15) >> 2, tp = lane & 3;
    const bf16_t* PROJ = (const bf16_t*)(p.ws + WS_PROJ); bf16_t* O = (bf16_t*)(p.ws + WS_O); f32x2* STATS = (f32x2*)(p.ws + WS_STATS);
    constexpr int KRS = 528, VRS = 144, OFF_V = 128 * KRS, OFF_VS = OFF_V + 128 * VRS, OFF_ST = OFF_VS + 128 * VRS;
    unsigned char* Kl = shm; unsigned char* Vl = shm + OFF_V; unsigned char* Vs = shm + OFF_VS; unsigned char* Stl = shm + OFF_ST;
    const unsigned lbase = (unsigned)(size_t)shm;
    const float lg2 = h == 0 ? -0.04580368961312479f : (h == 1 ? -0.02272007650008353f : (h == 2 ? -0.011315313227834146f : -0.005646563141142063f));
    const float g128 = __builtin_amdgcn_exp2f(lg2 * 128.0f);
    f32x4 sacc[2][4];
#pragma unroll
    for (int j = 0; j < 2; ++j)
#pragma unroll
        for (int eb = 0; eb < 4; ++eb) sacc[j][eb] = (f32x4){0.f, 0.f, 0.f, 0.f};
    const int nloc = 16 * w + fr;
    const unsigned trV_in = lbase + OFF_V + (4 * fq + tq) * VRS + 8 * tp, trV_up = lbase + OFF_VS + (8 * fq + tq) * VRS + 8 * tp, trK_up = lbase + (8 * fq + tq) * KRS + 64 * w + 8 * tp;
    const unsigned koff = (unsigned)((tid >> 5) * RIN + (tid & 31) * 8) * 2u, voff = (unsigned)((tid >> 3) * RIN + (tid & 7) * 8) * 2u, qoff = (unsigned)(nloc * RIN + fq * 8) * 2u;
    u32x4 kpre[8], vpre[2]; bf16x8 qf[8];
    {
        const char* base = (const char*)(PROJ + (size_t)NPR * RIN);
#pragma unroll
        for (int i = 0; i < 8; ++i) kpre[i] = *(const u32x4*)(base + (size_t)(1024 + h * 256 + i * 16 * RIN) * 2 + koff);
#pragma unroll
        for (int i = 0; i < 2; ++i) vpre[i] = *(const u32x4*)(base + (size_t)(2048 + h * 512 + dvb * 64 + i * 64 * RIN) * 2 + voff);
#pragma unroll
        for (int ks = 0; ks < 8; ++ks) qf[ks] = *(const bf16x8*)(base + (size_t)(h * 256 + ks * 32) * 2 + qoff);
    }
    for (int c = -1; c < 16; ++c) {
        float lg2c = lg2; asm volatile("" : "+v"(lg2c));
        const int rowbase = c < 0 ? NPR : b * 2048 + c * 128;
        const char* nbase = (const char*)(PROJ + (size_t)(b * 2048 + (c + 1) * 128) * RIN);
        __syncthreads();
#pragma unroll
        for (int i = 0; i < 8; ++i) { const int ch = tid + 512 * i, r = ch >> 5, cc = ch & 31; *(u32x4*)(Kl + r * KRS + cc * 16) = kpre[i]; }
#pragma unroll
        for (int i = 0; i < 2; ++i) { const int ch = tid + 512 * i, r = ch >> 3, cc = ch & 7;
            *(u32x4*)(Vl + r * VRS + cc * 16) = vpre[i];
            const float kd = __builtin_amdgcn_exp2f(lg2c * (float)(127 - r));
            float f[8]; unpack8(vpre[i], f);
#pragma unroll
            for (int k = 0; k < 8; ++k) f[k] *= kd;
            *(u32x4*)(Vs + r * VRS + cc * 16) = pack8(f); }
#pragma unroll
        for (int j = 0; j < 2; ++j)
#pragma unroll
            for (int eb = 0; eb < 4; ++eb) { u32x2 wv; wv.x = pk2(sacc[j][eb].x, sacc[j][eb].y); wv.y = pk2(sacc[j][eb].z, sacc[j][eb].w);
                *(u32x2*)(Stl + (16 * eb + fr) * KRS + (16 * (2 * w + j) + 4 * fq) * 2) = wv; }
        if (c < 15) {
#pragma unroll
            for (int i = 0; i < 8; ++i) kpre[i] = *(const u32x4*)(nbase + (size_t)(1024 + h * 256 + i * 16 * RIN) * 2 + koff);
#pragma unroll
            for (int i = 0; i < 2; ++i) vpre[i] = *(const u32x4*)(nbase + (size_t)(2048 + h * 512 + dvb * 64 + i * 64 * RIN) * 2 + voff);
        }
        __syncthreads();
        f32x4 oacc[4];
#pragma unroll
        for (int eb = 0; eb < 4; ++eb) {
            oacc[eb] = (f32x4){0.f, 0.f, 0.f, 0.f};
#pragma unroll
            for (int ks = 0; ks < 8; ++ks) { const bf16x8 sf = *(const bf16x8*)(Stl + (16 * eb + fr) * KRS + (ks * 32 + fq * 8) * 2); oacc[eb] = MFMA16(sf, qf[ks], oacc[eb]); }
        }
        const float cd = __builtin_amdgcn_exp2f(lg2c * (float)(nloc + 1));
#pragma unroll
        for (int eb = 0; eb < 4; ++eb) oacc[eb] = oacc[eb] * cd;
        __builtin_amdgcn_sched_barrier(0);
#pragma unroll
        for (int s = 0; s < 4; ++s) {
            if (2 * s <= w) {
                f32x4 p0 = (f32x4){0.f, 0.f, 0.f, 0.f}, p1 = (f32x4){0.f, 0.f, 0.f, 0.f};
#pragma unroll
                for (int ks = 0; ks < 8; ++ks) {
                    const bf16x8 k0 = *(const bf16x8*)(Kl + (32 * s + fr) * KRS + (ks * 32 + fq * 8) * 2), k1 = *(const bf16x8*)(Kl + (32 * s + 16 + fr) * KRS + (ks * 32 + fq * 8) * 2);
                    p0 = MFMA16(k0, qf[ks], p0); p1 = MFMA16(k1, qf[ks], p1);
                }
                float v[8];
#pragma unroll
                for (int t = 0; t < 4; ++t) { const int d0 = nloc - (32 * s + 4 * fq + t), d1 = d0 - 16;
                    v[t] = d0 >= 0 ? p0[t] * __builtin_amdgcn_exp2f(lg2c * (float)d0) : 0.f;
                    v[4 + t] = d1 >= 0 ? p1[t] * __builtin_amdgcn_exp2f(lg2c * (float)d1) : 0.f; }
                const u32x4 wv = pack8(v); const bf16x8 pf = __builtin_bit_cast(bf16x8, wv);
                s16x4 r[4][2];
#pragma unroll
                for (int eb = 0; eb < 4; ++eb) {
                    TR_READ2(r[eb][0], r[eb][1], trV_in, 32 * s * VRS + 32 * eb, (32 * s + 16) * VRS + 32 * eb);
                }
                asm volatile("s_waitcnt lgkmcnt(0)" : "+v"(r[0][0]), "+v"(r[0][1]), "+v"(r[1][0]), "+v"(r[1][1]), "+v"(r[2][0]), "+v"(r[2][1]), "+v"(r[3][0]), "+v"(r[3][1]) :: "memory");
#pragma unroll
                for (int eb = 0; eb < 4; ++eb) oacc[eb] = MFMA16(cat4(r[eb][0], r[eb][1]), pf, oacc[eb]);
            }
            __builtin_amdgcn_sched_barrier(0);
        }
        asm volatile("" ::: "memory");
        if (c < 15) {
#pragma unroll
            for (int ks = 0; ks < 8; ++ks) qf[ks] = *(const bf16x8*)(nbase + (size_t)(h * 256 + ks * 32) * 2 + qoff);
        }
        if (c >= 0 || b == 0) {
            float s1 = 0.f, s2 = 0.f;
#pragma unroll
            for (int eb = 0; eb < 4; ++eb) {
                const f32x4 o = oacc[eb];
                s1 += (o.x + o.y) + (o.z + o.w); s2 += (o.x * o.x + o.y * o.y) + (o.z * o.z + o.w * o.w);
                u32x2 wv; wv.x = pk2(o.x, o.y); wv.y = pk2(o.z, o.w);
                *(u32x2*)(O + (size_t)(rowbase + nloc) * VD + h * 512 + dvb * 64 + 16 * eb + 4 * fq) = wv;
            }
            s1 += __shfl_xor(s1, 16); s1 += __shfl_xor(s1, 32); s2 += __shfl_xor(s2, 16); s2 += __shfl_xor(s2, 32);
            if (fq == 0) STATS[((size_t)(rowbase + nloc) * 4 + h) * 8 + dvb] = (f32x2){s1, s2};
        }
#pragma unroll
        for (int j = 0; j < 2; ++j)
#pragma unroll
            for (int eb = 0; eb < 4; ++eb) sacc[j][eb] = sacc[j][eb] * g128;
        {
            s16x4 kr[2][2][2], vr[2][4][2];
#define UPD_ISSUE(bf, s_) do { _Pragma("unroll") for (int j = 0; j < 2; ++j) TR_READ2(kr[bf][j][0], kr[bf][j][1], trK_up, 32 * (s_) * KRS + 32 * j, (32 * (s_) + 4) * KRS + 32 * j); \
                               _Pragma("unroll") for (int eb = 0; eb < 4; ++eb) TR_READ2(vr[bf][eb][0], vr[bf][eb][1], trV_up, 32 * (s_) * VRS + 32 * eb, (32 * (s_) + 4) * VRS + 32 * eb); } while (0)
            UPD_ISSUE(0, 0);
#pragma unroll
            for (int s = 0; s < 4; ++s) {
                const int cb_ = s & 1;
                asm volatile("s_waitcnt lgkmcnt(0)" : "+v"(kr[cb_][0][0]), "+v"(kr[cb_][0][1]), "+v"(kr[cb_][1][0]), "+v"(kr[cb_][1][1]), "+v"(vr[cb_][0][0]), "+v"(vr[cb_][0][1]), "+v"(vr[cb_][1][0]), "+v"(vr[cb_][1][1]), "+v"(vr[cb_][2][0]), "+v"(vr[cb_][2][1]), "+v"(vr[cb_][3][0]), "+v"(vr[cb_][3][1]) :: "memory");
                if (s < 3) UPD_ISSUE(cb_ ^ 1, s + 1);
#pragma unroll
                for (int j = 0; j < 2; ++j)
#pragma unroll
                    for (int eb = 0; eb < 4; ++eb) sacc[j][eb] = MFMA16(cat4(kr[cb_][j][0], kr[cb_][j][1]), cat4(vr[cb_][eb][0], vr[cb_][eb][1]), sacc[j][eb]);
                __builtin_amdgcn_sched_barrier(0);
            }
#undef UPD_ISSUE
        }
    }
    float* RP = p.out + OUT_RETP + (size_t)(b * 4 + h) * 256 * 512;
#pragma unroll
    for (int j = 0; j < 2; ++j)
#pragma unroll
        for (int eb = 0; eb < 4; ++eb) {
            const int d0 = 16 * (2 * w + j) + 4 * fq, e = dvb * 64 + 16 * eb + fr;
            RP[(size_t)(d0 + 0) * 512 + e] = sacc[j][eb].x; RP[(size_t)(d0 + 1) * 512 + e] = sacc[j][eb].y; RP[(size_t)(d0 + 2) * 512 + e] = sacc[j][eb].z; RP[(size_t)(d0 + 3) * 512 + e] = sacc[j][eb].w;
        }
}
__device__ __forceinline__ void retention_sample(const Params& p, unsigned char* shm, int item) {
    const int b = item >> 2, h = item & 3, row = SAMP0 + b, tid = TIDX, lane = tid & 63, w = tid >> 6;
    const bf16_t* PROJ = (const bf16_t*)(p.ws + WS_PROJ); bf16_t* O = (bf16_t*)(p.ws + WS_O); f32x2* STATS = (f32x2*)(p.ws + WS_STATS);
    float* qs = (float*)shm; float* ks = qs + 256; float* red = ks + 256; float* opart = red + 32;
    const float gamma = 1.0f - (h == 0 ? 0.03125f : (h == 1 ? 0.015625f : (h == 2 ? 0.0078125f : 0.00390625f)));
    const bf16_t* prow = PROJ + (size_t)row * RIN;
    __syncthreads();
    if (tid < 256) {
        const float q = __uint_as_float((unsigned)prow[h * 256 + tid] << 16), k = __uint_as_float((unsigned)prow[1024 + h * 256 + tid] << 16);
        qs[tid] = q; ks[tid] = k;
        const float pr = wave_sum(q * k);
        if (lane == 0) red[w] = pr;
    }
    __syncthreads();
    const float qk = (red[0] + red[1]) + (red[2] + red[3]);
    const int e4 = (tid & 127) * 4, dsub = tid >> 7;
    const u32x2 vw = *(const u32x2*)(prow + 2048 + h * 512 + e4);
    const f32x4 v4 = (f32x4){bflo(vw.x), bfhi(vw.x), bflo(vw.y), bfhi(vw.y)};
    const float* Sp = p.in[I_SRET] + (size_t)(b * 4 + h) * 256 * 512 + e4;
    float* Sn = p.out + OUT_RETS + (size_t)(b * 4 + h) * 256 * 512 + e4;
    f32x4 oa = (f32x4){0.f, 0.f, 0.f, 0.f};
    f32x4 cur[16], nxt[16];
#pragma unroll
    for (int j = 0; j < 16; ++j) cur[j] = __builtin_nontemporal_load((const f32x4*)(Sp + (size_t)(dsub + 4 * j) * 512));
#pragma unroll
    for (int bt = 0; bt < 4; ++bt) {
        if (bt < 3) {
#pragma unroll
            for (int j = 0; j < 16; ++j) nxt[j] = __builtin_nontemporal_load((const f32x4*)(Sp + (size_t)(dsub + 4 * (16 * (bt + 1) + j)) * 512));
        }
#pragma unroll
        for (int j = 0; j < 16; ++j) {
            const int d = dsub + 4 * (16 * bt + j);
            const float qd = qs[d], kd = ks[d];
            oa = oa + cur[j] * qd;
            const f32x4 sn = cur[j] * gamma + v4 * kd;
            __builtin_nontemporal_store(sn, (f32x4*)(Sn + (size_t)d * 512));
        }
#pragma unroll
        for (int j = 0; j < 16; ++j) cur[j] = nxt[j];
    }
    *(f32x4*)(opart + dsub * 512 + e4) = oa;
    __syncthreads();
    const float ve = __uint_as_float((unsigned)prow[2048 + h * 512 + tid] << 16);
    const float o = gamma * ((opart[tid] + opart[512 + tid]) + (opart[1024 + tid] + opart[1536 + tid])) + qk * ve;
    O[(size_t)row * VD + h * 512 + tid] = (bf16_t)(pk2(o, 0.f) & 0xffffu);
    const float s1 = wave_sum(o), s2 = wave_sum(o * o);
    if (lane == 0) { red[8 + w] = s1; red[16 + w] = s2; }
    __syncthreads();
    if (tid < 8) {
        float a = 0.f, c = 0.f;
        if (tid == 0) {
#pragma unroll
            for (int i = 0; i < 8; ++i) { a += red[8 + i]; c += red[16 + i]; }
        }
        STATS[((size_t)row * 4 + h) * 8 + tid] = (f32x2){a, c};
    }
}
__device__ __forceinline__ void phase_retention(const Params& p, unsigned char* shm) {
    const bool stream_first = ((blockIdx.x >> 3) & 1) != 0;
    if (stream_first) { for (int item = blockIdx.x; item < 512; item += gridDim.x) retention_sample(p, shm, item); }
    __syncthreads();
    for (int item = blockIdx.x; item < 256; item += gridDim.x) retention_prompt(p, shm, item);
    __syncthreads();
    if (!stream_first) { for (int item = blockIdx.x; item < 512; item += gridDim.x) retention_sample(p, shm, item); }
}
__device__ __forceinline__ void phase_gatenorm(const Params& p) {
    const bf16_t* PROJ = (const bf16_t*)(p.ws + WS_PROJ); const bf16_t* O = (const bf16_t*)(p.ws + WS_O); const float* STATS = (const float*)(p.ws + WS_STATS); bf16_t* Y = (bf16_t*)(p.ws + WS_Y0);
    const int lane = TIDX & 63, gw = blockIdx.x * 8 + (TIDX >> 6), NW = gridDim.x * 8;
    for (int it0 = gw * 4; it0 < MROWS * 4; it0 += NW * 4) {
        u32x4 ow[4], gwv[4]; f32x4 sa[4], sb[4], sc[4], sd[4];
#pragma unroll
        for (int q = 0; q < 4; ++q) { const int it = it0 + q, row = it >> 2, h = it & 3; const float* st = STATS + (size_t)it * 16;
            sa[q] = *(const f32x4*)st; sb[q] = *(const f32x4*)(st + 4); sc[q] = *(const f32x4*)(st + 8); sd[q] = *(const f32x4*)(st + 12);
            ow[q] = *(const u32x4*)(O + (size_t)row * VD + h * 512 + lane * 8); gwv[q] = *(const u32x4*)(PROJ + (size_t)row * RIN + 4096 + h * 512 + lane * 8); }
#pragma unroll
        for (int q = 0; q < 4; ++q) { const int it = it0 + q, row = it >> 2, h = it & 3;
            const float s1 = (sa[q].x + sa[q].z) + (sb[q].x + sb[q].z) + (sc[q].x + sc[q].z) + (sd[q].x + sd[q].z), s2 = (sa[q].y + sa[q].w) + (sb[q].y + sb[q].w) + (sc[q].y + sc[q].w) + (sd[q].y + sd[q].w);
            const float mu = s1 * (1.0f / 512.0f); float var = s2 * (1.0f / 512.0f) - mu * mu; var = var > 0.f ? var : 0.f;
            const float rstd = 1.0f / sqrtf(var + 1e-6f);
            float of[8], gf[8], y[8]; unpack8(ow[q], of); unpack8(gwv[q], gf);
#pragma unroll
            for (int k = 0; k < 8; ++k) y[k] = gf[k] * ((of[k] - mu) * rstd);
            *(u32x4*)(Y + (size_t)row * VD + h * 512 + lane * 8) = pack8(y); }
    }
}
__device__ __forceinline__ void prev_rows(int row, int& p1, int& p2) {
    if (row < NPR) { const int t = row & 2047; p1 = t >= 1 ? row - 1 : SAMP0 - 1; p2 = t >= 2 ? row - 2 : (t == 1 ? SAMP0 - 1 : SAMP0 - 2); }
    else { p1 = row - 1; p2 = row - 2; }
}
__device__ __forceinline__ void seg_rows(int seg, int& r0, int& h1, int& h2) {
    if (seg < 2048) { r0 = seg * 8; if ((r0 & 2047) == 0) { h1 = SAMP0 - 1; h2 = SAMP0 - 2; } else { h1 = r0 - 1; h2 = r0 - 2; } }
    else { r0 = META0 + (seg - 2048) * 8; if (seg == 2048) { h1 = -1; h2 = -1; } else { h1 = r0 - 1; h2 = r0 - 2; } }
}
constexpr int NSEG = 2050;
__device__ __forceinline__ void phase_scconv(const Params& p) {
    const bf16_t* SC = (const bf16_t*)(p.ws + WS_PROJ); bf16_t* Y = (bf16_t*)(p.ws + WS_Y0);
    const float* cw = p.in[I_WSC]; const float* sin_ = p.in[I_SCONV];
    float* outp = p.out + OUT_CONVP; float* outs = p.out + OUT_CONVS;
    constexpr int CG = DM / 8, LD = 2 * DM;
    const int total = (NSEG + 128) * CG;
    for (int idx = blockIdx.x * 512 + TIDX; idx < total; idx += gridDim.x * 512) {
        const int seg = idx / CG, c = (idx - seg * CG) * 8;
        float w0[8], w1[8], w2[8], u1[8], u2[8];
        load8f(cw + c, w0); load8f(cw + DM + c, w1); load8f(cw + 2 * DM + c, w2);
        if (seg >= NSEG) {
            const int b = seg - NSEG, row = SAMP0 + b; float u0[8], bg[8], y[8];
            unpack8(*(const u32x4*)(SC + (size_t)row * LD + c), bg); unpack8(*(const u32x4*)(SC + (size_t)row * LD + DM + c), u0);
            load8f(sin_ + ((size_t)b * 2 + 1) * DM + c, u1); load8f(sin_ + ((size_t)b * 2 + 0) * DM + c, u2);
            store8f(outs + ((size_t)b * 2 + 0) * DM + c, u1); store8f(outs + ((size_t)b * 2 + 1) * DM + c, u0);
#pragma unroll
            for (int k = 0; k < 8; ++k) y[k] = bg[k] * (w0[k] * u2[k] + w1[k] * u1[k] + w2[k] * u0[k]);
            *(u32x4*)(Y + (size_t)row * DM + c) = pack8(y);
            continue;
        }
        int r0, h1, h2; seg_rows(seg, r0, h1, h2);
        u32x4 bw[8], uw[8];
#pragma unroll
        for (int i = 0; i < 8; ++i) { bw[i] = *(const u32x4*)(SC + (size_t)(r0 + i) * LD + c); uw[i] = *(const u32x4*)(SC + (size_t)(r0 + i) * LD + DM + c); }
        if (h1 >= 0) { unpack8(*(const u32x4*)(SC + (size_t)h1 * LD + DM + c), u1); unpack8(*(const u32x4*)(SC + (size_t)h2 * LD + DM + c), u2); }
        else {
#pragma unroll
            for (int k = 0; k < 8; ++k) { u1[k] = 0.f; u2[k] = 0.f; } }
#pragma unroll
        for (int i = 0; i < 8; ++i) {
            float u0[8], bg[8], y[8]; unpack8(bw[i], bg); unpack8(uw[i], u0);
#pragma unroll
            for (int k = 0; k < 8; ++k) { y[k] = bg[k] * (w0[k] * u2[k] + w1[k] * u1[k] + w2[k] * u0[k]); u2[k] = u1[k]; u1[k] = u0[k]; }
            *(u32x4*)(Y + (size_t)(r0 + i) * DM + c) = pack8(y);
            if (i >= 6 && seg < 2048 && (seg & 255) == 255) store8f(outp + ((size_t)(seg >> 8) * 2 + (i - 6)) * DM + c, u0);
        }
    }
}

constexpr int NPH = 15;
__global__ __launch_bounds__(512, 2) void fwd_megakernel(Params p) {
    extern __shared__ __attribute__((aligned(16))) unsigned char shm[];
    LAS unsigned char* lds = (LAS unsigned char*)shm;
    cg::grid_group grid = cg::this_grid();
    const bf16_t* H = (const bf16_t*)(p.ws + WS_H); const bf16_t* Y = (const bf16_t*)(p.ws + WS_Y);
    bf16_t* PROJ = (bf16_t*)(p.ws + WS_PROJ);
#define PH_BEGIN(k) if (p.ph_lo <= (k) && (k) < p.ph_hi) {
#define PH_END(k) if ((k) + 1 < p.ph_hi) xcd_barrier(xb); }
    float* SS = (float*)(p.ws + WS_SS); bf16_t* Hw = (bf16_t*)(p.ws + WS_H);
    volatile LAS unsigned* xst = (volatile LAS unsigned*)(lds + LDS_BYTES - 16);
    if (TIDX == 0) { xst[0] = 0u; xst[1] = 0u; }
    __syncthreads();
    const XcdBarrier xb = xcd_barrier_post((unsigned*)(p.ws + WS_BAR), xst);
    if (p.ph_hi < 0) grid.sync();
    unsigned* HC = (unsigned*)(p.ws + WS_BAR) + 3520;
    const bf16_t* Y0 = (const bf16_t*)(p.ws + WS_Y0);
#define PH_NOBAR(k) }
    PH_BEGIN(0) phase_prep(p, shm); PH_END(0)
    PH_BEGIN(1) { EpiRetIn E{PROJ, (const float*)(p.ws + WS_ROPE), (const float*)(shm + pg8::STAGE_BYTES)}; run_gemm(lds, SS, H, (const bf16_t*)(p.ws + WS_WRI), RIN, DM, E);
                  transpose_set<1>(p, shm, 24); transpose_set<2>(p, shm, 24); transpose_set<3>(p, shm, 24); } PH_END(1)
    PH_BEGIN(2) phase_retention(p, shm); PH_END(2)
    PH_BEGIN(3) phase_gatenorm(p); PH_END(3)
    PH_BEGIN(4) run_resid_gemm(p, -1, lds, Y0, (const bf16_t*)(p.ws + WS_WRO), VD, Hw, SS + (size_t)MROWS * 16, HC, HC + 64); PH_NOBAR(4)
    PH_BEGIN(5) { EpiFfn E{(bf16_t*)(p.ws + WS_Y), (const float*)(shm + pg8::STAGE_BYTES), (float*)(p.ws + WS_O), p.in[I_WFC], p.in[I_BFC], p.in[I_SFFN], p.out + OUT_FFNS}; run_gemm_tail(lds, SS + (size_t)MROWS * 16, HC + 64, H, (const bf16_t*)(p.ws + WS_WFI), 2 * DFF, DM, E); } PH_END(5)
    PH_BEGIN(7) run_resid_gemm(p, 0, lds, Y, (const bf16_t*)(p.ws + WS_WFO), DFF, Hw, SS + (size_t)2 * MROWS * 16, HC + 128, HC + 192); PH_NOBAR(7)
    PH_BEGIN(8) { EpiSc E{PROJ, (const float*)(shm + pg8::STAGE_BYTES)}; run_gemm_tail(lds, SS + (size_t)2 * MROWS * 16, HC + 192, H, (const bf16_t*)(p.ws + WS_WSI), 3 * DM, DM, E); } PH_END(8)
    PH_BEGIN(9) phase_scconv(p); PH_END(9)
    PH_BEGIN(10) run_resid_gemm(p, -1, lds, Y0, (const bf16_t*)(p.ws + WS_WSO), DM, Hw, SS + (size_t)3 * MROWS * 16, HC + 256, HC + 320); PH_NOBAR(10)
    PH_BEGIN(11) { EpiFfn E{(bf16_t*)(p.ws + WS_Y), (const float*)(shm + pg8::STAGE_BYTES), (float*)(p.ws + WS_O), p.in[I_WFC] + 3 * DFF, p.in[I_BFC] + DFF, p.in[I_SFFN] + (size_t)128 * 2 * DFF, p.out + OUT_FFNS + (size_t)128 * 2 * DFF}; run_gemm_tail(lds, SS + (size_t)3 * MROWS * 16, HC + 320, H, (const bf16_t*)(p.ws + WS_WFI) + (size_t)2 * DFF * DM, 2 * DFF, DM, E); } PH_END(11)
    PH_BEGIN(13) run_resid_gemm(p, 1, lds, Y, (const bf16_t*)(p.ws + WS_WFO) + (size_t)DM * DFF, DFF, Hw, SS + (size_t)4 * MROWS * 16, HC + 384, HC + 448); PH_NOBAR(13)
    PH_BEGIN(14) phase_final(p, HC + 448); PH_END(14)
}

extern "C" void kernel_launch(void* const* d_in, const int* in_sizes, int n_in, void* d_out, int out_size, void* d_ws, size_t ws_size, hipStream_t stream) {
    static int grid = 0;
    if (grid == 0) {
        if (n_in != 18 || ws_size < WS_END) { fprintf(stderr, "kernel_launch: unexpected n_in %d or ws_size %zu (< %zu)\n", n_in, ws_size, (size_t)WS_END); grid = -1; return; }
        int dev = 0, cus = 0, per_cu = 0;
        hipGetDevice(&dev); hipDeviceGetAttribute(&cus, hipDeviceAttributeMultiprocessorCount, dev);
        if (hipFuncSetAttribute((const void*)fwd_megakernel, hipFuncAttributeMaxDynamicSharedMemorySize, LDS_BYTES) != hipSuccess) fprintf(stderr, "kernel_launch: hipFuncSetAttribute failed\n");
        if (hipOccupancyMaxActiveBlocksPerMultiprocessor(&per_cu, (const void*)fwd_megakernel, 512, LDS_BYTES) != hipSuccess || per_cu < 1) { fprintf(stderr, "kernel_launch: occupancy query gave %d\n", per_cu); per_cu = 1; }
        (void)hipGetLastError();
        if (cus != 256) fprintf(stderr, "kernel_launch: note: %d CUs reported; the phase schedule is built for 256 workgroups (one per CU)\n", cus);
        grid = 256;
    }
    if (grid < 0) return;
    if (hipMemsetAsync((char*)d_ws + WS_BAR, 0, 16384, stream) != hipSuccess) fprintf(stderr, "kernel_launch: memset of barrier words failed\n");
    Params p{};
    for (int i = 0; i < 18; ++i) p.in[i] = (const float*)d_in[i];
    p.out = (float*)d_out; p.ws = (unsigned char*)d_ws; p.ph_lo = 0; p.ph_hi = NPH;
#if defined(MK_MULTI)
    for (int ph = 0; ph < NPH; ++ph) { p.ph_lo = ph; p.ph_hi = ph + 1; hipLaunchKernelGGL(fwd_megakernel, dim3(grid), dim3(512), LDS_BYTES, stream, p); }
#else
    void* args[] = {&p};
    hipError_t e = hipLaunchCooperativeKernel((const void*)fwd_megakernel, dim3(grid), dim3(512), args, LDS_BYTES, stream);
    if (e != hipSuccess) fprintf(stderr, "cooperative launch failed: %s (grid %d)\n", hipGetErrorString(e), grid);
#endif
}
```

```cpp
#include <hip/hip_runtime.h>
#include <hip/hip_cooperative_groups.h>
#include <cstdio>
#include <cstdint>
namespace cg = cooperative_groups;
__device__ __forceinline__ int launder_tid() { int t = (int)threadIdx.x; asm volatile("" : "+v"(t)); return t; }
#define TIDX launder_tid()

namespace pg8 {
#define PG8_LAS __attribute__((address_space(3)))
typedef unsigned short bf16_t;
typedef short bf16x8 __attribute__((ext_vector_type(8)));
typedef float f32x4 __attribute__((ext_vector_type(4)));
typedef unsigned u32x4 __attribute__((ext_vector_type(4)));
constexpr int BM = 256, BK = 64, HALF = 128, HTB = HALF * BK * 2  , STAGE_BYTES = 8 * HTB, NXCD = 8, WGM = 8;

__host__ __device__ __forceinline__ int lds_byte(int r, int c) { const int st = (r >> 4) * 2 + (c >> 5), rr = r & 15, cc = c & 31, ob = rr * 64 + cc * 2; return st * 1024 + (ob ^ (((ob >> 9) & 1) << 5)); }
__host__ __device__ __forceinline__ void stage_rc(int b, int& R, int& C) { const int st = b / 1024, sb = b % 1024, swz = sb ^ (((sb >> 9) & 1) << 5); R = (st >> 1) * 16 + swz / 64; C = (st & 1) * 32 + (swz % 64) / 2; }
__host__ __device__ __forceinline__ int perm32(int rho) { const int n = rho >> 4, i = rho & 15; return 8 * (i >> 2) + 4 * n + (i & 3); }

struct Unit { int pm, pn, idx; };
struct Gemm { const bf16_t* A; const bf16_t* Bt; int M, N, K; };

struct StaticOrder {
    int nM, nN, nwg, G, c;
    __host__ __device__ void init(int M, int N, int G_, int c_) { nM = M / BM; nN = N / BM; nwg = nM * nN; G = G_; c = c_; }
    __host__ __device__ bool next(int i, Unit& u) const {
        const long L = (long)i * G + c; if (L >= nwg) return false;
        int wgid = (int)L; { const int q = nwg / NXCD, r = nwg % NXCD, xcd = wgid % NXCD, off = wgid / NXCD; wgid = (xcd < r ? xcd * (q + 1) : r * (q + 1) + (xcd - r) * q) + off; }
        const int nig = WGM * nN, gid = wgid / nig, fm = gid * WGM, gsz = (nM - fm) < WGM ? (nM - fm) : WGM;
        u.pm = fm + ((wgid % nig) % gsz); u.pn = (wgid % nig) / gsz; u.idx = i; return true;
    }
    __host__ __device__ bool at(long L, Unit& u) const {
        if (L >= nwg) return false;
        int wgid = (int)L; { const int q = nwg / NXCD, r = nwg % NXCD, xcd = wgid % NXCD, off = wgid / NXCD; wgid = (xcd < r ? xcd * (q + 1) : r * (q + 1) + (xcd - r) * q) + off; }
        const int nig = WGM * nN, gid = wgid / nig, fm = gid * WGM, gsz = (nM - fm) < WGM ? (nM - fm) : WGM;
        u.pm = fm + ((wgid % nig) % gsz); u.pn = (wgid % nig) / gsz; return true;
    }
    __device__ __forceinline__ void a_ready(const Unit&) const {}
    __device__ __forceinline__ void done(const Unit&) const {}
};
__device__ __forceinline__ unsigned cvt_pk_bf16(float lo, float hi) { unsigned r; asm volatile("v_cvt_pk_bf16_f32 %0, %1, %2" : "=v"(r) : "v"(lo), "v"(hi)); return r; }

template <class Epi, class Sched, bool ALIGN_EPI = false, bool SP2 = false>
__device__ __forceinline__ void gemm_phase(PG8_LAS unsigned char* lds, const Gemm g, const Sched& S, const Epi& E) {
    const int tid = TIDX, wid = __builtin_amdgcn_readfirstlane(tid >> 6), lane = tid & 63, wr = wid >> 2, wc = wid & 3, fr = lane & 15, fq = lane >> 4;
    const int K = g.K, nt = K / BK;
    unsigned voffA[2], voffB[2];
#pragma unroll
    for (int i = 0; i < 2; ++i) { int R, C; stage_rc(tid * 16 + i * 8192, R, C); const int Rb = Epi::PERM ? ((R & ~31) + perm32(R & 31)) : R;
        voffA[i] = (unsigned)(R * K + C) * 2u; voffB[i] = (unsigned)(Rb * K + C) * 2u; }
    const size_t kstep = (size_t)(BK * 2);
    const size_t hstep = (size_t)HALF * K * 2;
    const size_t tstep = 2 * hstep;
    const unsigned ldsw = (unsigned)wid * 1024u;
    const int aoff = lds_byte(wr * 64 + fr, fq * 8), boff = lds_byte(wc * 32 + fr, fq * 8);
#define PG8_SA(b, h) (((b) * 2 + (h)) * HTB)
#define PG8_SB(b, h) ((4 + (b) * 2 + (h)) * HTB)
#define PG8_STAGE(bufoff, gbase, voff) do { _Pragma("unroll") for (int _i = 0; _i < 2; ++_i) \
        __builtin_amdgcn_global_load_lds((const unsigned*)((const char*)(gbase) + (voff)[_i]), (PG8_LAS unsigned*)(lds + (bufoff) + ldsw + _i * 8192), 16, 0, 0); } while (0)
#define PG8_LDA(dst, b, h) do { _Pragma("unroll") for (int m = 0; m < 4; ++m) _Pragma("unroll") for (int k = 0; k < 2; ++k) dst[m][k] = *(const PG8_LAS bf16x8*)(lds + PG8_SA(b, h) + aoff + m * 2048 + k * 1024); } while (0)
#define PG8_LDB(dst, b, h) do { _Pragma("unroll") for (int n = 0; n < 2; ++n) _Pragma("unroll") for (int k = 0; k < 2; ++k) dst[n][k] = *(const PG8_LAS bf16x8*)(lds + PG8_SB(b, h) + boff + n * 2048 + k * 1024); } while (0)
#define PG8_MMA(ai, bj, At, Bt) do { __builtin_amdgcn_s_setprio(1); _Pragma("unroll") for (int m = 0; m < 4; ++m) _Pragma("unroll") for (int n = 0; n < 2; ++n) _Pragma("unroll") for (int k = 0; k < 2; ++k) \
        acc[ai][bj][m][n] = __builtin_amdgcn_mfma_f32_16x16x32_bf16(Bt[n][k], At[m][k], acc[ai][bj][m][n], 0, 0, 0); __builtin_amdgcn_s_setprio(0); } while (0)
#define PG8_WAIT_V(n) asm volatile("s_waitcnt vmcnt(" #n ")" ::: "memory")
#define PG8_WAIT_L(n) asm volatile("s_waitcnt lgkmcnt(" #n ")" ::: "memory")
#define PG8_BAR __builtin_amdgcn_s_barrier()
#define PG8_SCHED __builtin_amdgcn_sched_barrier(0)
    Unit cur, nxt; int ui = 0;
    if (!S.next(0, cur)) return;
    f32x4 acc[2][2][4][2];
#pragma unroll
    for (int a = 0; a < 2; ++a)
#pragma unroll
        for (int b = 0; b < 2; ++b)
#pragma unroll
            for (int m = 0; m < 4; ++m)
#pragma unroll
                for (int n = 0; n < 2; ++n) acc[a][b][m][n] = (f32x4){0.f, 0.f, 0.f, 0.f};
    bf16x8 At[4][2], B0[2][2], B1[2][2];
    const char* cA = (const char*)g.A + (size_t)cur.pm * tstep; const char* cB = (const char*)g.Bt + (size_t)cur.pn * tstep;
    S.a_ready(cur);
    if constexpr (SP2) {
        PG8_STAGE(PG8_SB(0, 0), cB, voffB); PG8_STAGE(PG8_SB(0, 1), cB + hstep, voffB); PG8_STAGE(PG8_SA(0, 0), cA, voffA); PG8_STAGE(PG8_SA(0, 1), cA + hstep, voffA);
        if (wr == 1) PG8_BAR;
        PG8_WAIT_V(2); PG8_BAR;
        PG8_STAGE(PG8_SB(1, 0), cB + kstep, voffB); PG8_STAGE(PG8_SA(1, 0), cA + kstep, voffA); PG8_STAGE(PG8_SB(1, 1), cB + hstep + kstep, voffB);
        PG8_WAIT_V(6); PG8_BAR;
    } else {
        PG8_STAGE(PG8_SB(0, 0), cB, voffB); PG8_STAGE(PG8_SA(0, 0), cA, voffA); PG8_STAGE(PG8_SB(0, 1), cB + hstep, voffB); PG8_STAGE(PG8_SA(0, 1), cA + hstep, voffA);
        if (wr == 1) PG8_BAR;
        PG8_WAIT_V(4); PG8_BAR;
        PG8_STAGE(PG8_SB(1, 0), cB + kstep, voffB); PG8_STAGE(PG8_SA(1, 0), cA + kstep, voffA); PG8_STAGE(PG8_SB(1, 1), cB + hstep + kstep, voffB);
        PG8_WAIT_V(6); PG8_BAR;
    }
    for (;;) {
        const bool has_next = S.next(ui + 1, nxt);
        const char* nA = has_next ? (const char*)g.A + (size_t)nxt.pm * tstep : cA; const char* nB = has_next ? (const char*)g.Bt + (size_t)nxt.pn * tstep : cB;
        for (int t = 0; t < nt; t += 2) {
            const bool last = (t == nt - 2);
            const char* a1 = cA + (size_t)(t + 1) * kstep;
            const char* a2 = last ? nA : cA + (size_t)(t + 2) * kstep; const char* b2 = last ? nB : cB + (size_t)(t + 2) * kstep;
            const char* a3 = a2 + kstep; const char* b3 = b2 + kstep;
            if (last && has_next) S.a_ready(nxt);
            if constexpr (SP2) {
            PG8_LDB(B0, 0, 0); PG8_LDB(B1, 0, 1); PG8_SCHED; PG8_LDA(At, 0, 0); PG8_STAGE(PG8_SA(1, 1), a1 + hstep, voffA);
            PG8_WAIT_V(8); PG8_WAIT_L(0); PG8_BAR; PG8_MMA(0, 0, At, B0); PG8_MMA(0, 1, At, B1); PG8_BAR; PG8_SCHED;
            PG8_LDA(At, 0, 1); PG8_STAGE(PG8_SB(0, 0), b2, voffB); PG8_STAGE(PG8_SB(0, 1), b2 + hstep, voffB); PG8_STAGE(PG8_SA(0, 0), a2, voffA);
            PG8_WAIT_V(8); PG8_WAIT_L(0); PG8_BAR; PG8_MMA(1, 0, At, B0); PG8_MMA(1, 1, At, B1); PG8_BAR; PG8_SCHED;
            PG8_LDB(B0, 1, 0); PG8_LDB(B1, 1, 1); PG8_SCHED; PG8_LDA(At, 1, 0); PG8_STAGE(PG8_SA(0, 1), a2 + hstep, voffA);
            PG8_WAIT_V(8); PG8_WAIT_L(0); PG8_BAR; PG8_MMA(0, 0, At, B0); PG8_MMA(0, 1, At, B1); PG8_BAR; PG8_SCHED;
            PG8_LDA(At, 1, 1); PG8_STAGE(PG8_SB(1, 0), b3, voffB); PG8_STAGE(PG8_SB(1, 1), b3 + hstep, voffB); PG8_STAGE(PG8_SA(1, 0), a3, voffA);
            PG8_WAIT_V(8); PG8_WAIT_L(0); PG8_BAR; PG8_MMA(1, 0, At, B0); PG8_MMA(1, 1, At, B1); PG8_BAR; PG8_SCHED;
            } else {
            PG8_LDB(B0, 0, 0); PG8_SCHED; PG8_LDA(At, 0, 0); PG8_STAGE(PG8_SA(1, 1), a1 + hstep, voffA);
            PG8_WAIT_L(8); PG8_BAR; PG8_WAIT_L(0); PG8_MMA(0, 0, At, B0); PG8_BAR; PG8_SCHED;
            PG8_LDB(B1, 0, 1); PG8_STAGE(PG8_SB(0, 0), b2, voffB);
            PG8_BAR; PG8_WAIT_L(0); PG8_MMA(0, 1, At, B1); PG8_BAR;
            PG8_LDA(At, 0, 1); PG8_STAGE(PG8_SA(0, 0), a2, voffA);
            PG8_BAR; PG8_WAIT_L(0); PG8_MMA(1, 0, At, B0); PG8_BAR; PG8_SCHED;
            PG8_STAGE(PG8_SB(0, 1), b2 + hstep, voffB);
            PG8_WAIT_V(6); PG8_BAR; PG8_MMA(1, 1, At, B1); PG8_BAR;
            PG8_LDB(B0, 1, 0); PG8_SCHED; PG8_LDA(At, 1, 0); PG8_STAGE(PG8_SA(0, 1), a2 + hstep, voffA);
            PG8_WAIT_L(8); PG8_BAR; PG8_WAIT_L(0); PG8_MMA(0, 0, At, B0); PG8_BAR; PG8_SCHED;
            PG8_LDB(B1, 1, 1); PG8_STAGE(PG8_SB(1, 0), b3, voffB);
            PG8_BAR; PG8_WAIT_L(0); PG8_MMA(0, 1, At, B1); PG8_BAR;
            PG8_LDA(At, 1, 1); PG8_STAGE(PG8_SA(1, 0), a3, voffA);
            PG8_BAR; PG8_WAIT_L(0); PG8_MMA(1, 0, At, B0); PG8_BAR; PG8_SCHED;
            PG8_STAGE(PG8_SB(1, 1), b3 + hstep, voffB);
            PG8_WAIT_V(6); PG8_BAR; PG8_MMA(1, 1, At, B1); PG8_BAR;
            }
        }
        if constexpr (ALIGN_EPI) { if (wr == 0) PG8_BAR; }
        if constexpr (!Epi::AFTER_DRAIN) { E(acc, cur, wr, wc, fr, fq); S.done(cur); }
        if (!has_next) break;
#pragma unroll
        for (int a = 0; a < 2; ++a)
#pragma unroll
            for (int b = 0; b < 2; ++b)
#pragma unroll
                for (int m = 0; m < 4; ++m)
#pragma unroll
                    for (int n = 0; n < 2; ++n) acc[a][b][m][n] = (f32x4){0.f, 0.f, 0.f, 0.f};
        cur = nxt; cA = nA; cB = nB; ++ui;
        if constexpr (ALIGN_EPI) { if (wr == 1) PG8_BAR; }
    }
    PG8_WAIT_V(0);
    if constexpr (!ALIGN_EPI) { if (wr == 0) PG8_BAR; }
    PG8_BAR;
    if constexpr (Epi::AFTER_DRAIN) { E.fused(acc, cur, wr, wc, fr, fq, lds, wid, lane); S.done(cur); }
#undef PG8_SA
#undef PG8_SB
#undef PG8_STAGE
#undef PG8_LDA
#undef PG8_LDB
#undef PG8_MMA
#undef PG8_WAIT_V
#undef PG8_WAIT_L
#undef PG8_BAR
#undef PG8_SCHED
}
}

#define LAS __attribute__((address_space(3)))
typedef unsigned short bf16_t;
typedef short bf16x8 __attribute__((ext_vector_type(8)));
typedef short s16x4 __attribute__((ext_vector_type(4)));
typedef float f32x4 __attribute__((ext_vector_type(4)));
typedef float f32x2 __attribute__((ext_vector_type(2)));
typedef unsigned u32x4 __attribute__((ext_vector_type(4)));
typedef unsigned u32x2 __attribute__((ext_vector_type(2)));

constexpr int DM = 1024, MROWS = 16640, NPR = 16384, META0 = 16496, SAMP0 = 16512, DFF = 2816, RIN = 6144, VD = 2048;
constexpr int LDS_BYTES = 143360;
constexpr size_t OUT_YP = 0, OUT_YS = 16777216, OUT_RETP = 16908288, OUT_RETS = 21102592, OUT_CONVP = 88211456, OUT_CONVS = 88227840, OUT_FFNP = 88489984, OUT_FFNS = 88580096;
constexpr size_t WS_X = 0;
constexpr size_t WS_H = WS_X + (size_t)MROWS * DM * 4;
constexpr size_t WS_PROJ = WS_H + (size_t)MROWS * DM * 2;
constexpr size_t WS_O = WS_PROJ + (size_t)MROWS * RIN * 2;
constexpr size_t HALO_N = (size_t)260 * 2 * DFF;
constexpr size_t WS_Y = WS_O + (size_t)MROWS * VD * 2;
constexpr size_t WS_Y0 = WS_Y + (size_t)MROWS * DFF * 2;
constexpr size_t WS_STATS = WS_Y0 + (size_t)MROWS * VD * 2;
constexpr size_t WS_SS = WS_STATS + (size_t)MROWS * 32 * 8;
constexpr size_t WS_ROPE = WS_SS + (size_t)5 * MROWS * 16 * 4;
constexpr size_t WS_WRI = WS_ROPE + (size_t)2065 * 128 * 8;
constexpr size_t WS_WRO = WS_WRI + (size_t)RIN * DM * 2;
constexpr size_t WS_WSI = WS_WRO + (size_t)DM * VD * 2;
constexpr size_t WS_WSO = WS_WSI + (size_t)3072 * DM * 2;
constexpr size_t WS_WFI = WS_WSO + (size_t)DM * DM * 2;
constexpr size_t WS_WFO = WS_WFI + (size_t)2 * 2 * DFF * DM * 2;
constexpr size_t WS_BAR = WS_WFO + (size_t)2 * DM * DFF * 2;
constexpr size_t WS_END = WS_BAR + 16384;

struct Params {
    const float* in[18];
    float* out;
    unsigned char* ws;
    int ph_lo, ph_hi;
};
enum { I_XP = 0, I_XS, I_SRET, I_SCONV, I_SFFN, I_META, I_NMIX, I_NFFN, I_NFIN, I_WRI, I_WRO, I_WSI, I_WSC, I_WSO, I_WFI, I_WFC, I_BFC, I_WFO };

__device__ __forceinline__ float bflo(unsigned w) { return __uint_as_float(w << 16); }
__device__ __forceinline__ float bfhi(unsigned w) { return __uint_as_float(w & 0xffff0000u); }
__device__ __forceinline__ unsigned pk2(float lo, float hi) { unsigned r; asm("v_cvt_pk_bf16_f32 %0, %1, %2" : "=v"(r) : "v"(lo), "v"(hi)); return r; }
__device__ __forceinline__ float silu_f(float x) { return x * __builtin_amdgcn_rcpf(1.0f + __expf(-x)); }
__device__ __forceinline__ float wave_sum(float v) {
#pragma unroll
    for (int o = 1; o < 64; o <<= 1) v += __shfl_xor(v, o);
    return v;
}
__device__ __forceinline__ float rstd_of(const float* p16) {
    const f32x4 a = *(const f32x4*)p16, b = *(const f32x4*)(p16 + 4), c = *(const f32x4*)(p16 + 8), d = *(const f32x4*)(p16 + 12);
    const float ss = ((a.x + a.y) + (a.z + a.w)) + ((b.x + b.y) + (b.z + b.w)) + ((c.x + c.y) + (c.z + c.w)) + ((d.x + d.y) + (d.z + d.w));
    return 1.0f / sqrtf(ss * (1.0f / DM) + 1e-6f); }
__device__ __forceinline__ int pos_index(int row) { if (row < NPR) return 16 + (row & 2047); if (row < SAMP0) { const int j = row - META0; return j < 0 ? 0 : j; } return 2064; }
__device__ __forceinline__ void unpack8(const u32x4 w, float (&f)[8]) { f[0] = bflo(w.x); f[1] = bfhi(w.x); f[2] = bflo(w.y); f[3] = bfhi(w.y); f[4] = bflo(w.z); f[5] = bfhi(w.z); f[6] = bflo(w.w); f[7] = bfhi(w.w); }
__device__ __forceinline__ u32x4 pack8(const float (&f)[8]) { u32x4 w; w.x = pk2(f[0], f[1]); w.y = pk2(f[2], f[3]); w.z = pk2(f[4], f[5]); w.w = pk2(f[6], f[7]); return w; }
__device__ __forceinline__ void load8f(const float* p, float (&f)[8]) { const f32x4 a = *(const f32x4*)p, b = *(const f32x4*)(p + 4); f[0] = a.x; f[1] = a.y; f[2] = a.z; f[3] = a.w; f[4] = b.x; f[5] = b.y; f[6] = b.z; f[7] = b.w; }
__device__ __forceinline__ void store8f(float* p, const float (&f)[8]) { *(f32x4*)p = (f32x4){f[0], f[1], f[2], f[3]}; *(f32x4*)(p + 4) = (f32x4){f[4], f[5], f[6], f[7]}; }

#define XB_TMO      128
#define XB_XCNT(j)  (256  + 64 * (j))
#define XB_XSUB(j)  (1280 + 64 * (j))
#define XB_XGEN(j)  (2304 + 64 * (j))
#define XB_TOP      3328
#define XB_TOPGEN   3392
#define XCD_BAR_WORDS 3456
#define XB_SPIN_CAP (1u << 18)

__device__ __forceinline__ unsigned xb_ld(unsigned* p)              { return __hip_atomic_load(p, __ATOMIC_RELAXED, __HIP_MEMORY_SCOPE_AGENT); }
__device__ __forceinline__ unsigned xb_add(unsigned* p, unsigned v) { return __hip_atomic_fetch_add(p, v, __ATOMIC_RELAXED, __HIP_MEMORY_SCOPE_AGENT); }
__device__ __forceinline__ unsigned xb_xcc_id() { return (unsigned)__builtin_amdgcn_s_getreg((3 << 11) | 20) & 0xFu; }
#define XB_SPIN(cond, bar) do { unsigned _sp = 0; while (cond) { __builtin_amdgcn_s_sleep(1); \
    if ((++_sp & 255u) == 0u) { if (xb_ld(&(bar)[XB_TMO])) break; if (_sp > XB_SPIN_CAP) { atomicAdd(&(bar)[XB_TMO], 1u); break; } } } } while (0)

struct XcdBarrier {
    unsigned* bar; unsigned x;
    volatile LAS unsigned* st;
};

__device__ __forceinline__ XcdBarrier xcd_barrier_post(unsigned* bar, volatile LAS unsigned* st) {
    XcdBarrier b; b.bar = bar; b.x = xb_xcc_id(); b.st = st;
    if (TIDX == 0) (void)xb_add(&bar[XB_XCNT(b.x)], 1u);
    return b;
}
__device__ __forceinline__ void xcd_barrier_complete(unsigned* bar, unsigned x, unsigned& nloc, unsigned& nx) {
    const unsigned G = gridDim.x * gridDim.y * gridDim.z;
    unsigned sum, cnt, mine, sp = 0u;
    for (;;) {
        sum = 0u; cnt = 0u; mine = 0u;
#pragma unroll
        for (unsigned j = 0; j < 16; ++j) { const unsigned c = xb_ld(&bar[XB_XCNT(j)]); sum += c; cnt += (c > 0u) ? 1u : 0u; mine = (j == x) ? c : mine; }
        if (sum == G) break;
        __builtin_amdgcn_s_sleep(1);
        if ((++sp & 255u) == 0u) { if (xb_ld(&bar[XB_TMO])) break; if (sp > XB_SPIN_CAP) { atomicAdd(&bar[XB_TMO], 1u); break; } }
    }
    nloc = mine > 0u ? mine : 1u; nx = cnt > 0u ? cnt : 1u;
}

__device__ __forceinline__ void xcd_barrier(const XcdBarrier& b) {
    asm volatile("s_waitcnt vmcnt(0)" ::: "memory");
    __syncthreads();
    if (TIDX == 0) {
        unsigned* bar = b.bar;
        __builtin_amdgcn_s_waitcnt(0);
        unsigned nloc = b.st[0], nx = b.st[1];
        if (nloc == 0u) { xcd_barrier_complete(bar, b.x, nloc, nx); b.st[0] = nloc; b.st[1] = nx; }
        const unsigned old = xb_add(&bar[XB_XSUB(b.x)], 1u);
        const unsigned gen = old / nloc;
        if (old + 1u == (gen + 1u) * nloc) {
            __builtin_amdgcn_fence(__ATOMIC_RELEASE, "agent");
            asm volatile("s_waitcnt vmcnt(0)" ::: "memory");
            const unsigned og = xb_add(&bar[XB_TOP], 1u);
            const unsigned tg = og / nx;
            if (og + 1u == (tg + 1u) * nx) xb_add(&bar[XB_TOPGEN], 1u);
            else XB_SPIN(xb_ld(&bar[XB_TOPGEN]) == tg, bar);
            __builtin_amdgcn_fence(__ATOMIC_ACQUIRE, "agent");
            xb_add(&bar[XB_XGEN(b.x)], 1u);
            asm volatile("s_waitcnt vmcnt(0)" ::: "memory");
        } else {
            XB_SPIN(xb_ld(&bar[XB_XGEN(b.x)]) == gen, bar);
            __builtin_amdgcn_fence(__ATOMIC_ACQUIRE, "agent");
            asm volatile("s_waitcnt vmcnt(0)" ::: "memory");
        }
    }
    __syncthreads();
}

struct EpiRetIn {
    static constexpr bool PERM = true, AFTER_DRAIN = false;
    bf16_t* O; const float* rope; const float* rt;
    __device__ __forceinline__ void operator()(const f32x4 (&acc)[2][2][4][2], const pg8::Unit& u, int wr, int wc, int fr, int fq) const {
        const int row0 = u.pm * 256 + wr * 64 + fr, colt = u.pn * 256 + wc * 32 + 8 * fq;
        const int kind = u.pn < 4 ? 0 : (u.pn < 8 ? 1 : (u.pn < 16 ? 2 : 3));
        const float* rtu = rt + u.idx * 256 + wr * 64 + fr;
#pragma unroll
        for (int ai = 0; ai < 2; ++ai) {
            float rs[4];
#pragma unroll
            for (int m = 0; m < 4; ++m) rs[m] = rtu[ai * 128 + m * 16];
            if (kind <= 1) {
                f32x4 cs[4][2][2];
#pragma unroll
                for (int m = 0; m < 4; ++m) { const float* rp = rope + ((size_t)pos_index(row0 + ai * 128 + m * 16) * 128 + wc * 16 + 4 * fq) * 2;
#pragma unroll
                    for (int bj = 0; bj < 2; ++bj) { cs[m][bj][0] = *(const f32x4*)(rp + bj * 128); cs[m][bj][1] = *(const f32x4*)(rp + bj * 128 + 4); } }
#pragma unroll
                for (int m = 0; m < 4; ++m) {
                    bf16_t* rowp = O + (size_t)(row0 + ai * 128 + m * 16) * RIN + colt;
                    const float sc = kind == 1 ? 0.0625f * rs[m] : rs[m];
#pragma unroll
                    for (int bj = 0; bj < 2; ++bj) {
                        const f32x4 c0 = cs[m][bj][0], c1 = cs[m][bj][1];
                        const f32x4 v0 = acc[ai][bj][m][0] * sc, v1 = acc[ai][bj][m][1] * sc;
                        u32x4 w;
                        w.x = pk2(v0.x * c0.x - v0.y * c0.y, v0.x * c0.y + v0.y * c0.x);
                        w.y = pk2(v0.z * c0.z - v0.w * c0.w, v0.z * c0.w + v0.w * c0.z);
                        w.z = pk2(v1.x * c1.x - v1.y * c1.y, v1.x * c1.y + v1.y * c1.x);
                        w.w = pk2(v1.z * c1.z - v1.w * c1.w, v1.z * c1.w + v1.w * c1.z);
                        *(u32x4*)(rowp + bj * 128) = w;
                    }
                }
            } else {
#pragma unroll
                for (int m = 0; m < 4; ++m) {
                    bf16_t* rowp = O + (size_t)(row0 + ai * 128 + m * 16) * RIN + colt;
#pragma unroll
                    for (int bj = 0; bj < 2; ++bj) {
                        f32x4 v0 = acc[ai][bj][m][0] * rs[m], v1 = acc[ai][bj][m][1] * rs[m];
                        u32x4 w; w.x = pk2(v0.x, v0.y); w.y = pk2(v0.z, v0.w); w.z = pk2(v1.x, v1.y); w.w = pk2(v1.z, v1.w);
                        *(u32x4*)(rowp + bj * 128) = w;
                    }
                }
            }
        }
    }
};
struct EpiBf16 {
    static constexpr bool PERM = true, AFTER_DRAIN = false;
    bf16_t* O; int ldc; const float* rt;
    __device__ __forceinline__ void operator()(const f32x4 (&acc)[2][2][4][2], const pg8::Unit& u, int wr, int wc, int fr, int fq) const {
        const int row0 = u.pm * 256 + wr * 64 + fr, colt = u.pn * 256 + wc * 32 + 8 * fq;
#pragma unroll
        for (int ai = 0; ai < 2; ++ai)
#pragma unroll
            for (int m = 0; m < 4; ++m) {
                bf16_t* rowp = O + (size_t)(row0 + ai * 128 + m * 16) * ldc + colt;
                const float rs = rt[u.idx * 256 + ai * 128 + wr * 64 + m * 16 + fr];
#pragma unroll
                for (int bj = 0; bj < 2; ++bj) {
                    const f32x4 v0 = acc[ai][bj][m][0] * rs, v1 = acc[ai][bj][m][1] * rs;
                    u32x4 w; w.x = pk2(v0.x, v0.y); w.y = pk2(v0.z, v0.w); w.z = pk2(v1.x, v1.y); w.w = pk2(v1.z, v1.w);
                    *(u32x4*)(rowp + bj * 128) = w;
                }
            }
    }
};
struct EpiFfn {
    static constexpr bool PERM = true, AFTER_DRAIN = false;
    bf16_t* Y; const float* rt; float* halo; const float* cw; const float* cb; const float* sin_; float* outs;
    __device__ __forceinline__ void operator()(const f32x4 (&acc)[2][2][4][2], const pg8::Unit& u, int wr, int wc, int fr, int fq) const {
        const int src1 = (fq << 4) | ((fr + 15) & 15), src2 = (fq << 4) | ((fr + 14) & 15);
        const int chb = 128 * u.pn + 32 * wc + 8 * fq;
        const float* rtu = rt + u.idx * 256 + wr * 64 + fr;
        f32x4 cwv[2][4];
#pragma unroll
        for (int n = 0; n < 2; ++n) { const unsigned cho = (unsigned)(chb + 4 * n) * 4u;
            cwv[n][0] = *(const f32x4*)((const char*)cw + cho); cwv[n][1] = *(const f32x4*)((const char*)(cw + DFF) + cho); cwv[n][2] = *(const f32x4*)((const char*)(cw + 2 * DFF) + cho); cwv[n][3] = *(const f32x4*)((const char*)cb + cho); }
#pragma unroll
        for (int ai = 0; ai < 2; ++ai) {
            float rs[4];
#pragma unroll
            for (int m = 0; m < 4; ++m) rs[m] = rtu[ai * 128 + m * 16];
            const bool sample = (u.pm == 64) && (ai == 1);
            const int row0 = u.pm * 256 + ai * 128 + wr * 64 + fr, strip = (u.pm * 256 + ai * 128 + wr * 64) >> 6;
            if (!sample) {
                f32x4 q1[2], q2[2];
#pragma unroll
                for (int n = 0; n < 2; ++n) { q1[n] = (f32x4){0.f, 0.f, 0.f, 0.f}; q2[n] = q1[n]; }
#pragma unroll
                for (int m = 0; m < 4; ++m) {
                    u32x2 wv[2];
#pragma unroll
                    for (int n = 0; n < 2; ++n) {
                        const int ch = chb + 4 * n;
                        const f32x4 up = acc[ai][0][m][n] * rs[m];
                        f32x4 a1, a2, p1, p2;
#pragma unroll
                        for (int t = 0; t < 4; ++t) { a1[t] = __shfl(up[t], src1); a2[t] = __shfl(up[t], src2); p1[t] = fr >= 1 ? a1[t] : q1[n][t]; p2[t] = fr >= 2 ? a2[t] : q2[n][t]; }
                        q1[n] = a1; q2[n] = a2;
                        const f32x4 g = acc[ai][1][m][n] * rs[m];
                        const f32x4 a = cwv[n][0] * p2 + cwv[n][1] * p1 + cwv[n][2] * up + cwv[n][3];
                        wv[n].x = pk2(silu_f(a.x) * g.x, silu_f(a.y) * g.y); wv[n].y = pk2(silu_f(a.z) * g.z, silu_f(a.w) * g.w);
                        if (m == 0 && fr < 2) { const unsigned ho = (unsigned)((strip * 2 + fr) * DFF + ch) * 4u; *(f32x4*)((char*)halo + ho) = up; *(f32x4*)((char*)(halo + HALO_N) + ho) = g; }
                        if (m == 3 && fr >= 14) *(f32x4*)((char*)(halo + 2 * HALO_N) + (unsigned)((strip * 2 + (fr - 14)) * DFF + ch) * 4u) = up;
                    }
                    if (m > 0 || fr >= 2) *(u32x4*)((char*)Y + (unsigned)((row0 + m * 16) * DFF + chb) * 2u) = (u32x4){wv[0].x, wv[0].y, wv[1].x, wv[1].y};
                }
            } else {
#pragma unroll
                for (int m = 0; m < 4; ++m) {
                    const int b = wr * 64 + m * 16 + fr;
                    u32x2 wv[2];
#pragma unroll
                    for (int n = 0; n < 2; ++n) {
                        const int ch = chb + 4 * n;
                        const f32x4 upv = acc[ai][0][m][n] * rs[m], g = acc[ai][1][m][n] * rs[m];
                        const unsigned so = (unsigned)(b * 2 * DFF + ch) * 4u;
                        const f32x4 s0 = *(const f32x4*)((const char*)sin_ + so), s1 = *(const f32x4*)((const char*)(sin_ + DFF) + so);
                        const f32x4 a = cwv[n][0] * s0 + cwv[n][1] * s1 + cwv[n][2] * upv + cwv[n][3];
                        wv[n].x = pk2(silu_f(a.x) * g.x, silu_f(a.y) * g.y); wv[n].y = pk2(silu_f(a.z) * g.z, silu_f(a.w) * g.w);
                        *(f32x4*)((char*)outs + so) = s1; *(f32x4*)((char*)(outs + DFF) + so) = upv;
                    }
                    *(u32x4*)((char*)Y + (unsigned)((SAMP0 + b) * DFF + chb) * 2u) = (u32x4){wv[0].x, wv[0].y, wv[1].x, wv[1].y};
                }
            }
            asm volatile("" ::: "memory");
        }
    }
};
struct EpiSc {
    static constexpr bool PERM = true, AFTER_DRAIN = false;
    bf16_t* O; const float* rt;
    __device__ __forceinline__ void operator()(const f32x4 (&acc)[2][2][4][2], const pg8::Unit& u, int wr, int wc, int fr, int fq) const {
        const int row0 = u.pm * 256 + wr * 64 + fr;
        const float* rtu = rt + u.idx * 256 + wr * 64 + fr;
        if (u.pn < 4) {
            const int colt = u.pn * 256 + wc * 32 + 8 * fq;
#pragma unroll
            for (int ai = 0; ai < 2; ++ai)
#pragma unroll
                for (int m = 0; m < 4; ++m) {
                    bf16_t* rowp = O + (size_t)(row0 + ai * 128 + m * 16) * (2 * DM) + colt;
                    const float rs = rtu[ai * 128 + m * 16];
#pragma unroll
                    for (int bj = 0; bj < 2; ++bj) {
                        const f32x4 v0 = acc[ai][bj][m][0] * rs, v1 = acc[ai][bj][m][1] * rs;
                        u32x4 w; w.x = pk2(v0.x, v0.y); w.y = pk2(v0.z, v0.w); w.z = pk2(v1.x, v1.y); w.w = pk2(v1.z, v1.w);
                        *(u32x4*)(rowp + bj * 128) = w;
                    }
                }
        } else {
            const int ch0 = DM + 128 * (u.pn - 4) + wc * 32 + 8 * fq;
#pragma unroll
            for (int ai = 0; ai < 2; ++ai)
#pragma unroll
                for (int m = 0; m < 4; ++m) {
                    const float rs = rtu[ai * 128 + m * 16], r2 = rs * rs;
                    const f32x4 v0 = acc[ai][0][m][0] * acc[ai][1][m][0] * r2, v1 = acc[ai][0][m][1] * acc[ai][1][m][1] * r2;
                    u32x4 w; w.x = pk2(v0.x, v0.y); w.y = pk2(v0.z, v0.w); w.z = pk2(v1.x, v1.y); w.w = pk2(v1.z, v1.w);
                    *(u32x4*)(O + (size_t)(row0 + ai * 128 + m * 16) * (2 * DM) + ch0) = w;
                }
        }
    }
};
struct EpiResid {
    static constexpr bool PERM = true, AFTER_DRAIN = false;
    bf16_t* H; float* ssn;
    __device__ __forceinline__ void operator()(const f32x4 (&acc)[2][2][4][2], const pg8::Unit& u, int wr, int wc, int fr, int fq) const {
        const int row0 = u.pm * 256 + wr * 64 + fr, col0 = u.pn * 256 + wc * 32 + 8 * fq;
#pragma unroll
        for (int ai = 0; ai < 2; ++ai) {
            u32x4 xv[4][2];
#pragma unroll
            for (int m = 0; m < 4; ++m) { const bf16_t* rowp = H + (size_t)(row0 + ai * 128 + m * 16) * DM + col0;
#pragma unroll
                for (int bj = 0; bj < 2; ++bj) xv[m][bj] = *(const u32x4*)(rowp + bj * 128); }
#pragma unroll
            for (int m = 0; m < 4; ++m) {
                const int row = row0 + ai * 128 + m * 16;
                bf16_t* hp = H + (size_t)row * DM + col0;
                float sq = 0.f;
#pragma unroll
                for (int bj = 0; bj < 2; ++bj) { const u32x4 xw = xv[m][bj];
                    const f32x4 v0 = (f32x4){bflo(xw.x), bfhi(xw.x), bflo(xw.y), bfhi(xw.y)} + acc[ai][bj][m][0], v1 = (f32x4){bflo(xw.z), bfhi(xw.z), bflo(xw.w), bfhi(xw.w)} + acc[ai][bj][m][1];
                    sq += ((v0.x * v0.x + v0.y * v0.y) + (v0.z * v0.z + v0.w * v0.w)) + ((v1.x * v1.x + v1.y * v1.y) + (v1.z * v1.z + v1.w * v1.w));
                    u32x4 w; w.x = pk2(v0.x, v0.y); w.y = pk2(v0.z, v0.w); w.z = pk2(v1.x, v1.y); w.w = pk2(v1.z, v1.w); *(u32x4*)(hp + bj * 128) = w; }
                sq += __shfl_xor(sq, 16); sq += __shfl_xor(sq, 32);
                if (fq == 0) ssn[(size_t)row * 16 + u.pn * 4 + wc] = sq;
            }
            asm volatile("" ::: "memory");
        }
    }
};
__device__ __forceinline__ void ffnfix_strips(const Params& p, int layer, int s_lo, int s_hi) {
    bf16_t* Y = (bf16_t*)(p.ws + WS_Y); const float* HUF = (const float*)(p.ws + WS_O); const float* HGF = HUF + HALO_N; const float* HUL = HUF + 2 * HALO_N;
    const float* cw = p.in[I_WFC] + (size_t)layer * 3 * DFF; const float* cb = p.in[I_BFC] + (size_t)layer * DFF;
    constexpr int CG = DFF / 8;
    const int total = (s_hi - s_lo) * 2 * CG;
    for (int idx = TIDX; idx < total; idx += 512) {
        const int it = idx / CG, c = (idx - it * CG) * 8;
        const int s_ = s_lo + (it >> 1), i = it & 1, sp = (s_ < 256 && (s_ & 31) == 0) ? 257 : (s_ > 0 ? s_ - 1 : 0);
        float u0[8], u1[8], u2[8], gt[8], w0[8], w1[8], w2[8], bb[8], y[8];
        load8f(HUF + ((size_t)s_ * 2 + i) * DFF + c, u0); load8f(HGF + ((size_t)s_ * 2 + i) * DFF + c, gt);
        if (i == 0) { load8f(HUL + ((size_t)sp * 2 + 1) * DFF + c, u1); load8f(HUL + ((size_t)sp * 2 + 0) * DFF + c, u2); }
        else { load8f(HUF + ((size_t)s_ * 2 + 0) * DFF + c, u1); load8f(HUL + ((size_t)sp * 2 + 1) * DFF + c, u2); }
        load8f(cw + c, w0); load8f(cw + DFF + c, w1); load8f(cw + 2 * DFF + c, w2); load8f(cb + c, bb);
#pragma unroll
        for (int k = 0; k < 8; ++k) { const float a = w0[k] * u2[k] + w1[k] * u1[k] + w2[k] * u0[k] + bb[k]; y[k] = silu_f(a) * gt[k]; }
        *(u32x4*)(Y + (size_t)(64 * s_ + i) * DFF + c) = pack8(y);
    }
}
__device__ __forceinline__ void ffn_state_prompt(const Params& p, int layer, int b) {
    const float* HUL = (const float*)(p.ws + WS_O) + 2 * HALO_N; float* outp = p.out + OUT_FFNP + (size_t)layer * 8 * 2 * DFF;
    for (int idx = TIDX; idx < 2 * (DFF / 8); idx += 512) { const int i = idx / (DFF / 8), c = (idx - i * (DFF / 8)) * 8;
        float v[8]; load8f(HUL + ((size_t)(32 * b + 31) * 2 + i) * DFF + c, v); store8f(outp + ((size_t)b * 2 + i) * DFF + c, v); }
}
__device__ __forceinline__ void wg_arrive(unsigned* cnt) {
    asm volatile("s_waitcnt vmcnt(0)" ::: "memory");
    __syncthreads();
    if (TIDX == 0) { __builtin_amdgcn_fence(__ATOMIC_RELEASE, "agent"); asm volatile("s_waitcnt vmcnt(0)" ::: "memory"); (void)xb_add(cnt, 1u); }
}
__device__ __forceinline__ void poll_ge(unsigned* cnt, unsigned target) {
    unsigned sp = 0u;
    while ((unsigned)__builtin_amdgcn_readfirstlane(xb_ld(cnt)) < target) { __builtin_amdgcn_s_sleep(2); if (++sp > (1u << 16)) break; }
    __builtin_amdgcn_fence(__ATOMIC_ACQUIRE, "agent");
    asm volatile("s_waitcnt vmcnt(0)" ::: "memory");
}
__device__ __forceinline__ void wg_wait(unsigned* cnt, unsigned target) {
    if (TIDX < 64) poll_ge(cnt, target);
    __syncthreads();
}
struct OneUnit {
    int pm, pn;
    __device__ __forceinline__ bool next(int i, pg8::Unit& u) const { if (i != 0) return false; u.pm = pm; u.pn = pn; u.idx = 0; return true; }
    __device__ __forceinline__ void a_ready(const pg8::Unit&) const {}
    __device__ __forceinline__ void done(const pg8::Unit&) const {}
};
struct TailOrder {
    pg8::StaticOrder so; int nmain, nN, c; unsigned* cntB; float* rt; const float* ss;
    __device__ __forceinline__ void init(int N, int c_, unsigned* cntB_, float* rt_, const float* ss_) { so.init(NPR, N, 256, c_); nmain = so.nwg; nN = N / 256; c = c_; cntB = cntB_; rt = rt_; ss = ss_; }
    __device__ __forceinline__ bool next(int i, pg8::Unit& u) const {
        const int total = nmain + nN, jf = total >> 8, rem = total & 255;
        long L;
        if (c >= 252) { L = (long)(i + 2) * 256 + c; if (L >= total) return false; }
        else if (i < jf || (i == jf && c < rem)) L = (long)i * 256 + c;
        else if (i == jf && c < rem + 8) { const int hh = c - rem; L = (long)(hh >> 2) * 256 + 252 + (hh & 3); }
        else return false;
        if (L < nmain) so.at(L, u); else { u.pm = 64; u.pn = (int)(L - nmain); }
        u.idx = i; return true;
    }
    __device__ __forceinline__ void a_ready(const pg8::Unit& u) const {
        if (u.pm == 64) {
            if (TIDX < 64) poll_ge(cntB, 4u);
            asm volatile("" ::: "memory"); __builtin_amdgcn_s_barrier(); asm volatile("" ::: "memory");
            if (TIDX < 256) rt[u.idx * 256 + TIDX] = rstd_of(ss + (size_t)(64 * 256 + TIDX) * 16);
        }
    }
    __device__ __forceinline__ void done(const pg8::Unit&) const {}
};
__device__ __forceinline__ void run_resid_gemm(const Params& p, int fix_layer, LAS unsigned char* lds, const bf16_t* A, const bf16_t* Bt, int K, bf16_t* H, float* ssn, unsigned* cntA, unsigned* cntB) {
    EpiResid E{H, ssn};
    { pg8::Gemm g{A, Bt, NPR, DM, K}; pg8::StaticOrder S; S.init(NPR, DM, (int)gridDim.x, (int)blockIdx.x);
      if (fix_layer >= 0) { pg8::Unit u0; if (S.next(0, u0)) ffnfix_strips(p, fix_layer, 4 * u0.pm, 4 * u0.pm + 4); if ((int)blockIdx.x < 8) ffn_state_prompt(p, fix_layer, (int)blockIdx.x);
                            asm volatile("s_waitcnt vmcnt(0)" ::: "memory"); __syncthreads(); }
      pg8::gemm_phase<EpiResid, pg8::StaticOrder, false, true>(lds, g, S, E); }
    wg_arrive(cntA);
    if ((int)blockIdx.x >= 252) {
        if (fix_layer >= 0) { ffnfix_strips(p, fix_layer, 256, 258); asm volatile("s_waitcnt vmcnt(0)" ::: "memory"); __syncthreads(); }
        pg8::Gemm g{A, Bt, MROWS, DM, K}; OneUnit S1{64, (int)blockIdx.x - 252}; pg8::gemm_phase<EpiResid, OneUnit, false, true>(lds, g, S1, E);
        wg_arrive(cntB);
    }
    wg_wait(cntA, gridDim.x);
}
template <class Epi> __device__ __forceinline__ void run_gemm_tail(LAS unsigned char* lds, const float* ss, unsigned* cntB, const bf16_t* A, const bf16_t* Bt, int N, int K, const Epi& E) {
    float* rt = (float*)((unsigned char*)lds + pg8::STAGE_BYTES);
    pg8::Gemm g{A, Bt, MROWS, N, K}; TailOrder S; S.init(N, (int)blockIdx.x, cntB, rt, ss);
    for (int i = 0;; ++i) { pg8::Unit u; if (!S.next(i, u)) break;
        if (u.pm != 64 && TIDX < 256) rt[i * 256 + TIDX] = rstd_of(ss + (size_t)(u.pm * 256 + TIDX) * 16); }
    __syncthreads();
    pg8::gemm_phase<Epi, TailOrder, true, true>(lds, g, S, E);
}
__device__ __forceinline__ void build_rstd_table(float* rt, const pg8::StaticOrder& S, const float* ss) {
    for (int i = 0;; ++i) { pg8::Unit u; if (!S.next(i, u)) break;
        if (TIDX < 256) rt[i * 256 + TIDX] = rstd_of(ss + (size_t)(u.pm * 256 + TIDX) * 16); }
    __syncthreads();
}
template <class Epi> __device__ __forceinline__ void run_gemm(LAS unsigned char* lds, const float* ss, const bf16_t* A, const bf16_t* Bt, int N, int K, const Epi& E) {
    pg8::Gemm g{A, Bt, MROWS, N, K}; pg8::StaticOrder S; S.init(MROWS, N, (int)gridDim.x, (int)blockIdx.x);
    if (ss) build_rstd_table((float*)((unsigned char*)lds + pg8::STAGE_BYTES), S, ss);
    pg8::gemm_phase<Epi, pg8::StaticOrder, true, true>(lds, g, S, E);
}

template <bool FFN_INTERLEAVE = false, bool SC_INTERLEAVE = false> __device__ __forceinline__ void transpose_item(const float* W, const float* g, int K, int N, bf16_t* WT, float* scr, int item, int lane) {
    const int nblk = N / 32, kb = item / nblk, nb = item - kb * nblk, k0 = 64 * kb, n0 = 32 * nb;
    const int d0 = SC_INTERLEAVE ? (n0 < DM ? n0 : (n0 < 2 * DM ? DM + ((n0 - DM) >> 7) * 256 + ((n0 - DM) & 127) : DM + ((n0 - 2 * DM) >> 7) * 256 + 128 + ((n0 - 2 * DM) & 127))) : !FFN_INTERLEAVE ? n0 : (n0 < DFF ? (n0 >> 7) * 256 + (n0 & 127) : ((n0 - DFF) >> 7) * 256 + 128 + ((n0 - DFF) & 127));
#pragma unroll 8
    for (int i = 0; i < 32; ++i) { const int kk = 2 * i + (lane >> 5); const float gg = g ? g[k0 + kk] : 1.0f; scr[kk * 33 + (lane & 31)] = W[(size_t)(k0 + kk) * N + n0 + (lane & 31)] * gg; }
    asm volatile("s_waitcnt lgkmcnt(0)" ::: "memory");
    const int c = lane & 7;
#pragma unroll
    for (int j = 0; j < 4; ++j) { const int n = (lane >> 3) + 8 * j; const float* s = scr + (8 * c) * 33 + n;
        u32x4 o; o.x = pk2(s[0 * 33], s[1 * 33]); o.y = pk2(s[2 * 33], s[3 * 33]); o.z = pk2(s[4 * 33], s[5 * 33]); o.w = pk2(s[6 * 33], s[7 * 33]);
        *(u32x4*)(WT + (size_t)(d0 + n) * K + k0 + 8 * c) = o; }
    asm volatile("s_waitcnt lgkmcnt(0)" ::: "memory");
}
__device__ __forceinline__ void sincos_d(double r, float& c, float& s) {
    const double r2 = r * r;
    double sc = 1.0, ss = 1.0;
#pragma unroll
    for (int k = 14; k >= 1; --k) { sc = 1.0 - sc * r2 * (1.0 / (double)((2 * k - 1) * (2 * k))); ss = 1.0 - ss * r2 * (1.0 / (double)((2 * k) * (2 * k + 1))); }
    c = (float)sc; s = (float)(ss * r);
}
__device__ __forceinline__ void prep_rows(const Params& p) {
    bf16_t* H = (bf16_t*)(p.ws + WS_H); float* SS = (float*)(p.ws + WS_SS);
    const int lane = TIDX & 63, gw = blockIdx.x * 8 + (TIDX >> 6), NW = gridDim.x * 8;
    for (int row0 = gw; row0 < MROWS; row0 += 4 * NW) {
        f32x4 v[4][4];
#pragma unroll
        for (int k = 0; k < 4; ++k) { const int row = row0 + k * NW;
            const float* src = row >= MROWS ? nullptr : (row < NPR ? p.in[I_XP] + (size_t)row * DM : (row >= SAMP0 ? p.in[I_XS] + (size_t)(row - SAMP0) * DM : (row >= META0 ? p.in[I_META] + (size_t)(row - META0) * DM : nullptr)));
#pragma unroll
            for (int j = 0; j < 4; ++j) v[k][j] = src ? *(const f32x4*)(src + lane * 4 + 256 * j) : (f32x4){0.f, 0.f, 0.f, 0.f}; }
#pragma unroll
        for (int k = 0; k < 4; ++k) { const int row = row0 + k * NW; if (row < MROWS) {
            float ss = 0.f;
#pragma unroll
            for (int j = 0; j < 4; ++j) {
                u32x2 w; w.x = pk2(v[k][j].x, v[k][j].y); w.y = pk2(v[k][j].z, v[k][j].w); *(u32x2*)(H + (size_t)row * DM + lane * 4 + 256 * j) = w;
                ss += (v[k][j].x * v[k][j].x + v[k][j].y * v[k][j].y) + (v[k][j].z * v[k][j].z + v[k][j].w * v[k][j].w); }
            ss = wave_sum(ss);
            if (lane < 16) SS[(size_t)row * 16 + lane] = lane == 0 ? ss : 0.f; } }
    }
}
__device__ __forceinline__ void phase_final(const Params& p, unsigned* cntB) {
    const bf16_t* H = (const bf16_t*)(p.ws + WS_H); const float* SS = (const float*)(p.ws + WS_SS) + (size_t)4 * MROWS * 16; const float* g = p.in[I_NFIN];
    {
        const int S = (int)gridDim.x * 512, idx0 = blockIdx.x * 512 + TIDX, c = (idx0 & 127) * 8;
        float gv[8]; load8f(g + c, gv);
        for (int idx = idx0; idx < NPR * 128; idx += 4 * S) {
            u32x4 hv[4]; f32x4 sa[4][4];
#pragma unroll
            for (int k = 0; k < 4; ++k) { const int row = (idx + k * S) >> 7; if (row < NPR) { hv[k] = *(const u32x4*)(H + (size_t)row * DM + c);
#pragma unroll
                for (int q = 0; q < 4; ++q) sa[k][q] = *(const f32x4*)(SS + (size_t)row * 16 + 4 * q); } }
#pragma unroll
            for (int k = 0; k < 4; ++k) { const int row = (idx + k * S) >> 7; if (row < NPR) {
                const float sum = ((sa[k][0].x + sa[k][0].y) + (sa[k][0].z + sa[k][0].w)) + ((sa[k][1].x + sa[k][1].y) + (sa[k][1].z + sa[k][1].w)) + ((sa[k][2].x + sa[k][2].y) + (sa[k][2].z + sa[k][2].w)) + ((sa[k][3].x + sa[k][3].y) + (sa[k][3].z + sa[k][3].w));
                const float rs = 1.0f / sqrtf(sum * (1.0f / DM) + 1e-6f);
                float v[8]; unpack8(hv[k], v);
#pragma unroll
                for (int j = 0; j < 8; ++j) v[j] = v[j] * rs * gv[j];
                store8f(p.out + OUT_YP + (size_t)row * DM + c, v); } }
        }
    }
    wg_wait(cntB, 4u);
    for (int idx = blockIdx.x * 512 + TIDX; idx < 128 * 128; idx += gridDim.x * 512) {
        const int r = idx >> 7, c = (idx & 127) * 8, row = SAMP0 + r;
        const float rs = rstd_of(SS + (size_t)row * 16);
        float v[8], gv[8]; unpack8(*(const u32x4*)(H + (size_t)row * DM + c), v); load8f(g + c, gv);
#pragma unroll
        for (int k = 0; k < 8; ++k) v[k] = v[k] * rs * gv[k];
        store8f(p.out + OUT_YS + (size_t)r * DM + c, v);
    }
}
template <int SET> __device__ __forceinline__ void transpose_set(const Params& p, unsigned char* shm, int first) {
    const int lane = TIDX & 63, wave = TIDX >> 6;
    if ((int)blockIdx.x < first) return;
    const int gw = ((int)blockIdx.x - first) * 8 + wave, NW = ((int)gridDim.x - first) * 8;
    float* scr = (float*)(shm + wave * 8704);
    constexpr int I0 = 16 * 192, I1 = 32 * 32, I2 = 16 * 96, I3 = 16 * 32, I4 = 16 * 176, I5 = 44 * 32;
    constexpr int NIT = SET == 0 ? I0 : (SET == 1 ? I1 + I4 : (SET == 2 ? I5 + I2 + I3 : I4 + I5));
    for (int it = gw; it < NIT; it += NW) {
        int r = it;
        if (SET == 0) { transpose_item(p.in[I_WRI], p.in[I_NMIX], DM, RIN, (bf16_t*)(p.ws + WS_WRI), scr, r, lane); }
        else if (SET == 1) {
            if (r < I1) { transpose_item(p.in[I_WRO], nullptr, VD, DM, (bf16_t*)(p.ws + WS_WRO), scr, r, lane); continue; } r -= I1;
            transpose_item<true>(p.in[I_WFI], p.in[I_NFFN], DM, 2 * DFF, (bf16_t*)(p.ws + WS_WFI), scr, r, lane);
        } else if (SET == 2) {
            if (r < I5) { transpose_item(p.in[I_WFO], nullptr, DFF, DM, (bf16_t*)(p.ws + WS_WFO), scr, r, lane); continue; } r -= I5;
            if (r < I2) { transpose_item<false, true>(p.in[I_WSI], p.in[I_NMIX] + DM, DM, 3072, (bf16_t*)(p.ws + WS_WSI), scr, r, lane); continue; } r -= I2;
            transpose_item(p.in[I_WSO], nullptr, DM, DM, (bf16_t*)(p.ws + WS_WSO), scr, r, lane);
        } else {
            if (r < I4) { transpose_item<true>(p.in[I_WFI] + (size_t)DM * 2 * DFF, p.in[I_NFFN] + DM, DM, 2 * DFF, (bf16_t*)(p.ws + WS_WFI) + (size_t)2 * DFF * DM, scr, r, lane); continue; } r -= I4;
            transpose_item(p.in[I_WFO] + (size_t)DFF * DM, nullptr, DFF, DM, (bf16_t*)(p.ws + WS_WFO) + (size_t)DM * DFF, scr, r, lane);
        }
    }
}
__device__ __forceinline__ void phase_prep(const Params& p, unsigned char* shm) {
    transpose_set<0>(p, shm, 0);
    float* rope = (float*)(p.ws + WS_ROPE);
    for (int i = blockIdx.x * 512 + TIDX; i < 2065 * 128; i += gridDim.x * 512) {
        const int pi = i >> 7, fi = i & 127; const double pos = pi == 2064 ? 16384.0 : (double)pi;
        const double y = -(double)fi * 0.10462765653188542;
        const double nn = rint(y), f = (y - nn) * 0.6931471805599453;
        double e = 1.0;
#pragma unroll
        for (int k = 18; k >= 1; --k) e = 1.0 + e * f * (1.0 / (double)k);
        const double inv = e / (double)(1 << (int)(-nn));
        const double ang = pos * inv; const double kk = rint(ang * 0.15915494309189535); const double rr = ang - kk * 6.283185307179586;
        float c, s; sincos_d(rr, c, s);
        *(f32x2*)(rope + (size_t)i * 2) = (f32x2){c, s};
    }
    prep_rows(p);
}

#define TR_READ2(r0, r1, base, OFF0, OFF1) asm volatile("ds_read_b64_tr_b16 %0, %2 offset:%3\n\tds_read_b64_tr_b16 %1, %2 offset:%4" : "=&v"(r0), "=&v"(r1) : "v"(base), "i"(OFF0), "i"(OFF1) : "memory")
#define MFMA16(a, b, c) __builtin_amdgcn_mfma_f32_16x16x32_bf16((a), (b), (c), 0, 0, 0)
__device__ __forceinline__ bf16x8 cat4(s16x4 a, s16x4 b) { return __builtin_shufflevector(a, b, 0, 1, 2, 3, 4, 5, 6, 7); }

__device__ __forceinline__ void retention_prompt(const Params& p, unsigned char* shm, int item) {
    const int b = item >> 5, h = (item >> 3) & 3, dvb = item & 7;
    const int tid = TIDX, w = __builtin_amdgcn_readfirstlane(tid >> 6), lane = tid & 63, fr = lane & 15, fq = lane >> 4, tq = (lane & 15) >> 2, tp = lane & 3;
    const bf16_t* PROJ = (const bf16_t*)(p.ws + WS_PROJ); bf16_t* O = (bf16_t*)(p.ws + WS_O); f32x2* STATS = (f32x2*)(p.ws + WS_STATS);
    constexpr int KRS = 528, VRS = 160  , OFF_V = 128 * KRS, OFF_VS = OFF_V + 128 * VRS, OFF_ST = OFF_VS + 128 * VRS;
    unsigned char* Kl = shm; unsigned char* Vl = shm + OFF_V; unsigned char* Vs = shm + OFF_VS; unsigned char* Stl = shm + OFF_ST;
    const unsigned lbase = (unsigned)(size_t)shm;
    const float lg2 = h == 0 ? -0.04580368961312479f : (h == 1 ? -0.02272007650008353f : (h == 2 ? -0.011315313227834146f : -0.005646563141142063f));
    const float g128 = __builtin_amdgcn_exp2f(lg2 * 128.0f);
    f32x4 sacc[2][4];
#pragma unroll
    for (int j = 0; j < 2; ++j)
#pragma unroll
        for (int eb = 0; eb < 4; ++eb) sacc[j][eb] = (f32x4){0.f, 0.f, 0.f, 0.f};
    const int nloc = 16 * w + fr;
    const unsigned trV_in = lbase + OFF_V + (4 * fq + tq) * VRS + 8 * tp, trV_up = lbase + OFF_VS + (4 * fq + tq) * VRS + 8 * tp, trK_up = lbase + (4 * fq + tq) * KRS + 64 * w + 8 * tp;
    const unsigned koff = (unsigned)((tid >> 5) * RIN + (tid & 31) * 8) * 2u, voff = (unsigned)((tid >> 3) * RIN + (tid & 7) * 8) * 2u, qoff = (unsigned)(nloc * RIN + fq * 8) * 2u;
    u32x4 kpre[8], vpre[2]; bf16x8 qf[8];
    {
        const char* base = (const char*)(PROJ + (size_t)NPR * RIN);
#pragma unroll
        for (int i = 0; i < 8; ++i) kpre[i] = *(const u32x4*)(base + (size_t)(1024 + h * 256 + i * 16 * RIN) * 2 + koff);
#pragma unroll
        for (int i = 0; i < 2; ++i) vpre[i] = *(const u32x4*)(base + (size_t)(2048 + h * 512 + dvb * 64 + i * 64 * RIN) * 2 + voff);
#pragma unroll
        for (int ks = 0; ks < 8; ++ks) qf[ks] = *(const bf16x8*)(base + (size_t)(h * 256 + ks * 32) * 2 + qoff);
    }
    for (int c = -1; c < 16; ++c) {
        float lg2c = lg2; asm volatile("" : "+v"(lg2c));
        const int rowbase = c < 0 ? NPR : b * 2048 + c * 128;
        const char* nbase = (const char*)(PROJ + (size_t)(b * 2048 + (c + 1) * 128) * RIN);
        __syncthreads();
#pragma unroll
        for (int i = 0; i < 8; ++i) { const int ch = tid + 512 * i, r = ch >> 5, cc = ch & 31; *(u32x4*)(Kl + r * KRS + cc * 16) = kpre[i]; }
#pragma unroll
        for (int i = 0; i < 2; ++i) { const int ch = tid + 512 * i, r = ch >> 3, cc = ch & 7;
            *(u32x4*)(Vl + r * VRS + cc * 16) = vpre[i];
            const float kd = __builtin_amdgcn_exp2f(lg2c * (float)(127 - r));
            float f[8]; unpack8(vpre[i], f);
#pragma unroll
            for (int k = 0; k < 8; ++k) f[k] *= kd;
            *(u32x4*)(Vs + r * VRS + cc * 16) = pack8(f); }
#pragma unroll
        for (int j = 0; j < 2; ++j)
#pragma unroll
            for (int eb = 0; eb < 4; ++eb) { u32x2 wv; wv.x = pk2(sacc[j][eb].x, sacc[j][eb].y); wv.y = pk2(sacc[j][eb].z, sacc[j][eb].w);
                *(u32x2*)(Stl + (16 * eb + fr) * KRS + (16 * (2 * w + j) + 4 * fq) * 2) = wv; }
        if (c < 15) {
#pragma unroll
            for (int i = 0; i < 8; ++i) kpre[i] = *(const u32x4*)(nbase + (size_t)(1024 + h * 256 + i * 16 * RIN) * 2 + koff);
#pragma unroll
            for (int i = 0; i < 2; ++i) vpre[i] = *(const u32x4*)(nbase + (size_t)(2048 + h * 512 + dvb * 64 + i * 64 * RIN) * 2 + voff);
        }
        __syncthreads();
        f32x4 oacc[4];
#pragma unroll
        for (int eb = 0; eb < 4; ++eb) {
            oacc[eb] = (f32x4){0.f, 0.f, 0.f, 0.f};
            if (c >= 0) {
#pragma unroll
            for (int ks = 0; ks < 8; ++ks) { const bf16x8 sf = *(const bf16x8*)(Stl + (16 * eb + fr) * KRS + (ks * 32 + fq * 8) * 2); oacc[eb] = MFMA16(sf, qf[ks], oacc[eb]); }
            }
        }
        const float cd = __builtin_amdgcn_exp2f(lg2c * (float)(nloc + 1));
#pragma unroll
        for (int eb = 0; eb < 4; ++eb) oacc[eb] = oacc[eb] * cd;
        __builtin_amdgcn_sched_barrier(0);
#pragma unroll
        for (int s = 0; s < 4; ++s) {
            if (2 * s <= w && (c >= 0 || s == 3)) {
                f32x4 p0 = (f32x4){0.f, 0.f, 0.f, 0.f}, p1 = (f32x4){0.f, 0.f, 0.f, 0.f};
#pragma unroll
                for (int ks = 0; ks < 8; ++ks) {
                    const bf16x8 k0 = *(const bf16x8*)(Kl + (32 * s + fr) * KRS + (ks * 32 + fq * 8) * 2), k1 = *(const bf16x8*)(Kl + (32 * s + 16 + fr) * KRS + (ks * 32 + fq * 8) * 2);
                    p0 = MFMA16(k0, qf[ks], p0); p1 = MFMA16(k1, qf[ks], p1);
                }
                float v[8];
#pragma unroll
                for (int t = 0; t < 4; ++t) { const int d0 = nloc - (32 * s + 4 * fq + t), d1 = d0 - 16;
                    v[t] = d0 >= 0 ? p0[t] * __builtin_amdgcn_exp2f(lg2c * (float)d0) : 0.f;
                    v[4 + t] = d1 >= 0 ? p1[t] * __builtin_amdgcn_exp2f(lg2c * (float)d1) : 0.f; }
                const u32x4 wv = pack8(v); const bf16x8 pf = __builtin_bit_cast(bf16x8, wv);
                s16x4 r[4][2];
#pragma unroll
                for (int eb = 0; eb < 4; ++eb) {
                    TR_READ2(r[eb][0], r[eb][1], trV_in, 32 * s * VRS + 32 * eb, (32 * s + 16) * VRS + 32 * eb);
                }
                asm volatile("s_waitcnt lgkmcnt(0)" : "+v"(r[0][0]), "+v"(r[0][1]), "+v"(r[1][0]), "+v"(r[1][1]), "+v"(r[2][0]), "+v"(r[2][1]), "+v"(r[3][0]), "+v"(r[3][1]) :: "memory");
#pragma unroll
                for (int eb = 0; eb < 4; ++eb) oacc[eb] = MFMA16(cat4(r[eb][0], r[eb][1]), pf, oacc[eb]);
            }
            __builtin_amdgcn_sched_barrier(0);
        }
        asm volatile("" ::: "memory");
        if (c < 15) {
#pragma unroll
            for (int ks = 0; ks < 8; ++ks) qf[ks] = *(const bf16x8*)(nbase + (size_t)(h * 256 + ks * 32) * 2 + qoff);
        }
        if (c >= 0 || b == 0) {
            float s1 = 0.f, s2 = 0.f;
#pragma unroll
            for (int eb = 0; eb < 4; ++eb) {
                const f32x4 o = oacc[eb];
                s1 += (o.x + o.y) + (o.z + o.w); s2 += (o.x * o.x + o.y * o.y) + (o.z * o.z + o.w * o.w);
                u32x2 wv; wv.x = pk2(o.x, o.y); wv.y = pk2(o.z, o.w);
                *(u32x2*)(O + (size_t)(rowbase + nloc) * VD + h * 512 + dvb * 64 + 16 * eb + 4 * fq) = wv;
            }
            s1 += __shfl_xor(s1, 16); s1 += __shfl_xor(s1, 32); s2 += __shfl_xor(s2, 16); s2 += __shfl_xor(s2, 32);
            if (fq == 0) STATS[((size_t)(rowbase + nloc) * 4 + h) * 8 + dvb] = (f32x2){s1, s2};
        }
#pragma unroll
        for (int j = 0; j < 2; ++j)
#pragma unroll
            for (int eb = 0; eb < 4; ++eb) sacc[j][eb] = sacc[j][eb] * g128;
        {
            s16x4 kr[2][2][2], vr[2][4][2];
#define UPD_ISSUE(bf, s_) do { _Pragma("unroll") for (int j = 0; j < 2; ++j) TR_READ2(kr[bf][j][0], kr[bf][j][1], trK_up, 32 * (s_) * KRS + 32 * j, (32 * (s_) + 16) * KRS + 32 * j); \
                               _Pragma("unroll") for (int eb = 0; eb < 4; ++eb) TR_READ2(vr[bf][eb][0], vr[bf][eb][1], trV_up, 32 * (s_) * VRS + 32 * eb, (32 * (s_) + 16) * VRS + 32 * eb); } while (0)
            UPD_ISSUE(0, 0);
#pragma unroll
            for (int s = 0; s < 4; ++s) {
                const int cb_ = s & 1;
                asm volatile("s_waitcnt lgkmcnt(0)" : "+v"(kr[cb_][0][0]), "+v"(kr[cb_][0][1]), "+v"(kr[cb_][1][0]), "+v"(kr[cb_][1][1]), "+v"(vr[cb_][0][0]), "+v"(vr[cb_][0][1]), "+v"(vr[cb_][1][0]), "+v"(vr[cb_][1][1]), "+v"(vr[cb_][2][0]), "+v"(vr[cb_][2][1]), "+v"(vr[cb_][3][0]), "+v"(vr[cb_][3][1]) :: "memory");
                if (s < 3) UPD_ISSUE(cb_ ^ 1, s + 1);
#pragma unroll
                for (int j = 0; j < 2; ++j)
#pragma unroll
                    for (int eb = 0; eb < 4; ++eb) sacc[j][eb] = MFMA16(cat4(kr[cb_][j][0], kr[cb_][j][1]), cat4(vr[cb_][eb][0], vr[cb_][eb][1]), sacc[j][eb]);
                __builtin_amdgcn_sched_barrier(0);
            }
#undef UPD_ISSUE
        }
    }
    float* RP = p.out + OUT_RETP + (size_t)(b * 4 + h) * 256 * 512;
#pragma unroll
    for (int j = 0; j < 2; ++j)
#pragma unroll
        for (int eb = 0; eb < 4; ++eb) {
            const int d0 = 16 * (2 * w + j) + 4 * fq, e = dvb * 64 + 16 * eb + fr;
            RP[(size_t)(d0 + 0) * 512 + e] = sacc[j][eb].x; RP[(size_t)(d0 + 1) * 512 + e] = sacc[j][eb].y; RP[(size_t)(d0 + 2) * 512 + e] = sacc[j][eb].z; RP[(size_t)(d0 + 3) * 512 + e] = sacc[j][eb].w;
        }
}
__device__ __forceinline__ void retention_sample(const Params& p, unsigned char* shm, int item) {
    const int b = item >> 2, h = item & 3, row = SAMP0 + b, tid = TIDX, lane = tid & 63, w = tid >> 6;
    const bf16_t* PROJ = (const bf16_t*)(p.ws + WS_PROJ); bf16_t* O = (bf16_t*)(p.ws + WS_O); f32x2* STATS = (f32x2*)(p.ws + WS_STATS);
    float* qs = (float*)shm; float* ks = qs + 256; float* red = ks + 256; float* opart = red + 32;
    const float gamma = 1.0f - (h == 0 ? 0.03125f : (h == 1 ? 0.015625f : (h == 2 ? 0.0078125f : 0.00390625f)));
    const bf16_t* prow = PROJ + (size_t)row * RIN;
    __syncthreads();
    if (tid < 256) {
        const float q = __uint_as_float((unsigned)prow[h * 256 + tid] << 16), k = __uint_as_float((unsigned)prow[1024 + h * 256 + tid] << 16);
        qs[tid] = q; ks[tid] = k;
        const float pr = wave_sum(q * k);
        if (lane == 0) red[w] = pr;
    }
    __syncthreads();
    const float qk = (red[0] + red[1]) + (red[2] + red[3]);
    const int e4 = (tid & 127) * 4, dsub = tid >> 7;
    const u32x2 vw = *(const u32x2*)(prow + 2048 + h * 512 + e4);
    const f32x4 v4 = (f32x4){bflo(vw.x), bfhi(vw.x), bflo(vw.y), bfhi(vw.y)};
    const float* Sp = p.in[I_SRET] + (size_t)(b * 4 + h) * 256 * 512 + e4;
    float* Sn = p.out + OUT_RETS + (size_t)(b * 4 + h) * 256 * 512 + e4;
    f32x4 oa = (f32x4){0.f, 0.f, 0.f, 0.f};
    f32x4 cur[16], nxt[16];
#pragma unroll
    for (int j = 0; j < 16; ++j) cur[j] = __builtin_nontemporal_load((const f32x4*)(Sp + (size_t)(dsub + 4 * j) * 512));
#pragma unroll
    for (int bt = 0; bt < 4; ++bt) {
        if (bt < 3) {
#pragma unroll
            for (int j = 0; j < 16; ++j) nxt[j] = __builtin_nontemporal_load((const f32x4*)(Sp + (size_t)(dsub + 4 * (16 * (bt + 1) + j)) * 512));
        }
#pragma unroll
        for (int j = 0; j < 16; ++j) {
            const int d = dsub + 4 * (16 * bt + j);
            const float qd = qs[d], kd = ks[d];
            oa = oa + cur[j] * qd;
            const f32x4 sn = cur[j] * gamma + v4 * kd;
            __builtin_nontemporal_store(sn, (f32x4*)(Sn + (size_t)d * 512));
        }
#pragma unroll
        for (int j = 0; j < 16; ++j) cur[j] = nxt[j];
    }
    *(f32x4*)(opart + dsub * 512 + e4) = oa;
    __syncthreads();
    const float ve = __uint_as_float((unsigned)prow[2048 + h * 512 + tid] << 16);
    const float o = gamma * ((opart[tid] + opart[512 + tid]) + (opart[1024 + tid] + opart[1536 + tid])) + qk * ve;
    O[(size_t)row * VD + h * 512 + tid] = (bf16_t)(pk2(o, 0.f) & 0xffffu);
    const float s1 = wave_sum(o), s2 = wave_sum(o * o);
    if (lane == 0) { red[8 + w] = s1; red[16 + w] = s2; }
    __syncthreads();
    if (tid < 8) {
        float a = 0.f, c = 0.f;
        if (tid == 0) {
#pragma unroll
            for (int i = 0; i < 8; ++i) { a += red[8 + i]; c += red[16 + i]; }
        }
        STATS[((size_t)row * 4 + h) * 8 + tid] = (f32x2){a, c};
    }
}
__device__ __forceinline__ void phase_retention(const Params& p, unsigned char* shm) {
    const bool stream_first = ((blockIdx.x >> 3) & 1) != 0;
    if (stream_first) { for (int item = blockIdx.x; item < 512; item += gridDim.x) retention_sample(p, shm, item); }
    __syncthreads();
    for (int item = blockIdx.x; item < 256; item += gridDim.x) retention_prompt(p, shm, item);
    __syncthreads();
    if (!stream_first) { for (int item = blockIdx.x; item < 512; item += gridDim.x) retention_sample(p, shm, item); }
}
__device__ __forceinline__ void phase_gatenorm(const Params& p) {
    const bf16_t* PROJ = (const bf16_t*)(p.ws + WS_PROJ); const bf16_t* O = (const bf16_t*)(p.ws + WS_O); const float* STATS = (const float*)(p.ws + WS_STATS); bf16_t* Y = (bf16_t*)(p.ws + WS_Y0);
    const int lane = TIDX & 63, gw = blockIdx.x * 8 + (TIDX >> 6), NW = gridDim.x * 8;
    for (int it0 = gw * 4; it0 < MROWS * 4; it0 += NW * 4) {
        u32x4 ow[4], gwv[4]; f32x4 sa[4], sb[4], sc[4], sd[4];
#pragma unroll
        for (int q = 0; q < 4; ++q) { const int it = it0 + q, row = it >> 2, h = it & 3; const float* st = STATS + (size_t)it * 16;
            sa[q] = *(const f32x4*)st; sb[q] = *(const f32x4*)(st + 4); sc[q] = *(const f32x4*)(st + 8); sd[q] = *(const f32x4*)(st + 12);
            ow[q] = *(const u32x4*)(O + (size_t)row * VD + h * 512 + lane * 8); gwv[q] = *(const u32x4*)(PROJ + (size_t)row * RIN + 4096 + h * 512 + lane * 8); }
#pragma unroll
        for (int q = 0; q < 4; ++q) { const int it = it0 + q, row = it >> 2, h = it & 3;
            const float s1 = (sa[q].x + sa[q].z) + (sb[q].x + sb[q].z) + (sc[q].x + sc[q].z) + (sd[q].x + sd[q].z), s2 = (sa[q].y + sa[q].w) + (sb[q].y + sb[q].w) + (sc[q].y + sc[q].w) + (sd[q].y + sd[q].w);
            const float mu = s1 * (1.0f / 512.0f); float var = s2 * (1.0f / 512.0f) - mu * mu; var = var > 0.f ? var : 0.f;
            const float rstd = 1.0f / sqrtf(var + 1e-6f);
            float of[8], gf[8], y[8]; unpack8(ow[q], of); unpack8(gwv[q], gf);
#pragma unroll
            for (int k = 0; k < 8; ++k) y[k] = silu_f(gf[k]) * ((of[k] - mu) * rstd);
            *(u32x4*)(Y + (size_t)row * VD + h * 512 + lane * 8) = pack8(y); }
    }
}
__device__ __forceinline__ void prev_rows(int row, int& p1, int& p2) {
    if (row < NPR) { const int t = row & 2047; p1 = t >= 1 ? row - 1 : SAMP0 - 1; p2 = t >= 2 ? row - 2 : (t == 1 ? SAMP0 - 1 : SAMP0 - 2); }
    else { p1 = row - 1; p2 = row - 2; }
}
__device__ __forceinline__ void seg_rows(int seg, int& r0, int& h1, int& h2) {
    if (seg < 2048) { r0 = seg * 8; if ((r0 & 2047) == 0) { h1 = SAMP0 - 1; h2 = SAMP0 - 2; } else { h1 = r0 - 1; h2 = r0 - 2; } }
    else { r0 = META0 + (seg - 2048) * 8; if (seg == 2048) { h1 = -1; h2 = -1; } else { h1 = r0 - 1; h2 = r0 - 2; } }
}
constexpr int NSEG = 2050;
__device__ __forceinline__ void phase_scconv(const Params& p) {
    const bf16_t* SC = (const bf16_t*)(p.ws + WS_PROJ); bf16_t* Y = (bf16_t*)(p.ws + WS_Y0);
    const float* cw = p.in[I_WSC]; const float* sin_ = p.in[I_SCONV];
    float* outp = p.out + OUT_CONVP; float* outs = p.out + OUT_CONVS;
    constexpr int CG = DM / 8, LD = 2 * DM;
    const int total = (NSEG + 128) * CG;
    for (int idx = blockIdx.x * 512 + TIDX; idx < total; idx += gridDim.x * 512) {
        const int seg = idx / CG, c = (idx - seg * CG) * 8;
        float w0[8], w1[8], w2[8], u1[8], u2[8];
        load8f(cw + c, w0); load8f(cw + DM + c, w1); load8f(cw + 2 * DM + c, w2);
        if (seg >= NSEG) {
            const int b = seg - NSEG, row = SAMP0 + b; float u0[8], bg[8], y[8];
            unpack8(*(const u32x4*)(SC + (size_t)row * LD + c), bg); unpack8(*(const u32x4*)(SC + (size_t)row * LD + DM + c), u0);
            load8f(sin_ + ((size_t)b * 2 + 1) * DM + c, u1); load8f(sin_ + ((size_t)b * 2 + 0) * DM + c, u2);
            store8f(outs + ((size_t)b * 2 + 0) * DM + c, u1); store8f(outs + ((size_t)b * 2 + 1) * DM + c, u0);
#pragma unroll
            for (int k = 0; k < 8; ++k) y[k] = bg[k] * (w0[k] * u2[k] + w1[k] * u1[k] + w2[k] * u0[k]);
            *(u32x4*)(Y + (size_t)row * DM + c) = pack8(y);
            continue;
        }
        int r0, h1, h2; seg_rows(seg, r0, h1, h2);
        u32x4 bw[8], uw[8];
#pragma unroll
        for (int i = 0; i < 8; ++i) { bw[i] = *(const u32x4*)(SC + (size_t)(r0 + i) * LD + c); uw[i] = *(const u32x4*)(SC + (size_t)(r0 + i) * LD + DM + c); }
        if (h1 >= 0) { unpack8(*(const u32x4*)(SC + (size_t)h1 * LD + DM + c), u1); unpack8(*(const u32x4*)(SC + (size_t)h2 * LD + DM + c), u2); }
        else {
#pragma unroll
            for (int k = 0; k < 8; ++k) { u1[k] = 0.f; u2[k] = 0.f; } }
#pragma unroll
        for (int i = 0; i < 8; ++i) {
            float u0[8], bg[8], y[8]; unpack8(bw[i], bg); unpack8(uw[i], u0);
#pragma unroll
            for (int k = 0; k < 8; ++k) { y[k] = bg[k] * (w0[k] * u2[k] + w1[k] * u1[k] + w2[k] * u0[k]); u2[k] = u1[k]; u1[k] = u0[k]; }
            *(u32x4*)(Y + (size_t)(r0 + i) * DM + c) = pack8(y);
            if (i >= 6 && seg < 2048 && (seg & 255) == 255) store8f(outp + ((size_t)(seg >> 8) * 2 + (i - 6)) * DM + c, u0);
        }
    }
}

constexpr int NPH = 15;
__global__ __launch_bounds__(512, 2) void fwd_megakernel(Params p) {
    extern __shared__ __attribute__((aligned(16))) unsigned char shm[];
    LAS unsigned char* lds = (LAS unsigned char*)shm;
    cg::grid_group grid = cg::this_grid();
    const bf16_t* H = (const bf16_t*)(p.ws + WS_H); const bf16_t* Y = (const bf16_t*)(p.ws + WS_Y);
    bf16_t* PROJ = (bf16_t*)(p.ws + WS_PROJ);
#define PH_BEGIN(k) if (p.ph_lo <= (k) && (k) < p.ph_hi) {
#define PH_END(k) if ((k) + 1 < p.ph_hi) xcd_barrier(xb); }
    float* SS = (float*)(p.ws + WS_SS); bf16_t* Hw = (bf16_t*)(p.ws + WS_H);
    volatile LAS unsigned* xst = (volatile LAS unsigned*)(lds + LDS_BYTES - 16);
    if (TIDX == 0) { xst[0] = 0u; xst[1] = 0u; }
    __syncthreads();
    const XcdBarrier xb = xcd_barrier_post((unsigned*)(p.ws + WS_BAR), xst);
    if (p.ph_hi < 0) grid.sync();
    unsigned* HC = (unsigned*)(p.ws + WS_BAR) + 3520;
    const bf16_t* Y0 = (const bf16_t*)(p.ws + WS_Y0);
#define PH_NOBAR(k) }
    PH_BEGIN(0) phase_prep(p, shm); PH_END(0)
    PH_BEGIN(1) { EpiRetIn E{PROJ, (const float*)(p.ws + WS_ROPE), (const float*)(shm + pg8::STAGE_BYTES)}; run_gemm(lds, SS, H, (const bf16_t*)(p.ws + WS_WRI), RIN, DM, E);
                  transpose_set<1>(p, shm, 24); transpose_set<2>(p, shm, 24); transpose_set<3>(p, shm, 24); } PH_END(1)
    PH_BEGIN(2) phase_retention(p, shm); PH_END(2)
    PH_BEGIN(3) phase_gatenorm(p); PH_END(3)
    PH_BEGIN(4) run_resid_gemm(p, -1, lds, Y0, (const bf16_t*)(p.ws + WS_WRO), VD, Hw, SS + (size_t)MROWS * 16, HC, HC + 64); PH_NOBAR(4)
    PH_BEGIN(5) { EpiFfn E{(bf16_t*)(p.ws + WS_Y), (const float*)(shm + pg8::STAGE_BYTES), (float*)(p.ws + WS_O), p.in[I_WFC], p.in[I_BFC], p.in[I_SFFN], p.out + OUT_FFNS}; run_gemm_tail(lds, SS + (size_t)MROWS * 16, HC + 64, H, (const bf16_t*)(p.ws + WS_WFI), 2 * DFF, DM, E); } PH_END(5)
    PH_BEGIN(7) run_resid_gemm(p, 0, lds, Y, (const bf16_t*)(p.ws + WS_WFO), DFF, Hw, SS + (size_t)2 * MROWS * 16, HC + 128, HC + 192); PH_NOBAR(7)
    PH_BEGIN(8) { EpiSc E{PROJ, (const float*)(shm + pg8::STAGE_BYTES)}; run_gemm_tail(lds, SS + (size_t)2 * MROWS * 16, HC + 192, H, (const bf16_t*)(p.ws + WS_WSI), 3 * DM, DM, E); } PH_END(8)
    PH_BEGIN(9) phase_scconv(p); PH_END(9)
    PH_BEGIN(10) run_resid_gemm(p, -1, lds, Y0, (const bf16_t*)(p.ws + WS_WSO), DM, Hw, SS + (size_t)3 * MROWS * 16, HC + 256, HC + 320); PH_NOBAR(10)
    PH_BEGIN(11) { EpiFfn E{(bf16_t*)(p.ws + WS_Y), (const float*)(shm + pg8::STAGE_BYTES), (float*)(p.ws + WS_O), p.in[I_WFC] + 3 * DFF, p.in[I_BFC] + DFF, p.in[I_SFFN] + (size_t)128 * 2 * DFF, p.out + OUT_FFNS + (size_t)128 * 2 * DFF}; run_gemm_tail(lds, SS + (size_t)3 * MROWS * 16, HC + 320, H, (const bf16_t*)(p.ws + WS_WFI) + (size_t)2 * DFF * DM, 2 * DFF, DM, E); } PH_END(11)
    PH_BEGIN(13) run_resid_gemm(p, 1, lds, Y, (const bf16_t*)(p.ws + WS_WFO) + (size_t)DM * DFF, DFF, Hw, SS + (size_t)4 * MROWS * 16, HC + 384, HC + 448); PH_NOBAR(13)
    PH_BEGIN(14) phase_final(p, HC + 448); PH_END(14)
}

extern "C" void kernel_launch(void* const* d_in, const int* in_sizes, int n_in, void* d_out, int out_size, void* d_ws, size_t ws_size, hipStream_t stream) {
    static int grid = 0;
    if (grid == 0) {
        if (n_in != 18 || ws_size < WS_END) { fprintf(stderr, "kernel_launch: unexpected n_in %d or ws_size %zu (< %zu)\n", n_in, ws_size, (size_t)WS_END); grid = -1; return; }
        int dev = 0, cus = 0, per_cu = 0;
        hipGetDevice(&dev); hipDeviceGetAttribute(&cus, hipDeviceAttributeMultiprocessorCount, dev);
        if (hipFuncSetAttribute((const void*)fwd_megakernel, hipFuncAttributeMaxDynamicSharedMemorySize, LDS_BYTES) != hipSuccess) fprintf(stderr, "kernel_launch: hipFuncSetAttribute failed\n");
        if (hipOccupancyMaxActiveBlocksPerMultiprocessor(&per_cu, (const void*)fwd_megakernel, 512, LDS_BYTES) != hipSuccess || per_cu < 1) { fprintf(stderr, "kernel_launch: occupancy query gave %d\n", per_cu); per_cu = 1; }
        (void)hipGetLastError();
        if (cus != 256) fprintf(stderr, "kernel_launch: note: %d CUs reported; the phase schedule is built for 256 workgroups (one per CU)\n", cus);
        grid = 256;
    }
    if (grid < 0) return;
    if (hipMemsetAsync((char*)d_ws + WS_BAR, 0, 16384, stream) != hipSuccess) fprintf(stderr, "kernel_launch: memset of barrier words failed\n");
    Params p{};
    for (int i = 0; i < 18; ++i) p.in[i] = (const float*)d_in[i];
    p.out = (float*)d_out; p.ws = (unsigned char*)d_ws; p.ph_lo = 0; p.ph_hi = NPH;
#if defined(MK_MULTI)
    for (int ph = 0; ph < NPH; ++ph) { p.ph_lo = ph; p.ph_hi = ph + 1; hipLaunchKernelGGL(fwd_megakernel, dim3(grid), dim3(512), LDS_BYTES, stream, p); }
#else
    void* args[] = {&p};
    hipError_t e = hipLaunchCooperativeKernel((const void*)fwd_megakernel, dim3(grid), dim3(512), args, LDS_BYTES, stream);
    if (e != hipSuccess) fprintf(stderr, "cooperative launch failed: %s (grid %d)\n", hipGetErrorString(e), grid);
#endif
}
```

```cpp
#include <hip/hip_runtime.h>
#include <hip/hip_cooperative_groups.h>
#include <cstdio>
#include <cstdint>
namespace cg = cooperative_groups;
__device__ __forceinline__ int launder_tid() { int t = (int)threadIdx.x; asm volatile("" : "+v"(t)); return t; }
#define TIDX launder_tid()

namespace pg8 {
#define PG8_LAS __attribute__((address_space(3)))
typedef unsigned short bf16_t;
typedef short bf16x8 __attribute__((ext_vector_type(8)));
typedef float f32x4 __attribute__((ext_vector_type(4)));
typedef unsigned u32x4 __attribute__((ext_vector_type(4)));
constexpr int BM = 256, BK = 64, HALF = 128, HTB = HALF * BK * 2  , STAGE_BYTES = 8 * HTB, NXCD = 8, WGM = 2;

__host__ __device__ __forceinline__ int lds_byte(int r, int c) { const int st = (r >> 4) * 2 + (c >> 5), rr = r & 15, cc = c & 31, ob = rr * 64 + cc * 2; return st * 1024 + (ob ^ (((ob >> 9) & 1) << 5)); }
__host__ __device__ __forceinline__ void stage_rc(int b, int& R, int& C) { const int st = b / 1024, sb = b % 1024, swz = sb ^ (((sb >> 9) & 1) << 5); R = (st >> 1) * 16 + swz / 64; C = (st & 1) * 32 + (swz % 64) / 2; }
__host__ __device__ __forceinline__ int perm32(int rho) { const int n = rho >> 4, i = rho & 15; return 8 * (i >> 2) + 4 * n + (i & 3); }

struct Unit { int pm, pn, idx; };
struct Gemm { const bf16_t* A; const bf16_t* Bt; int M, N, K; };

struct StaticOrder {
    int nM, nN, nwg, G, c;
    __host__ __device__ void init(int M, int N, int G_, int c_) { nM = M / BM; nN = N / BM; nwg = nM * nN; G = G_; c = c_; }
    __host__ __device__ bool next(int i, Unit& u) const {
        const long L = (long)i * G + c; if (L >= nwg) return false;
        int wgid = (int)L; { const int q = nwg / NXCD, r = nwg % NXCD, xcd = wgid % NXCD, off = wgid / NXCD; wgid = (xcd < r ? xcd * (q + 1) : r * (q + 1) + (xcd - r) * q) + off; }
        const int nig = WGM * nN, gid = wgid / nig, fm = gid * WGM, gsz = (nM - fm) < WGM ? (nM - fm) : WGM;
        u.pm = fm + ((wgid % nig) % gsz); u.pn = (wgid % nig) / gsz; u.idx = i; return true;
    }
    __host__ __device__ bool at(long L, Unit& u) const {
        if (L >= nwg) return false;
        int wgid = (int)L; { const int q = nwg / NXCD, r = nwg % NXCD, xcd = wgid % NXCD, off = wgid / NXCD; wgid = (xcd < r ? xcd * (q + 1) : r * (q + 1) + (xcd - r) * q) + off; }
        const int nig = WGM * nN, gid = wgid / nig, fm = gid * WGM, gsz = (nM - fm) < WGM ? (nM - fm) : WGM;
        u.pm = fm + ((wgid % nig) % gsz); u.pn = (wgid % nig) / gsz; return true;
    }
    __device__ __forceinline__ void a_ready(const Unit&) const {}
    __device__ __forceinline__ void done(const Unit&) const {}
};
__device__ __forceinline__ unsigned cvt_pk_bf16(float lo, float hi) { unsigned r; asm volatile("v_cvt_pk_bf16_f32 %0, %1, %2" : "=v"(r) : "v"(lo), "v"(hi)); return r; }

template <class Epi, class Sched, bool ALIGN_EPI = false, bool SP2 = false>
__device__ __forceinline__ void gemm_phase(PG8_LAS unsigned char* lds, const Gemm g, const Sched& S, const Epi& E) {
    const int tid = TIDX, wid = __builtin_amdgcn_readfirstlane(tid >> 6), lane = tid & 63, wr = wid >> 2, wc = wid & 3, fr = lane & 15, fq = lane >> 4;
    const int K = g.K, nt = K / BK;
    unsigned voffA[2], voffB[2];
#pragma unroll
    for (int i = 0; i < 2; ++i) { int R, C; stage_rc(tid * 16 + i * 8192, R, C); const int Rb = Epi::PERM ? ((R & ~31) + perm32(R & 31)) : R;
        voffA[i] = (unsigned)(R * K + C) * 2u; voffB[i] = (unsigned)(Rb * K + C) * 2u; }
    const size_t kstep = (size_t)(BK * 2);
    const size_t hstep = (size_t)HALF * K * 2;
    const size_t tstep = 2 * hstep;
    const unsigned ldsw = (unsigned)wid * 1024u;
    const int aoff = lds_byte(wr * 64 + fr, fq * 8), boff = lds_byte(wc * 32 + fr, fq * 8);
#define PG8_SA(b, h) (((b) * 2 + (h)) * HTB)
#define PG8_SB(b, h) ((4 + (b) * 2 + (h)) * HTB)
#define PG8_STAGE(bufoff, gbase, voff) do { _Pragma("unroll") for (int _i = 0; _i < 2; ++_i) \
        __builtin_amdgcn_global_load_lds((const unsigned*)((const char*)(gbase) + (voff)[_i]), (PG8_LAS unsigned*)(lds + (bufoff) + ldsw + _i * 8192), 16, 0, 0); } while (0)
#define PG8_LDA(dst, b, h) do { _Pragma("unroll") for (int m = 0; m < 4; ++m) _Pragma("unroll") for (int k = 0; k < 2; ++k) dst[m][k] = *(const PG8_LAS bf16x8*)(lds + PG8_SA(b, h) + aoff + m * 2048 + k * 1024); } while (0)
#define PG8_LDB(dst, b, h) do { _Pragma("unroll") for (int n = 0; n < 2; ++n) _Pragma("unroll") for (int k = 0; k < 2; ++k) dst[n][k] = *(const PG8_LAS bf16x8*)(lds + PG8_SB(b, h) + boff + n * 2048 + k * 1024); } while (0)
#define PG8_MMA(ai, bj, At, Bt) do { __builtin_amdgcn_s_setprio(1); _Pragma("unroll") for (int m = 0; m < 4; ++m) _Pragma("unroll") for (int n = 0; n < 2; ++n) _Pragma("unroll") for (int k = 0; k < 2; ++k) \
        acc[ai][bj][m][n] = __builtin_amdgcn_mfma_f32_16x16x32_bf16(Bt[n][k], At[m][k], acc[ai][bj][m][n], 0, 0, 0); __builtin_amdgcn_s_setprio(0); } while (0)
#define PG8_WAIT_V(n) asm volatile("s_waitcnt vmcnt(" #n ")" ::: "memory")
#define PG8_WAIT_L(n) asm volatile("s_waitcnt lgkmcnt(" #n ")" ::: "memory")
#define PG8_BAR __builtin_amdgcn_s_barrier()
#define PG8_SCHED __builtin_amdgcn_sched_barrier(0)
    Unit cur, nxt; int ui = 0;
    if (!S.next(0, cur)) return;
    f32x4 acc[2][2][4][2];
#pragma unroll
    for (int a = 0; a < 2; ++a)
#pragma unroll
        for (int b = 0; b < 2; ++b)
#pragma unroll
            for (int m = 0; m < 4; ++m)
#pragma unroll
                for (int n = 0; n < 2; ++n) acc[a][b][m][n] = (f32x4){0.f, 0.f, 0.f, 0.f};
    bf16x8 At[4][2], B0[2][2], B1[2][2];
    const char* cA = (const char*)g.A + (size_t)cur.pm * tstep; const char* cB = (const char*)g.Bt + (size_t)cur.pn * tstep;
    S.a_ready(cur);
    if constexpr (SP2) {
        PG8_STAGE(PG8_SB(0, 0), cB, voffB); PG8_STAGE(PG8_SB(0, 1), cB + hstep, voffB); PG8_STAGE(PG8_SA(0, 0), cA, voffA); PG8_STAGE(PG8_SA(0, 1), cA + hstep, voffA);
        if (wr == 1) PG8_BAR;
        PG8_WAIT_V(2); PG8_BAR;
        PG8_STAGE(PG8_SB(1, 0), cB + kstep, voffB); PG8_STAGE(PG8_SA(1, 0), cA + kstep, voffA); PG8_STAGE(PG8_SB(1, 1), cB + hstep + kstep, voffB);
        PG8_WAIT_V(6); PG8_BAR;
    } else {
        PG8_STAGE(PG8_SB(0, 0), cB, voffB); PG8_STAGE(PG8_SA(0, 0), cA, voffA); PG8_STAGE(PG8_SB(0, 1), cB + hstep, voffB); PG8_STAGE(PG8_SA(0, 1), cA + hstep, voffA);
        if (wr == 1) PG8_BAR;
        PG8_WAIT_V(4); PG8_BAR;
        PG8_STAGE(PG8_SB(1, 0), cB + kstep, voffB); PG8_STAGE(PG8_SA(1, 0), cA + kstep, voffA); PG8_STAGE(PG8_SB(1, 1), cB + hstep + kstep, voffB);
        PG8_WAIT_V(6); PG8_BAR;
    }
    for (;;) {
        const bool has_next = S.next(ui + 1, nxt);
        const char* nA = has_next ? (const char*)g.A + (size_t)nxt.pm * tstep : cA; const char* nB = has_next ? (const char*)g.Bt + (size_t)nxt.pn * tstep : cB;
        for (int t = 0; t < nt; t += 2) {
            const bool last = (t == nt - 2);
            const char* a1 = cA + (size_t)(t + 1) * kstep;
            const char* a2 = last ? nA : cA + (size_t)(t + 2) * kstep; const char* b2 = last ? nB : cB + (size_t)(t + 2) * kstep;
            const char* a3 = a2 + kstep; const char* b3 = b2 + kstep;
            if (last && has_next) S.a_ready(nxt);
            if constexpr (SP2) {
            PG8_LDB(B0, 0, 0); PG8_LDB(B1, 0, 1); PG8_SCHED; PG8_LDA(At, 0, 0); PG8_STAGE(PG8_SA(1, 1), a1 + hstep, voffA);
            PG8_WAIT_V(8); PG8_WAIT_L(0); PG8_BAR; PG8_MMA(0, 0, At, B0); PG8_MMA(0, 1, At, B1); PG8_BAR; PG8_SCHED;
            PG8_LDA(At, 0, 1); PG8_STAGE(PG8_SB(0, 0), b2, voffB); PG8_STAGE(PG8_SB(0, 1), b2 + hstep, voffB); PG8_STAGE(PG8_SA(0, 0), a2, voffA);
            PG8_WAIT_V(8); PG8_WAIT_L(0); PG8_BAR; PG8_MMA(1, 0, At, B0); PG8_MMA(1, 1, At, B1); PG8_BAR; PG8_SCHED;
            PG8_LDB(B0, 1, 0); PG8_LDB(B1, 1, 1); PG8_SCHED; PG8_LDA(At, 1, 0); PG8_STAGE(PG8_SA(0, 1), a2 + hstep, voffA);
            PG8_WAIT_V(8); PG8_WAIT_L(0); PG8_BAR; PG8_MMA(0, 0, At, B0); PG8_MMA(0, 1, At, B1); PG8_BAR; PG8_SCHED;
            PG8_LDA(At, 1, 1); PG8_STAGE(PG8_SB(1, 0), b3, voffB); PG8_STAGE(PG8_SB(1, 1), b3 + hstep, voffB); PG8_STAGE(PG8_SA(1, 0), a3, voffA);
            PG8_WAIT_V(8); PG8_WAIT_L(0); PG8_BAR; PG8_MMA(1, 0, At, B0); PG8_MMA(1, 1, At, B1); PG8_BAR; PG8_SCHED;
            } else {
            PG8_LDB(B0, 0, 0); PG8_SCHED; PG8_LDA(At, 0, 0); PG8_STAGE(PG8_SA(1, 1), a1 + hstep, voffA);
            PG8_WAIT_L(8); PG8_BAR; PG8_WAIT_L(0); PG8_MMA(0, 0, At, B0); PG8_BAR; PG8_SCHED;
            PG8_LDB(B1, 0, 1); PG8_STAGE(PG8_SB(0, 0), b2, voffB);
            PG8_BAR; PG8_WAIT_L(0); PG8_MMA(0, 1, At, B1); PG8_BAR;
            PG8_LDA(At, 0, 1); PG8_STAGE(PG8_SA(0, 0), a2, voffA);
            PG8_BAR; PG8_WAIT_L(0); PG8_MMA(1, 0, At, B0); PG8_BAR; PG8_SCHED;
            PG8_STAGE(PG8_SB(0, 1), b2 + hstep, voffB);
            PG8_WAIT_V(6); PG8_BAR; PG8_MMA(1, 1, At, B1); PG8_BAR;
            PG8_LDB(B0, 1, 0); PG8_SCHED; PG8_LDA(At, 1, 0); PG8_STAGE(PG8_SA(0, 1), a2 + hstep, voffA);
            PG8_WAIT_L(8); PG8_BAR; PG8_WAIT_L(0); PG8_MMA(0, 0, At, B0); PG8_BAR; PG8_SCHED;
            PG8_LDB(B1, 1, 1); PG8_STAGE(PG8_SB(1, 0), b3, voffB);
            PG8_BAR; PG8_WAIT_L(0); PG8_MMA(0, 1, At, B1); PG8_BAR;
            PG8_LDA(At, 1, 1); PG8_STAGE(PG8_SA(1, 0), a3, voffA);
            PG8_BAR; PG8_WAIT_L(0); PG8_MMA(1, 0, At, B0); PG8_BAR; PG8_SCHED;
            PG8_STAGE(PG8_SB(1, 1), b3 + hstep, voffB);
            PG8_WAIT_V(6); PG8_BAR; PG8_MMA(1, 1, At, B1); PG8_BAR;
            }
        }
        if constexpr (ALIGN_EPI) { if (wr == 0) PG8_BAR; }
        if constexpr (!Epi::AFTER_DRAIN) { E(acc, cur, wr, wc, fr, fq); S.done(cur); }
        if (!has_next) break;
#pragma unroll
        for (int a = 0; a < 2; ++a)
#pragma unroll
            for (int b = 0; b < 2; ++b)
#pragma unroll
                for (int m = 0; m < 4; ++m)
#pragma unroll
                    for (int n = 0; n < 2; ++n) acc[a][b][m][n] = (f32x4){0.f, 0.f, 0.f, 0.f};
        cur = nxt; cA = nA; cB = nB; ++ui;
        if constexpr (ALIGN_EPI) { if (wr == 1) PG8_BAR; }
    }
    PG8_WAIT_V(0);
    if constexpr (!ALIGN_EPI) { if (wr == 0) PG8_BAR; }
    PG8_BAR;
    if constexpr (Epi::AFTER_DRAIN) { E.fused(acc, cur, wr, wc, fr, fq, lds, wid, lane); S.done(cur); }
#undef PG8_SA
#undef PG8_SB
#undef PG8_STAGE
#undef PG8_LDA
#undef PG8_LDB
#undef PG8_MMA
#undef PG8_WAIT_V
#undef PG8_WAIT_L
#undef PG8_BAR
#undef PG8_SCHED
}
}

#define LAS __attribute__((address_space(3)))
typedef unsigned short bf16_t;
typedef short bf16x8 __attribute__((ext_vector_type(8)));
typedef short s16x4 __attribute__((ext_vector_type(4)));
typedef float f32x4 __attribute__((ext_vector_type(4)));
typedef float f32x2 __attribute__((ext_vector_type(2)));
typedef unsigned u32x4 __attribute__((ext_vector_type(4)));
typedef unsigned u32x2 __attribute__((ext_vector_type(2)));

constexpr int DM = 1024, MROWS = 16640, NPR = 16384, META0 = 16496, SAMP0 = 16512, DFF = 2816, RIN = 6144, VD = 2048;
constexpr int LDS_BYTES = 143360;
constexpr size_t OUT_YP = 0, OUT_YS = 16777216, OUT_RETP = 16908288, OUT_RETS = 21102592, OUT_CONVP = 88211456, OUT_CONVS = 88227840, OUT_FFNP = 88489984, OUT_FFNS = 88580096;
constexpr size_t WS_X = 0;
constexpr size_t WS_H = WS_X + (size_t)MROWS * DM * 4;
constexpr size_t WS_PROJ = WS_H + (size_t)MROWS * DM * 2;
constexpr size_t WS_O = WS_PROJ + (size_t)MROWS * RIN * 2;
constexpr size_t HALO_N = (size_t)260 * 2 * DFF;
constexpr size_t WS_Y = WS_O + (size_t)MROWS * VD * 2;
constexpr size_t WS_Y0 = WS_Y + (size_t)MROWS * DFF * 2;
constexpr size_t WS_STATS = WS_Y0 + (size_t)MROWS * VD * 2;
constexpr size_t WS_SS = WS_STATS + (size_t)MROWS * 32 * 8;
constexpr size_t WS_ROPE = WS_SS + (size_t)5 * MROWS * 16 * 4;
constexpr size_t WS_WRI = WS_ROPE + (size_t)2065 * 128 * 8;
constexpr size_t WS_WRO = WS_WRI + (size_t)RIN * DM * 2;
constexpr size_t WS_WSI = WS_WRO + (size_t)DM * VD * 2;
constexpr size_t WS_WSO = WS_WSI + (size_t)3072 * DM * 2;
constexpr size_t WS_WFI = WS_WSO + (size_t)DM * DM * 2;
constexpr size_t WS_WFO = WS_WFI + (size_t)2 * 2 * DFF * DM * 2;
constexpr size_t WS_BAR = WS_WFO + (size_t)2 * DM * DFF * 2;
constexpr size_t WS_END = WS_BAR + 16384;

struct Params {
    const float* in[18];
    float* out;
    unsigned char* ws;
    int ph_lo, ph_hi;
};
enum { I_XP = 0, I_XS, I_SRET, I_SCONV, I_SFFN, I_META, I_NMIX, I_NFFN, I_NFIN, I_WRI, I_WRO, I_WSI, I_WSC, I_WSO, I_WFI, I_WFC, I_BFC, I_WFO };

__device__ __forceinline__ float bflo(unsigned w) { return __uint_as_float(w << 16); }
__device__ __forceinline__ float bfhi(unsigned w) { return __uint_as_float(w & 0xffff0000u); }
__device__ __forceinline__ unsigned pk2(float lo, float hi) { unsigned r; asm("v_cvt_pk_bf16_f32 %0, %1, %2" : "=v"(r) : "v"(lo), "v"(hi)); return r; }
__device__ __forceinline__ float silu_f(float x) { return x * __builtin_amdgcn_rcpf(1.0f + __expf(-x)); }
__device__ __forceinline__ float wave_sum(float v) {
#pragma unroll
    for (int o = 1; o < 64; o <<= 1) v += __shfl_xor(v, o);
    return v;
}
__device__ __forceinline__ float rstd_of(const float* p16) {
    const f32x4 a = *(const f32x4*)p16, b = *(const f32x4*)(p16 + 4), c = *(const f32x4*)(p16 + 8), d = *(const f32x4*)(p16 + 12);
    const float ss = ((a.x + a.y) + (a.z + a.w)) + ((b.x + b.y) + (b.z + b.w)) + ((c.x + c.y) + (c.z + c.w)) + ((d.x + d.y) + (d.z + d.w));
    return 1.0f / sqrtf(ss * (1.0f / DM) + 1e-6f); }
__device__ __forceinline__ int pos_index(int row) { if (row < NPR) return 16 + (row & 2047); if (row < SAMP0) { const int j = row - META0; return j < 0 ? 0 : j; } return 2064; }
__device__ __forceinline__ void unpack8(const u32x4 w, float (&f)[8]) { f[0] = bflo(w.x); f[1] = bfhi(w.x); f[2] = bflo(w.y); f[3] = bfhi(w.y); f[4] = bflo(w.z); f[5] = bfhi(w.z); f[6] = bflo(w.w); f[7] = bfhi(w.w); }
__device__ __forceinline__ u32x4 pack8(const float (&f)[8]) { u32x4 w; w.x = pk2(f[0], f[1]); w.y = pk2(f[2], f[3]); w.z = pk2(f[4], f[5]); w.w = pk2(f[6], f[7]); return w; }
__device__ __forceinline__ void load8f(const float* p, float (&f)[8]) { const f32x4 a = *(const f32x4*)p, b = *(const f32x4*)(p + 4); f[0] = a.x; f[1] = a.y; f[2] = a.z; f[3] = a.w; f[4] = b.x; f[5] = b.y; f[6] = b.z; f[7] = b.w; }
__device__ __forceinline__ void store8f(float* p, const float (&f)[8]) { *(f32x4*)p = (f32x4){f[0], f[1], f[2], f[3]}; *(f32x4*)(p + 4) = (f32x4){f[4], f[5], f[6], f[7]}; }

#define XB_TMO      128
#define XB_XCNT(j)  (256  + 64 * (j))
#define XB_XSUB(j)  (1280 + 64 * (j))
#define XB_XGEN(j)  (2304 + 64 * (j))
#define XB_TOP      3328
#define XB_TOPGEN   3392
#define XCD_BAR_WORDS 3456
#define XB_SPIN_CAP (1u << 18)

__device__ __forceinline__ unsigned xb_ld(unsigned* p)              { return __hip_atomic_load(p, __ATOMIC_RELAXED, __HIP_MEMORY_SCOPE_AGENT); }
__device__ __forceinline__ unsigned xb_add(unsigned* p, unsigned v) { return __hip_atomic_fetch_add(p, v, __ATOMIC_RELAXED, __HIP_MEMORY_SCOPE_AGENT); }
__device__ __forceinline__ unsigned xb_xcc_id() { return (unsigned)__builtin_amdgcn_s_getreg((3 << 11) | 20) & 0xFu; }
#define XB_SPIN(cond, bar) do { unsigned _sp = 0; while (cond) { __builtin_amdgcn_s_sleep(1); \
    if ((++_sp & 255u) == 0u) { if (xb_ld(&(bar)[XB_TMO])) break; if (_sp > XB_SPIN_CAP) { atomicAdd(&(bar)[XB_TMO], 1u); break; } } } } while (0)

struct XcdBarrier {
    unsigned* bar; unsigned x;
    volatile LAS unsigned* st;
};

__device__ __forceinline__ XcdBarrier xcd_barrier_post(unsigned* bar, volatile LAS unsigned* st) {
    XcdBarrier b; b.bar = bar; b.x = xb_xcc_id(); b.st = st;
    if (TIDX == 0) (void)xb_add(&bar[XB_XCNT(b.x)], 1u);
    return b;
}
__device__ __forceinline__ void xcd_barrier_complete(unsigned* bar, unsigned x, unsigned& nloc, unsigned& nx) {
    const unsigned G = gridDim.x * gridDim.y * gridDim.z;
    unsigned sum, cnt, mine, sp = 0u;
    for (;;) {
        sum = 0u; cnt = 0u; mine = 0u;
#pragma unroll
        for (unsigned j = 0; j < 16; ++j) { const unsigned c = xb_ld(&bar[XB_XCNT(j)]); sum += c; cnt += (c > 0u) ? 1u : 0u; mine = (j == x) ? c : mine; }
        if (sum == G) break;
        __builtin_amdgcn_s_sleep(1);
        if ((++sp & 255u) == 0u) { if (xb_ld(&bar[XB_TMO])) break; if (sp > XB_SPIN_CAP) { atomicAdd(&bar[XB_TMO], 1u); break; } }
    }
    nloc = mine > 0u ? mine : 1u; nx = cnt > 0u ? cnt : 1u;
}

__device__ __forceinline__ void xcd_barrier(const XcdBarrier& b) {
    asm volatile("s_waitcnt vmcnt(0)" ::: "memory");
    __syncthreads();
    if (TIDX == 0) {
        unsigned* bar = b.bar;
        __builtin_amdgcn_s_waitcnt(0);
        unsigned nloc = b.st[0], nx = b.st[1];
        if (nloc == 0u) { xcd_barrier_complete(bar, b.x, nloc, nx); b.st[0] = nloc; b.st[1] = nx; }
        const unsigned old = xb_add(&bar[XB_XSUB(b.x)], 1u);
        const unsigned gen = old / nloc;
        if (old + 1u == (gen + 1u) * nloc) {
            __builtin_amdgcn_fence(__ATOMIC_RELEASE, "agent");
            asm volatile("s_waitcnt vmcnt(0)" ::: "memory");
            const unsigned og = xb_add(&bar[XB_TOP], 1u);
            const unsigned tg = og / nx;
            if (og + 1u == (tg + 1u) * nx) xb_add(&bar[XB_TOPGEN], 1u);
            else XB_SPIN(xb_ld(&bar[XB_TOPGEN]) == tg, bar);
            __builtin_amdgcn_fence(__ATOMIC_ACQUIRE, "agent");
            xb_add(&bar[XB_XGEN(b.x)], 1u);
            asm volatile("s_waitcnt vmcnt(0)" ::: "memory");
        } else {
            XB_SPIN(xb_ld(&bar[XB_XGEN(b.x)]) == gen, bar);
            __builtin_amdgcn_fence(__ATOMIC_ACQUIRE, "agent");
            asm volatile("s_waitcnt vmcnt(0)" ::: "memory");
        }
    }
    __syncthreads();
}

struct EpiRetIn {
    static constexpr bool PERM = true, AFTER_DRAIN = false;
    bf16_t* O; const float* rope; const float* rt;
    __device__ __forceinline__ void operator()(const f32x4 (&acc)[2][2][4][2], const pg8::Unit& u, int wr, int wc, int fr, int fq) const {
        const int row0 = u.pm * 256 + wr * 64 + fr, colt = u.pn * 256 + wc * 32 + 8 * fq;
        const int kind = u.pn < 4 ? 0 : (u.pn < 8 ? 1 : (u.pn < 16 ? 2 : 3));
        const float* rtu = rt + u.idx * 256 + wr * 64 + fr;
#pragma unroll
        for (int ai = 0; ai < 2; ++ai) {
            float rs[4];
#pragma unroll
            for (int m = 0; m < 4; ++m) rs[m] = rtu[ai * 128 + m * 16];
            if (kind <= 1) {
                f32x4 cs[4][2][2];
#pragma unroll
                for (int m = 0; m < 4; ++m) { const float* rp = rope + ((size_t)pos_index(row0 + ai * 128 + m * 16) * 128 + wc * 16 + 4 * fq) * 2;
#pragma unroll
                    for (int bj = 0; bj < 2; ++bj) { cs[m][bj][0] = *(const f32x4*)(rp + bj * 128); cs[m][bj][1] = *(const f32x4*)(rp + bj * 128 + 4); } }
#pragma unroll
                for (int m = 0; m < 4; ++m) {
                    bf16_t* rowp = O + (size_t)(row0 + ai * 128 + m * 16) * RIN + colt;
                    const float sc = kind == 1 ? 0.0625f * rs[m] : rs[m];
#pragma unroll
                    for (int bj = 0; bj < 2; ++bj) {
                        const f32x4 c0 = cs[m][bj][0], c1 = cs[m][bj][1];
                        const f32x4 v0 = acc[ai][bj][m][0] * sc, v1 = acc[ai][bj][m][1] * sc;
                        u32x4 w;
                        w.x = pk2(v0.x * c0.x - v0.y * c0.y, v0.x * c0.y + v0.y * c0.x);
                        w.y = pk2(v0.z * c0.z - v0.w * c0.w, v0.z * c0.w + v0.w * c0.z);
                        w.z = pk2(v1.x * c1.x - v1.y * c1.y, v1.x * c1.y + v1.y * c1.x);
                        w.w = pk2(v1.z * c1.z - v1.w * c1.w, v1.z * c1.w + v1.w * c1.z);
                        *(u32x4*)(rowp + bj * 128) = w;
                    }
                }
            } else {
#pragma unroll
                for (int m = 0; m < 4; ++m) {
                    bf16_t* rowp = O + (size_t)(row0 + ai * 128 + m * 16) * RIN + colt;
#pragma unroll
                    for (int bj = 0; bj < 2; ++bj) {
                        f32x4 v0 = acc[ai][bj][m][0] * rs[m], v1 = acc[ai][bj][m][1] * rs[m];
                        u32x4 w; w.x = pk2(v0.x, v0.y); w.y = pk2(v0.z, v0.w); w.z = pk2(v1.x, v1.y); w.w = pk2(v1.z, v1.w);
                        *(u32x4*)(rowp + bj * 128) = w;
                    }
                }
            }
        }
    }
};
struct EpiBf16 {
    static constexpr bool PERM = true, AFTER_DRAIN = false;
    bf16_t* O; int ldc; const float* rt;
    __device__ __forceinline__ void operator()(const f32x4 (&acc)[2][2][4][2], const pg8::Unit& u, int wr, int wc, int fr, int fq) const {
        const int row0 = u.pm * 256 + wr * 64 + fr, colt = u.pn * 256 + wc * 32 + 8 * fq;
#pragma unroll
        for (int ai = 0; ai < 2; ++ai)
#pragma unroll
            for (int m = 0; m < 4; ++m) {
                bf16_t* rowp = O + (size_t)(row0 + ai * 128 + m * 16) * ldc + colt;
                const float rs = rt[u.idx * 256 + ai * 128 + wr * 64 + m * 16 + fr];
#pragma unroll
                for (int bj = 0; bj < 2; ++bj) {
                    const f32x4 v0 = acc[ai][bj][m][0] * rs, v1 = acc[ai][bj][m][1] * rs;
                    u32x4 w; w.x = pk2(v0.x, v0.y); w.y = pk2(v0.z, v0.w); w.z = pk2(v1.x, v1.y); w.w = pk2(v1.z, v1.w);
                    *(u32x4*)(rowp + bj * 128) = w;
                }
            }
    }
};
struct EpiFfn {
    static constexpr bool PERM = true, AFTER_DRAIN = false;
    bf16_t* Y; const float* rt; float* halo; const float* cw; const float* cb; const float* sin_; float* outs;
    __device__ __forceinline__ void operator()(const f32x4 (&acc)[2][2][4][2], const pg8::Unit& u, int wr, int wc, int fr, int fq) const {
        const int src1 = (fq << 4) | ((fr + 15) & 15), src2 = (fq << 4) | ((fr + 14) & 15);
        const int chb = 128 * u.pn + 32 * wc + 8 * fq;
        const float* rtu = rt + u.idx * 256 + wr * 64 + fr;
        f32x4 cwv[2][4];
#pragma unroll
        for (int n = 0; n < 2; ++n) { const unsigned cho = (unsigned)(chb + 4 * n) * 4u;
            cwv[n][0] = *(const f32x4*)((const char*)cw + cho); cwv[n][1] = *(const f32x4*)((const char*)(cw + DFF) + cho); cwv[n][2] = *(const f32x4*)((const char*)(cw + 2 * DFF) + cho); cwv[n][3] = *(const f32x4*)((const char*)cb + cho); }
#pragma unroll
        for (int ai = 0; ai < 2; ++ai) {
            float rs[4];
#pragma unroll
            for (int m = 0; m < 4; ++m) rs[m] = rtu[ai * 128 + m * 16];
            const bool sample = (u.pm == 64) && (ai == 1);
            const int row0 = u.pm * 256 + ai * 128 + wr * 64 + fr, strip = (u.pm * 256 + ai * 128 + wr * 64) >> 6;
            if (!sample) {
                f32x4 q1[2], q2[2];
#pragma unroll
                for (int n = 0; n < 2; ++n) { q1[n] = (f32x4){0.f, 0.f, 0.f, 0.f}; q2[n] = q1[n]; }
#pragma unroll
                for (int m = 0; m < 4; ++m) {
                    u32x2 wv[2];
#pragma unroll
                    for (int n = 0; n < 2; ++n) {
                        const int ch = chb + 4 * n;
                        const f32x4 up = acc[ai][0][m][n] * rs[m];
                        f32x4 a1, a2, p1, p2;
#pragma unroll
                        for (int t = 0; t < 4; ++t) { a1[t] = __shfl(up[t], src1); a2[t] = __shfl(up[t], src2); p1[t] = fr >= 1 ? a1[t] : q1[n][t]; p2[t] = fr >= 2 ? a2[t] : q2[n][t]; }
                        q1[n] = a1; q2[n] = a2;
                        const f32x4 g = acc[ai][1][m][n] * rs[m];
                        const f32x4 a = cwv[n][0] * p2 + cwv[n][1] * p1 + cwv[n][2] * up + cwv[n][3];
                        wv[n].x = pk2(silu_f(a.x) * g.x, silu_f(a.y) * g.y); wv[n].y = pk2(silu_f(a.z) * g.z, silu_f(a.w) * g.w);
                        if (m == 0 && fr < 2) { const unsigned ho = (unsigned)((strip * 2 + fr) * DFF + ch) * 4u; *(f32x4*)((char*)halo + ho) = up; *(f32x4*)((char*)(halo + HALO_N) + ho) = g; }
                        if (m == 3 && fr >= 14) *(f32x4*)((char*)(halo + 2 * HALO_N) + (unsigned)((strip * 2 + (fr - 14)) * DFF + ch) * 4u) = up;
                    }
                    if (m > 0 || fr >= 2) *(u32x4*)((char*)Y + (unsigned)((row0 + m * 16) * DFF + chb) * 2u) = (u32x4){wv[0].x, wv[0].y, wv[1].x, wv[1].y};
                }
            } else {
#pragma unroll
                for (int m = 0; m < 4; ++m) {
                    const int b = wr * 64 + m * 16 + fr;
                    u32x2 wv[2];
#pragma unroll
                    for (int n = 0; n < 2; ++n) {
                        const int ch = chb + 4 * n;
                        const f32x4 upv = acc[ai][0][m][n] * rs[m], g = acc[ai][1][m][n] * rs[m];
                        const unsigned so = (unsigned)(b * 2 * DFF + ch) * 4u;
                        const f32x4 s0 = *(const f32x4*)((const char*)sin_ + so), s1 = *(const f32x4*)((const char*)(sin_ + DFF) + so);
                        const f32x4 a = cwv[n][0] * s0 + cwv[n][1] * s1 + cwv[n][2] * upv + cwv[n][3];
                        wv[n].x = pk2(silu_f(a.x) * g.x, silu_f(a.y) * g.y); wv[n].y = pk2(silu_f(a.z) * g.z, silu_f(a.w) * g.w);
                        *(f32x4*)((char*)outs + so) = s1; *(f32x4*)((char*)(outs + DFF) + so) = upv;
                    }
                    *(u32x4*)((char*)Y + (unsigned)((SAMP0 + b) * DFF + chb) * 2u) = (u32x4){wv[0].x, wv[0].y, wv[1].x, wv[1].y};
                }
            }
            asm volatile("" ::: "memory");
        }
    }
};
struct EpiSc {
    static constexpr bool PERM = true, AFTER_DRAIN = false;
    bf16_t* O; const float* rt;
    __device__ __forceinline__ void operator()(const f32x4 (&acc)[2][2][4][2], const pg8::Unit& u, int wr, int wc, int fr, int fq) const {
        const int row0 = u.pm * 256 + wr * 64 + fr;
        const float* rtu = rt + u.idx * 256 + wr * 64 + fr;
        if (u.pn < 4) {
            const int colt = u.pn * 256 + wc * 32 + 8 * fq;
#pragma unroll
            for (int ai = 0; ai < 2; ++ai)
#pragma unroll
                for (int m = 0; m < 4; ++m) {
                    bf16_t* rowp = O + (size_t)(row0 + ai * 128 + m * 16) * (2 * DM) + colt;
                    const float rs = rtu[ai * 128 + m * 16];
#pragma unroll
                    for (int bj = 0; bj < 2; ++bj) {
                        const f32x4 v0 = acc[ai][bj][m][0] * rs, v1 = acc[ai][bj][m][1] * rs;
                        u32x4 w; w.x = pk2(v0.x, v0.y); w.y = pk2(v0.z, v0.w); w.z = pk2(v1.x, v1.y); w.w = pk2(v1.z, v1.w);
                        *(u32x4*)(rowp + bj * 128) = w;
                    }
                }
        } else {
            const int ch0 = DM + 128 * (u.pn - 4) + wc * 32 + 8 * fq;
#pragma unroll
            for (int ai = 0; ai < 2; ++ai)
#pragma unroll
                for (int m = 0; m < 4; ++m) {
                    const float rs = rtu[ai * 128 + m * 16], r2 = rs * rs;
                    const f32x4 v0 = acc[ai][0][m][0] * acc[ai][1][m][0] * r2, v1 = acc[ai][0][m][1] * acc[ai][1][m][1] * r2;
                    u32x4 w; w.x = pk2(v0.x, v0.y); w.y = pk2(v0.z, v0.w); w.z = pk2(v1.x, v1.y); w.w = pk2(v1.z, v1.w);
                    *(u32x4*)(O + (size_t)(row0 + ai * 128 + m * 16) * (2 * DM) + ch0) = w;
                }
        }
    }
};
struct EpiResid {
    static constexpr bool PERM = true, AFTER_DRAIN = false;
    bf16_t* H; float* ssn;
    __device__ __forceinline__ void operator()(const f32x4 (&acc)[2][2][4][2], const pg8::Unit& u, int wr, int wc, int fr, int fq) const {
        const int row0 = u.pm * 256 + wr * 64 + fr, col0 = u.pn * 256 + wc * 32 + 8 * fq;
#pragma unroll
        for (int ai = 0; ai < 2; ++ai) {
            u32x4 xv[4][2];
#pragma unroll
            for (int m = 0; m < 4; ++m) { const bf16_t* rowp = H + (size_t)(row0 + ai * 128 + m * 16) * DM + col0;
#pragma unroll
                for (int bj = 0; bj < 2; ++bj) xv[m][bj] = *(const u32x4*)(rowp + bj * 128); }
#pragma unroll
            for (int m = 0; m < 4; ++m) {
                const int row = row0 + ai * 128 + m * 16;
                bf16_t* hp = H + (size_t)row * DM + col0;
                float sq = 0.f;
#pragma unroll
                for (int bj = 0; bj < 2; ++bj) { const u32x4 xw = xv[m][bj];
                    const f32x4 v0 = (f32x4){bflo(xw.x), bfhi(xw.x), bflo(xw.y), bfhi(xw.y)} + acc[ai][bj][m][0], v1 = (f32x4){bflo(xw.z), bfhi(xw.z), bflo(xw.w), bfhi(xw.w)} + acc[ai][bj][m][1];
                    sq += ((v0.x * v0.x + v0.y * v0.y) + (v0.z * v0.z + v0.w * v0.w)) + ((v1.x * v1.x + v1.y * v1.y) + (v1.z * v1.z + v1.w * v1.w));
                    u32x4 w; w.x = pk2(v0.x, v0.y); w.y = pk2(v0.z, v0.w); w.z = pk2(v1.x, v1.y); w.w = pk2(v1.z, v1.w); *(u32x4*)(hp + bj * 128) = w; }
                sq += __shfl_xor(sq, 16); sq += __shfl_xor(sq, 32);
                if (fq == 0) ssn[(size_t)row * 16 + u.pn * 4 + wc] = sq;
            }
            asm volatile("" ::: "memory");
        }
    }
};
__device__ __forceinline__ void ffnfix_strips(const Params& p, int layer, int s_lo, int s_hi) {
    bf16_t* Y = (bf16_t*)(p.ws + WS_Y); const float* HUF = (const float*)(p.ws + WS_O); const float* HGF = HUF + HALO_N; const float* HUL = HUF + 2 * HALO_N;
    const float* cw = p.in[I_WFC] + (size_t)layer * 3 * DFF; const float* cb = p.in[I_BFC] + (size_t)layer * DFF;
    constexpr int CG = DFF / 8;
    const int total = (s_hi - s_lo) * 2 * CG;
    for (int idx = TIDX; idx < total; idx += 512) {
        const int it = idx / CG, c = (idx - it * CG) * 8;
        const int s_ = s_lo + (it >> 1), i = it & 1, sp = (s_ < 256 && (s_ & 31) == 0) ? 257 : (s_ > 0 ? s_ - 1 : 0);
        float u0[8], u1[8], u2[8], gt[8], w0[8], w1[8], w2[8], bb[8], y[8];
        load8f(HUF + ((size_t)s_ * 2 + i) * DFF + c, u0); load8f(HGF + ((size_t)s_ * 2 + i) * DFF + c, gt);
        if (i == 0) { load8f(HUL + ((size_t)sp * 2 + 1) * DFF + c, u1); load8f(HUL + ((size_t)sp * 2 + 0) * DFF + c, u2); }
        else { load8f(HUF + ((size_t)s_ * 2 + 0) * DFF + c, u1); load8f(HUL + ((size_t)sp * 2 + 1) * DFF + c, u2); }
        load8f(cw + c, w0); load8f(cw + DFF + c, w1); load8f(cw + 2 * DFF + c, w2); load8f(cb + c, bb);
#pragma unroll
        for (int k = 0; k < 8; ++k) { const float a = w0[k] * u2[k] + w1[k] * u1[k] + w2[k] * u0[k] + bb[k]; y[k] = silu_f(a) * gt[k]; }
        *(u32x4*)(Y + (size_t)(64 * s_ + i) * DFF + c) = pack8(y);
    }
}
__device__ __forceinline__ void ffn_state_prompt(const Params& p, int layer, int b) {
    const float* HUL = (const float*)(p.ws + WS_O) + 2 * HALO_N; float* outp = p.out + OUT_FFNP + (size_t)layer * 8 * 2 * DFF;
    for (int idx = TIDX; idx < 2 * (DFF / 8); idx += 512) { const int i = idx / (DFF / 8), c = (idx - i * (DFF / 8)) * 8;
        float v[8]; load8f(HUL + ((size_t)(32 * b + 31) * 2 + i) * DFF + c, v); store8f(outp + ((size_t)b * 2 + i) * DFF + c, v); }
}
__device__ __forceinline__ void wg_arrive(unsigned* cnt) {
    asm volatile("s_waitcnt vmcnt(0)" ::: "memory");
    __syncthreads();
    if (TIDX == 0) { __builtin_amdgcn_fence(__ATOMIC_RELEASE, "agent"); asm volatile("s_waitcnt vmcnt(0)" ::: "memory"); (void)xb_add(cnt, 1u); }
}
__device__ __forceinline__ void poll_ge(unsigned* cnt, unsigned target) {
    unsigned sp = 0u;
    while ((unsigned)__builtin_amdgcn_readfirstlane(xb_ld(cnt)) < target) { __builtin_amdgcn_s_sleep(2); if (++sp > (1u << 16)) break; }
    __builtin_amdgcn_fence(__ATOMIC_ACQUIRE, "agent");
    asm volatile("s_waitcnt vmcnt(0)" ::: "memory");
}
__device__ __forceinline__ void wg_wait(unsigned* cnt, unsigned target) {
    if (TIDX < 64) poll_ge(cnt, target);
    __syncthreads();
}
struct OneUnit {
    int pm, pn;
    __device__ __forceinline__ bool next(int i, pg8::Unit& u) const { if (i != 0) return false; u.pm = pm; u.pn = pn; u.idx = 0; return true; }
    __device__ __forceinline__ void a_ready(const pg8::Unit&) const {}
    __device__ __forceinline__ void done(const pg8::Unit&) const {}
};
struct TailOrder {
    pg8::StaticOrder so; int nmain, nN, c; unsigned* cntB; float* rt; const float* ss;
    __device__ __forceinline__ void init(int N, int c_, unsigned* cntB_, float* rt_, const float* ss_) { so.init(NPR, N, 256, c_); nmain = so.nwg; nN = N / 256; c = c_; cntB = cntB_; rt = rt_; ss = ss_; }
    __device__ __forceinline__ bool next(int i, pg8::Unit& u) const {
        const int total = nmain + nN, jf = total >> 8, rem = total & 255;
        long L;
        if (c >= 252) { L = (long)(i + 2) * 256 + c; if (L >= total) return false; }
        else if (i < jf || (i == jf && c < rem)) L = (long)i * 256 + c;
        else if (i == jf && c < rem + 8) { const int hh = c - rem; L = (long)(hh >> 2) * 256 + 252 + (hh & 3); }
        else return false;
        if (L < nmain) so.at(L, u); else { u.pm = 64; u.pn = (int)(L - nmain); }
        u.idx = i; return true;
    }
    __device__ __forceinline__ void a_ready(const pg8::Unit& u) const {
        if (u.pm == 64) {
            if (TIDX < 64) poll_ge(cntB, 4u);
            asm volatile("" ::: "memory"); __builtin_amdgcn_s_barrier(); asm volatile("" ::: "memory");
            if (TIDX < 256) rt[u.idx * 256 + TIDX] = rstd_of(ss + (size_t)(64 * 256 + TIDX) * 16);
        }
    }
    __device__ __forceinline__ void done(const pg8::Unit&) const {}
};
__device__ __forceinline__ void run_resid_gemm(const Params& p, int fix_layer, LAS unsigned char* lds, const bf16_t* A, const bf16_t* Bt, int K, bf16_t* H, float* ssn, unsigned* cntA, unsigned* cntB) {
    EpiResid E{H, ssn};
    { pg8::Gemm g{A, Bt, NPR, DM, K}; pg8::StaticOrder S; S.init(NPR, DM, (int)gridDim.x, (int)blockIdx.x);
      if (fix_layer >= 0) { pg8::Unit u0; if (S.next(0, u0)) ffnfix_strips(p, fix_layer, 4 * u0.pm, 4 * u0.pm + 4); if ((int)blockIdx.x < 8) ffn_state_prompt(p, fix_layer, (int)blockIdx.x);
                            asm volatile("s_waitcnt vmcnt(0)" ::: "memory"); __syncthreads(); }
      pg8::gemm_phase<EpiResid, pg8::StaticOrder, false, true>(lds, g, S, E); }
    wg_arrive(cntA);
    if ((int)blockIdx.x >= 252) {
        if (fix_layer >= 0) { ffnfix_strips(p, fix_layer, 256, 258); asm volatile("s_waitcnt vmcnt(0)" ::: "memory"); __syncthreads(); }
        pg8::Gemm g{A, Bt, MROWS, DM, K}; OneUnit S1{64, (int)blockIdx.x - 252}; pg8::gemm_phase<EpiResid, OneUnit, false, true>(lds, g, S1, E);
        wg_arrive(cntB);
    }
    wg_wait(cntA, gridDim.x);
}
template <class Epi> __device__ __forceinline__ void run_gemm_tail(LAS unsigned char* lds, const float* ss, unsigned* cntB, const bf16_t* A, const bf16_t* Bt, int N, int K, const Epi& E) {
    float* rt = (float*)((unsigned char*)lds + pg8::STAGE_BYTES);
    pg8::Gemm g{A, Bt, MROWS, N, K}; TailOrder S; S.init(N, (int)blockIdx.x, cntB, rt, ss);
    for (int i = 0;; ++i) { pg8::Unit u; if (!S.next(i, u)) break;
        if (u.pm != 64 && TIDX < 256) rt[i * 256 + TIDX] = rstd_of(ss + (size_t)(u.pm * 256 + TIDX) * 16); }
    __syncthreads();
    pg8::gemm_phase<Epi, TailOrder, true, true>(lds, g, S, E);
}
__device__ __forceinline__ void build_rstd_table(float* rt, const pg8::StaticOrder& S, const float* ss) {
    for (int i = 0;; ++i) { pg8::Unit u; if (!S.next(i, u)) break;
        if (TIDX < 256) rt[i * 256 + TIDX] = rstd_of(ss + (size_t)(u.pm * 256 + TIDX) * 16); }
    __syncthreads();
}
template <class Epi> __device__ __forceinline__ void run_gemm(LAS unsigned char* lds, const float* ss, const bf16_t* A, const bf16_t* Bt, int N, int K, const Epi& E) {
    pg8::Gemm g{A, Bt, MROWS, N, K}; pg8::StaticOrder S; S.init(MROWS, N, (int)gridDim.x, (int)blockIdx.x);
    if (ss) build_rstd_table((float*)((unsigned char*)lds + pg8::STAGE_BYTES), S, ss);
    pg8::gemm_phase<Epi, pg8::StaticOrder, true, true>(lds, g, S, E);
}

template <bool FFN_INTERLEAVE = false, bool SC_INTERLEAVE = false> __device__ __forceinline__ void transpose_item(const float* W, const float* g, int K, int N, bf16_t* WT, float* scr, int item, int lane) {
    const int nblk = N / 32, kb = item / nblk, nb = item - kb * nblk, k0 = 64 * kb, n0 = 32 * nb;
    const int d0 = SC_INTERLEAVE ? (n0 < DM ? n0 : (n0 < 2 * DM ? DM + ((n0 - DM) >> 7) * 256 + ((n0 - DM) & 127) : DM + ((n0 - 2 * DM) >> 7) * 256 + 128 + ((n0 - 2 * DM) & 127))) : !FFN_INTERLEAVE ? n0 : (n0 < DFF ? (n0 >> 7) * 256 + (n0 & 127) : ((n0 - DFF) >> 7) * 256 + 128 + ((n0 - DFF) & 127));
#pragma unroll 8
    for (int i = 0; i < 32; ++i) { const int kk = 2 * i + (lane >> 5); const float gg = g ? g[k0 + kk] : 1.0f; scr[kk * 33 + (lane & 31)] = W[(size_t)(k0 + kk) * N + n0 + (lane & 31)] * gg; }
    asm volatile("s_waitcnt lgkmcnt(0)" ::: "memory");
    const int c = lane & 7;
#pragma unroll
    for (int j = 0; j < 4; ++j) { const int n = (lane >> 3) + 8 * j; const float* s = scr + (8 * c) * 33 + n;
        u32x4 o; o.x = pk2(s[0 * 33], s[1 * 33]); o.y = pk2(s[2 * 33], s[3 * 33]); o.z = pk2(s[4 * 33], s[5 * 33]); o.w = pk2(s[6 * 33], s[7 * 33]);
        *(u32x4*)(WT + (size_t)(d0 + n) * K + k0 + 8 * c) = o; }
    asm volatile("s_waitcnt lgkmcnt(0)" ::: "memory");
}
__device__ __forceinline__ void sincos_d(double r, float& c, float& s) {
    const double r2 = r * r;
    double sc = 1.0, ss = 1.0;
#pragma unroll
    for (int k = 14; k >= 1; --k) { sc = 1.0 - sc * r2 * (1.0 / (double)((2 * k - 1) * (2 * k))); ss = 1.0 - ss * r2 * (1.0 / (double)((2 * k) * (2 * k + 1))); }
    c = (float)sc; s = (float)(ss * r);
}
__device__ __forceinline__ void prep_rows(const Params& p) {
    bf16_t* H = (bf16_t*)(p.ws + WS_H); float* SS = (float*)(p.ws + WS_SS);
    const int lane = TIDX & 63, gw = blockIdx.x * 8 + (TIDX >> 6), NW = gridDim.x * 8;
    for (int row0 = gw; row0 < MROWS; row0 += 4 * NW) {
        f32x4 v[4][4];
#pragma unroll
        for (int k = 0; k < 4; ++k) { const int row = row0 + k * NW;
            const float* src = row >= MROWS ? nullptr : (row < NPR ? p.in[I_XP] + (size_t)row * DM : (row >= SAMP0 ? p.in[I_XS] + (size_t)(row - SAMP0) * DM : (row >= META0 ? p.in[I_META] + (size_t)(row - META0) * DM : nullptr)));
#pragma unroll
            for (int j = 0; j < 4; ++j) v[k][j] = src ? *(const f32x4*)(src + lane * 4 + 256 * j) : (f32x4){0.f, 0.f, 0.f, 0.f}; }
#pragma unroll
        for (int k = 0; k < 4; ++k) { const int row = row0 + k * NW; if (row < MROWS) {
            float ss = 0.f;
#pragma unroll
            for (int j = 0; j < 4; ++j) {
                u32x2 w; w.x = pk2(v[k][j].x, v[k][j].y); w.y = pk2(v[k][j].z, v[k][j].w); *(u32x2*)(H + (size_t)row * DM + lane * 4 + 256 * j) = w;
                ss += (v[k][j].x * v[k][j].x + v[k][j].y * v[k][j].y) + (v[k][j].z * v[k][j].z + v[k][j].w * v[k][j].w); }
            ss = wave_sum(ss);
            if (lane < 16) SS[(size_t)row * 16 + lane] = lane == 0 ? ss : 0.f; } }
    }
}
__device__ __forceinline__ void phase_final(const Params& p, unsigned* cntB) {
    const bf16_t* H = (const bf16_t*)(p.ws + WS_H); const float* SS = (const float*)(p.ws + WS_SS) + (size_t)4 * MROWS * 16; const float* g = p.in[I_NFIN];
    {
        const int S = (int)gridDim.x * 512, idx0 = blockIdx.x * 512 + TIDX, c = (idx0 & 127) * 8;
        float gv[8]; load8f(g + c, gv);
        for (int idx = idx0; idx < NPR * 128; idx += 4 * S) {
            u32x4 hv[4]; f32x4 sa[4][4];
#pragma unroll
            for (int k = 0; k < 4; ++k) { const int row = (idx + k * S) >> 7; if (row < NPR) { hv[k] = *(const u32x4*)(H + (size_t)row * DM + c);
#pragma unroll
                for (int q = 0; q < 4; ++q) sa[k][q] = *(const f32x4*)(SS + (size_t)row * 16 + 4 * q); } }
#pragma unroll
            for (int k = 0; k < 4; ++k) { const int row = (idx + k * S) >> 7; if (row < NPR) {
                const float sum = ((sa[k][0].x + sa[k][0].y) + (sa[k][0].z + sa[k][0].w)) + ((sa[k][1].x + sa[k][1].y) + (sa[k][1].z + sa[k][1].w)) + ((sa[k][2].x + sa[k][2].y) + (sa[k][2].z + sa[k][2].w)) + ((sa[k][3].x + sa[k][3].y) + (sa[k][3].z + sa[k][3].w));
                const float rs = 1.0f / sqrtf(sum * (1.0f / DM) + 1e-6f);
                float v[8]; unpack8(hv[k], v);
#pragma unroll
                for (int j = 0; j < 8; ++j) v[j] = v[j] * rs * gv[j];
                store8f(p.out + OUT_YP + (size_t)row * DM + c, v); } }
        }
    }
    wg_wait(cntB, 4u);
    for (int idx = blockIdx.x * 512 + TIDX; idx < 128 * 128; idx += gridDim.x * 512) {
        const int r = idx >> 7, c = (idx & 127) * 8, row = SAMP0 + r;
        const float rs = rstd_of(SS + (size_t)row * 16);
        float v[8], gv[8]; unpack8(*(const u32x4*)(H + (size_t)row * DM + c), v); load8f(g + c, gv);
#pragma unroll
        for (int k = 0; k < 8; ++k) v[k] = v[k] * rs * gv[k];
        store8f(p.out + OUT_YS + (size_t)r * DM + c, v);
    }
}
template <int SET> __device__ __forceinline__ void transpose_set(const Params& p, unsigned char* shm, int first) {
    const int lane = TIDX & 63, wave = TIDX >> 6;
    if ((int)blockIdx.x < first) return;
    const int gw = ((int)blockIdx.x - first) * 8 + wave, NW = ((int)gridDim.x - first) * 8;
    float* scr = (float*)(shm + wave * 8704);
    constexpr int I0 = 16 * 192, I1 = 32 * 32, I2 = 16 * 96, I3 = 16 * 32, I4 = 16 * 176, I5 = 44 * 32;
    constexpr int NIT = SET == 0 ? I0 : (SET == 1 ? I1 + I4 : (SET == 2 ? I5 + I2 + I3 : I4 + I5));
    for (int it = gw; it < NIT; it += NW) {
        int r = it;
        if (SET == 0) { transpose_item(p.in[I_WRI], p.in[I_NMIX], DM, RIN, (bf16_t*)(p.ws + WS_WRI), scr, r, lane); }
        else if (SET == 1) {
            if (r < I1) { transpose_item(p.in[I_WRO], nullptr, VD, DM, (bf16_t*)(p.ws + WS_WRO), scr, r, lane); continue; } r -= I1;
            transpose_item<true>(p.in[I_WFI], p.in[I_NFFN], DM, 2 * DFF, (bf16_t*)(p.ws + WS_WFI), scr, r, lane);
        } else if (SET == 2) {
            if (r < I5) { transpose_item(p.in[I_WFO], nullptr, DFF, DM, (bf16_t*)(p.ws + WS_WFO), scr, r, lane); continue; } r -= I5;
            if (r < I2) { transpose_item<false, true>(p.in[I_WSI], p.in[I_NMIX] + DM, DM, 3072, (bf16_t*)(p.ws + WS_WSI), scr, r, lane); continue; } r -= I2;
            transpose_item(p.in[I_WSO], nullptr, DM, DM, (bf16_t*)(p.ws + WS_WSO), scr, r, lane);
        } else {
            if (r < I4) { transpose_item<true>(p.in[I_WFI] + (size_t)DM * 2 * DFF, p.in[I_NFFN] + DM, DM, 2 * DFF, (bf16_t*)(p.ws + WS_WFI) + (size_t)2 * DFF * DM, scr, r, lane); continue; } r -= I4;
            transpose_item(p.in[I_WFO] + (size_t)DFF * DM, nullptr, DFF, DM, (bf16_t*)(p.ws + WS_WFO) + (size_t)DM * DFF, scr, r, lane);
        }
    }
}
__device__ __forceinline__ void phase_prep(const Params& p, unsigned char* shm) {
    transpose_set<0>(p, shm, 0);
    float* rope = (float*)(p.ws + WS_ROPE);
    for (int i = blockIdx.x * 512 + TIDX; i < 2065 * 128; i += gridDim.x * 512) {
        const int pi = i >> 7, fi = i & 127; const double pos = pi == 2064 ? 16384.0 : (double)pi;
        const double y = -(double)fi * 0.10462765653188542;
        const double nn = rint(y), f = (y - nn) * 0.6931471805599453;
        double e = 1.0;
#pragma unroll
        for (int k = 18; k >= 1; --k) e = 1.0 + e * f * (1.0 / (double)k);
        const double inv = e / (double)(1 << (int)(-nn));
        const double ang = pos * inv; const double kk = rint(ang * 0.15915494309189535); const double rr = ang - kk * 6.283185307179586;
        float c, s; sincos_d(rr, c, s);
        *(f32x2*)(rope + (size_t)i * 2) = (f32x2){c, s};
    }
    prep_rows(p);
}

#define TR_READ2(r0, r1, base, OFF0, OFF1) asm volatile("ds_read_b64_tr_b16 %0, %2 offset:%3\n\tds_read_b64_tr_b16 %1, %2 offset:%4" : "=&v"(r0), "=&v"(r1) : "v"(base), "i"(OFF0), "i"(OFF1) : "memory")
#define MFMA16(a, b, c) __builtin_amdgcn_mfma_f32_16x16x32_bf16((a), (b), (c), 0, 0, 0)
__device__ __forceinline__ bf16x8 cat4(s16x4 a, s16x4 b) { return __builtin_shufflevector(a, b, 0, 1, 2, 3, 4, 5, 6, 7); }

__device__ __forceinline__ void retention_prompt(const Params& p, unsigned char* shm, int item) {
    const int b = item >> 5, h = (item >> 3) & 3, dvb = item & 7;
    const int tid = TIDX, w = __builtin_amdgcn_readfirstlane(tid >> 6), lane = tid & 63, fr = lane & 15, fq = lane >> 4, tq = (lane & 15) >> 2, tp = lane & 3;
    const bf16_t* PROJ = (const bf16_t*)(p.ws + WS_PROJ); bf16_t* O = (bf16_t*)(p.ws + WS_O); f32x2* STATS = (f32x2*)(p.ws + WS_STATS);
    constexpr int KRS = 528, VRS = 160  , OFF_V = 128 * KRS, OFF_VS = OFF_V + 128 * VRS, OFF_ST = OFF_VS + 128 * VRS;
    unsigned char* Kl = shm; unsigned char* Vl = shm + OFF_V; unsigned char* Vs = shm + OFF_VS; unsigned char* Stl = shm + OFF_ST;
    const unsigned lbase = (unsigned)(size_t)shm;
    const float lg2 = h == 0 ? -0.04580368961312479f : (h == 1 ? -0.02272007650008353f : (h == 2 ? -0.011315313227834146f : -0.005646563141142063f));
    const float g128 = __builtin_amdgcn_exp2f(lg2 * 128.0f);
    f32x4 sacc[2][4];
#pragma unroll
    for (int j = 0; j < 2; ++j)
#pragma unroll
        for (int eb = 0; eb < 4; ++eb) sacc[j][eb] = (f32x4){0.f, 0.f, 0.f, 0.f};
    const int nloc = 16 * w + fr;
    const unsigned trV_in = lbase + OFF_V + (4 * fq + tq) * VRS + 8 * tp, trV_up = lbase + OFF_VS + (4 * fq + tq) * VRS + 8 * tp, trK_up = lbase + (4 * fq + tq) * KRS + 64 * w + 8 * tp;
    const unsigned koff = (unsigned)((tid >> 5) * RIN + (tid & 31) * 8) * 2u, voff = (unsigned)((tid >> 3) * RIN + (tid & 7) * 8) * 2u, qoff = (unsigned)(nloc * RIN + fq * 8) * 2u;
    u32x4 kpre[8], vpre[2]; bf16x8 qf[8];
    {
        const char* base = (const char*)(PROJ + (size_t)NPR * RIN);
#pragma unroll
        for (int i = 0; i < 8; ++i) kpre[i] = *(const u32x4*)(base + (size_t)(1024 + h * 256 + i * 16 * RIN) * 2 + koff);
#pragma unroll
        for (int i = 0; i < 2; ++i) vpre[i] = *(const u32x4*)(base + (size_t)(2048 + h * 512 + dvb * 64 + i * 64 * RIN) * 2 + voff);
#pragma unroll
        for (int ks = 0; ks < 8; ++ks) qf[ks] = *(const bf16x8*)(base + (size_t)(h * 256 + ks * 32) * 2 + qoff);
    }
    for (int c = -1; c < 16; ++c) {
        float lg2c = lg2; asm volatile("" : "+v"(lg2c));
        const int rowbase = c < 0 ? NPR : b * 2048 + c * 128;
        const char* nbase = (const char*)(PROJ + (size_t)(b * 2048 + (c + 1) * 128) * RIN);
        __syncthreads();
#pragma unroll
        for (int i = 0; i < 8; ++i) { const int ch = tid + 512 * i, r = ch >> 5, cc = ch & 31; *(u32x4*)(Kl + r * KRS + cc * 16) = kpre[i]; }
#pragma unroll
        for (int i = 0; i < 2; ++i) { const int ch = tid + 512 * i, r = ch >> 3, cc = ch & 7;
            *(u32x4*)(Vl + r * VRS + cc * 16) = vpre[i];
            const float kd = __builtin_amdgcn_exp2f(lg2c * (float)(127 - r));
            float f[8]; unpack8(vpre[i], f);
#pragma unroll
            for (int k = 0; k < 8; ++k) f[k] *= kd;
            *(u32x4*)(Vs + r * VRS + cc * 16) = pack8(f); }
#pragma unroll
        for (int j = 0; j < 2; ++j)
#pragma unroll
            for (int eb = 0; eb < 4; ++eb) { u32x2 wv; wv.x = pk2(sacc[j][eb].x, sacc[j][eb].y); wv.y = pk2(sacc[j][eb].z, sacc[j][eb].w);
                *(u32x2*)(Stl + (16 * eb + fr) * KRS + (16 * (2 * w + j) + 4 * fq) * 2) = wv; }
        if (c < 15) {
#pragma unroll
            for (int i = 0; i < 8; ++i) kpre[i] = *(const u32x4*)(nbase + (size_t)(1024 + h * 256 + i * 16 * RIN) * 2 + koff);
#pragma unroll
            for (int i = 0; i < 2; ++i) vpre[i] = *(const u32x4*)(nbase + (size_t)(2048 + h * 512 + dvb * 64 + i * 64 * RIN) * 2 + voff);
        }
        __syncthreads();
        f32x4 oacc[4];
#pragma unroll
        for (int eb = 0; eb < 4; ++eb) {
            oacc[eb] = (f32x4){0.f, 0.f, 0.f, 0.f};
            if (c >= 0) {
#pragma unroll
            for (int ks = 0; ks < 8; ++ks) { const bf16x8 sf = *(const bf16x8*)(Stl + (16 * eb + fr) * KRS + (ks * 32 + fq * 8) * 2); oacc[eb] = MFMA16(sf, qf[ks], oacc[eb]); }
            }
        }
        const float cd = __builtin_amdgcn_exp2f(lg2c * (float)(nloc + 1));
#pragma unroll
        for (int eb = 0; eb < 4; ++eb) oacc[eb] = oacc[eb] * cd;
        __builtin_amdgcn_sched_barrier(0);
#pragma unroll
        for (int s = 0; s < 4; ++s) {
            if (2 * s <= w && (c >= 0 || s == 3)) {
                f32x4 p0 = (f32x4){0.f, 0.f, 0.f, 0.f}, p1 = (f32x4){0.f, 0.f, 0.f, 0.f};
#pragma unroll
                for (int ks = 0; ks < 8; ++ks) {
                    const bf16x8 k0 = *(const bf16x8*)(Kl + (32 * s + fr) * KRS + (ks * 32 + fq * 8) * 2), k1 = *(const bf16x8*)(Kl + (32 * s + 16 + fr) * KRS + (ks * 32 + fq * 8) * 2);
                    p0 = MFMA16(k0, qf[ks], p0); p1 = MFMA16(k1, qf[ks], p1);
                }
                float v[8];
#pragma unroll
                for (int t = 0; t < 4; ++t) { const int d0 = nloc - (32 * s + 4 * fq + t), d1 = d0 - 16;
                    v[t] = d0 >= 0 ? p0[t] * __builtin_amdgcn_exp2f(lg2c * (float)d0) : 0.f;
                    v[4 + t] = d1 >= 0 ? p1[t] * __builtin_amdgcn_exp2f(lg2c * (float)d1) : 0.f; }
                const u32x4 wv = pack8(v); const bf16x8 pf = __builtin_bit_cast(bf16x8, wv);
                s16x4 r[4][2];
#pragma unroll
                for (int eb = 0; eb < 4; ++eb) {
                    TR_READ2(r[eb][0], r[eb][1], trV_in, 32 * s * VRS + 32 * eb, (32 * s + 16) * VRS + 32 * eb);
                }
                asm volatile("s_waitcnt lgkmcnt(0)" : "+v"(r[0][0]), "+v"(r[0][1]), "+v"(r[1][0]), "+v"(r[1][1]), "+v"(r[2][0]), "+v"(r[2][1]), "+v"(r[3][0]), "+v"(r[3][1]) :: "memory");
#pragma unroll
                for (int eb = 0; eb < 4; ++eb) oacc[eb] = MFMA16(cat4(r[eb][0], r[eb][1]), pf, oacc[eb]);
            }
            __builtin_amdgcn_sched_barrier(0);
        }
        asm volatile("" ::: "memory");
        if (c < 15) {
#pragma unroll
            for (int ks = 0; ks < 8; ++ks) qf[ks] = *(const bf16x8*)(nbase + (size_t)(h * 256 + ks * 32) * 2 + qoff);
        }
        if (c >= 0 || b == 0) {
            float s1 = 0.f, s2 = 0.f;
#pragma unroll
            for (int eb = 0; eb < 4; ++eb) {
                const f32x4 o = oacc[eb];
                s1 += (o.x + o.y) + (o.z + o.w); s2 += (o.x * o.x + o.y * o.y) + (o.z * o.z + o.w * o.w);
                u32x2 wv; wv.x = pk2(o.x, o.y); wv.y = pk2(o.z, o.w);
                *(u32x2*)(O + (size_t)(rowbase + nloc) * VD + h * 512 + dvb * 64 + 16 * eb + 4 * fq) = wv;
            }
            s1 += __shfl_xor(s1, 16); s1 += __shfl_xor(s1, 32); s2 += __shfl_xor(s2, 16); s2 += __shfl_xor(s2, 32);
            if (fq == 0) STATS[((size_t)(rowbase + nloc) * 4 + h) * 8 + dvb] = (f32x2){s1, s2};
        }
#pragma unroll
        for (int j = 0; j < 2; ++j)
#pragma unroll
            for (int eb = 0; eb < 4; ++eb) sacc[j][eb] = sacc[j][eb] * g128;
        {
            s16x4 kr[2][2][2], vr[2][4][2];
#define UPD_ISSUE(bf, s_) do { _Pragma("unroll") for (int j = 0; j < 2; ++j) TR_READ2(kr[bf][j][0], kr[bf][j][1], trK_up, 32 * (s_) * KRS + 32 * j, (32 * (s_) + 16) * KRS + 32 * j); \
                               _Pragma("unroll") for (int eb = 0; eb < 4; ++eb) TR_READ2(vr[bf][eb][0], vr[bf][eb][1], trV_up, 32 * (s_) * VRS + 32 * eb, (32 * (s_) + 16) * VRS + 32 * eb); } while (0)
            UPD_ISSUE(0, 0);
#pragma unroll
            for (int s = 0; s < 4; ++s) {
                const int cb_ = s & 1;
                asm volatile("s_waitcnt lgkmcnt(0)" : "+v"(kr[cb_][0][0]), "+v"(kr[cb_][0][1]), "+v"(kr[cb_][1][0]), "+v"(kr[cb_][1][1]), "+v"(vr[cb_][0][0]), "+v"(vr[cb_][0][1]), "+v"(vr[cb_][1][0]), "+v"(vr[cb_][1][1]), "+v"(vr[cb_][2][0]), "+v"(vr[cb_][2][1]), "+v"(vr[cb_][3][0]), "+v"(vr[cb_][3][1]) :: "memory");
                if (s < 3) UPD_ISSUE(cb_ ^ 1, s + 1);
#pragma unroll
                for (int j = 0; j < 2; ++j)
#pragma unroll
                    for (int eb = 0; eb < 4; ++eb) sacc[j][eb] = MFMA16(cat4(kr[cb_][j][0], kr[cb_][j][1]), cat4(vr[cb_][eb][0], vr[cb_][eb][1]), sacc[j][eb]);
                __builtin_amdgcn_sched_barrier(0);
            }
#undef UPD_ISSUE
        }
    }
    float* RP = p.out + OUT_RETP + (size_t)(b * 4 + h) * 256 * 512;
#pragma unroll
    for (int j = 0; j < 2; ++j)
#pragma unroll
        for (int eb = 0; eb < 4; ++eb) {
            const int d0 = 16 * (2 * w + j) + 4 * fq, e = dvb * 64 + 16 * eb + fr;
            RP[(size_t)(d0 + 0) * 512 + e] = sacc[j][eb].x; RP[(size_t)(d0 + 1) * 512 + e] = sacc[j][eb].y; RP[(size_t)(d0 + 2) * 512 + e] = sacc[j][eb].z; RP[(size_t)(d0 + 3) * 512 + e] = sacc[j][eb].w;
        }
}
__device__ __forceinline__ void retention_sample(const Params& p, unsigned char* shm, int item) {
    const int b = item >> 2, h = item & 3, row = SAMP0 + b, tid = TIDX, lane = tid & 63, w = tid >> 6;
    const bf16_t* PROJ = (const bf16_t*)(p.ws + WS_PROJ); bf16_t* O = (bf16_t*)(p.ws + WS_O); f32x2* STATS = (f32x2*)(p.ws + WS_STATS);
    float* qs = (float*)shm; float* ks = qs + 256; float* red = ks + 256; float* opart = red + 32;
    const float gamma = 1.0f - (h == 0 ? 0.03125f : (h == 1 ? 0.015625f : (h == 2 ? 0.0078125f : 0.00390625f)));
    const bf16_t* prow = PROJ + (size_t)row * RIN;
    __syncthreads();
    if (tid < 256) {
        const float q = __uint_as_float((unsigned)prow[h * 256 + tid] << 16), k = __uint_as_float((unsigned)prow[1024 + h * 256 + tid] << 16);
        qs[tid] = q; ks[tid] = k;
        const float pr = wave_sum(q * k);
        if (lane == 0) red[w] = pr;
    }
    __syncthreads();
    const float qk = (red[0] + red[1]) + (red[2] + red[3]);
    const int e4 = (tid & 127) * 4, dsub = tid >> 7;
    const u32x2 vw = *(const u32x2*)(prow + 2048 + h * 512 + e4);
    const f32x4 v4 = (f32x4){bflo(vw.x), bfhi(vw.x), bflo(vw.y), bfhi(vw.y)};
    const float* Sp = p.in[I_SRET] + (size_t)(b * 4 + h) * 256 * 512 + e4;
    float* Sn = p.out + OUT_RETS + (size_t)(b * 4 + h) * 256 * 512 + e4;
    f32x4 oa = (f32x4){0.f, 0.f, 0.f, 0.f};
    f32x4 cur[16], nxt[16];
#pragma unroll
    for (int j = 0; j < 16; ++j) cur[j] = __builtin_nontemporal_load((const f32x4*)(Sp + (size_t)(dsub + 4 * j) * 512));
#pragma unroll
    for (int bt = 0; bt < 4; ++bt) {
        if (bt < 3) {
#pragma unroll
            for (int j = 0; j < 16; ++j) nxt[j] = __builtin_nontemporal_load((const f32x4*)(Sp + (size_t)(dsub + 4 * (16 * (bt + 1) + j)) * 512));
        }
#pragma unroll
        for (int j = 0; j < 16; ++j) {
            const int d = dsub + 4 * (16 * bt + j);
            const float qd = qs[d], kd = ks[d];
            oa = oa + cur[j] * qd;
            const f32x4 sn = cur[j] * gamma + v4 * kd;
            __builtin_nontemporal_store(sn, (f32x4*)(Sn + (size_t)d * 512));
        }
#pragma unroll
        for (int j = 0; j < 16; ++j) cur[j] = nxt[j];
    }
    *(f32x4*)(opart + dsub * 512 + e4) = oa;
    __syncthreads();
    const float ve = __uint_as_float((unsigned)prow[2048 + h * 512 + tid] << 16);
    const float o = gamma * ((opart[tid] + opart[512 + tid]) + (opart[1024 + tid] + opart[1536 + tid])) + qk * ve;
    O[(size_t)row * VD + h * 512 + tid] = (bf16_t)(pk2(o, 0.f) & 0xffffu);
    const float s1 = wave_sum(o), s2 = wave_sum(o * o);
    if (lane == 0) { red[8 + w] = s1; red[16 + w] = s2; }
    __syncthreads();
    if (tid < 8) {
        float a = 0.f, c = 0.f;
        if (tid == 0) {
#pragma unroll
            for (int i = 0; i < 8; ++i) { a += red[8 + i]; c += red[16 + i]; }
        }
        STATS[((size_t)row * 4 + h) * 8 + tid] = (f32x2){a, c};
    }
}
__device__ __forceinline__ void phase_retention(const Params& p, unsigned char* shm) {
    const bool stream_first = ((blockIdx.x >> 3) & 1) != 0;
    if (stream_first) { for (int item = blockIdx.x; item < 512; item += gridDim.x) retention_sample(p, shm, item); }
    __syncthreads();
    for (int item = blockIdx.x; item < 256; item += gridDim.x) retention_prompt(p, shm, item);
    __syncthreads();
    if (!stream_first) { for (int item = blockIdx.x; item < 512; item += gridDim.x) retention_sample(p, shm, item); }
}
__device__ __forceinline__ void phase_gatenorm(const Params& p) {
    const bf16_t* PROJ = (const bf16_t*)(p.ws + WS_PROJ); const bf16_t* O = (const bf16_t*)(p.ws + WS_O); const float* STATS = (const float*)(p.ws + WS_STATS); bf16_t* Y = (bf16_t*)(p.ws + WS_Y0);
    const int lane = TIDX & 63, gw = blockIdx.x * 8 + (TIDX >> 6), NW = gridDim.x * 8;
    for (int it0 = gw * 4; it0 < MROWS * 4; it0 += NW * 4) {
        u32x4 ow[4], gwv[4]; f32x4 sa[4], sb[4], sc[4], sd[4];
#pragma unroll
        for (int q = 0; q < 4; ++q) { const int it = it0 + q, row = it >> 2, h = it & 3; const float* st = STATS + (size_t)it * 16;
            sa[q] = *(const f32x4*)st; sb[q] = *(const f32x4*)(st + 4); sc[q] = *(const f32x4*)(st + 8); sd[q] = *(const f32x4*)(st + 12);
            ow[q] = *(const u32x4*)(O + (size_t)row * VD + h * 512 + lane * 8); gwv[q] = *(const u32x4*)(PROJ + (size_t)row * RIN + 4096 + h * 512 + lane * 8); }
#pragma unroll
        for (int q = 0; q < 4; ++q) { const int it = it0 + q, row = it >> 2, h = it & 3;
            const float s1 = (sa[q].x + sa[q].z) + (sb[q].x + sb[q].z) + (sc[q].x + sc[q].z) + (sd[q].x + sd[q].z), s2 = (sa[q].y + sa[q].w) + (sb[q].y + sb[q].w) + (sc[q].y + sc[q].w) + (sd[q].y + sd[q].w);
            const float mu = s1 * (1.0f / 512.0f); float var = s2 * (1.0f / 512.0f) - mu * mu; var = var > 0.f ? var : 0.f;
            const float rstd = 1.0f / sqrtf(var + 1e-6f);
            float of[8], gf[8], y[8]; unpack8(ow[q], of); unpack8(gwv[q], gf);
#pragma unroll
            for (int k = 0; k < 8; ++k) y[k] = silu_f(gf[k]) * ((of[k] - mu) * rstd);
            *(u32x4*)(Y + (size_t)row * VD + h * 512 + lane * 8) = pack8(y); }
    }
}
__device__ __forceinline__ void prev_rows(int row, int& p1, int& p2) {
    if (row < NPR) { const int t = row & 2047; p1 = t >= 1 ? row - 1 : SAMP0 - 1; p2 = t >= 2 ? row - 2 : (t == 1 ? SAMP0 - 1 : SAMP0 - 2); }
    else { p1 = row - 1; p2 = row - 2; }
}
__device__ __forceinline__ void seg_rows(int seg, int& r0, int& h1, int& h2) {
    if (seg < 2048) { r0 = seg * 8; if ((r0 & 2047) == 0) { h1 = SAMP0 - 1; h2 = SAMP0 - 2; } else { h1 = r0 - 1; h2 = r0 - 2; } }
    else { r0 = META0 + (seg - 2048) * 8; if (seg == 2048) { h1 = -1; h2 = -1; } else { h1 = r0 - 1; h2 = r0 - 2; } }
}
constexpr int NSEG = 2050;
__device__ __forceinline__ void phase_scconv(const Params& p) {
    const bf16_t* SC = (const bf16_t*)(p.ws + WS_PROJ); bf16_t* Y = (bf16_t*)(p.ws + WS_Y0);
    const float* cw = p.in[I_WSC]; const float* sin_ = p.in[I_SCONV];
    float* outp = p.out + OUT_CONVP; float* outs = p.out + OUT_CONVS;
    constexpr int CG = DM / 8, LD = 2 * DM;
    const int total = (NSEG + 128) * CG;
    for (int idx = blockIdx.x * 512 + TIDX; idx < total; idx += gridDim.x * 512) {
        const int seg = idx / CG, c = (idx - seg * CG) * 8;
        float w0[8], w1[8], w2[8], u1[8], u2[8];
        load8f(cw + c, w0); load8f(cw + DM + c, w1); load8f(cw + 2 * DM + c, w2);
        if (seg >= NSEG) {
            const int b = seg - NSEG, row = SAMP0 + b; float u0[8], bg[8], y[8];
            unpack8(*(const u32x4*)(SC + (size_t)row * LD + c), bg); unpack8(*(const u32x4*)(SC + (size_t)row * LD + DM + c), u0);
            load8f(sin_ + ((size_t)b * 2 + 1) * DM + c, u1); load8f(sin_ + ((size_t)b * 2 + 0) * DM + c, u2);
            store8f(outs + ((size_t)b * 2 + 0) * DM + c, u1); store8f(outs + ((size_t)b * 2 + 1) * DM + c, u0);
#pragma unroll
            for (int k = 0; k < 8; ++k) y[k] = bg[k] * (w0[k] * u2[k] + w1[k] * u1[k] + w2[k] * u0[k]);
            *(u32x4*)(Y + (size_t)row * DM + c) = pack8(y);
            continue;
        }
        int r0, h1, h2; seg_rows(seg, r0, h1, h2);
        u32x4 bw[8], uw[8];
#pragma unroll
        for (int i = 0; i < 8; ++i) { bw[i] = *(const u32x4*)(SC + (size_t)(r0 + i) * LD + c); uw[i] = *(const u32x4*)(SC + (size_t)(r0 + i) * LD + DM + c); }
        if (h1 >= 0) { unpack8(*(const u32x4*)(SC + (size_t)h1 * LD + DM + c), u1); unpack8(*(const u32x4*)(SC + (size_t)h2 * LD + DM + c), u2); }
        else {
#pragma unroll
            for (int k = 0; k < 8; ++k) { u1[k] = 0.f; u2[k] = 0.f; } }
#pragma unroll
        for (int i = 0; i < 8; ++i) {
            float u0[8], bg[8], y[8]; unpack8(bw[i], bg); unpack8(uw[i], u0);
#pragma unroll
            for (int k = 0; k < 8; ++k) { y[k] = bg[k] * (w0[k] * u2[k] + w1[k] * u1[k] + w2[k] * u0[k]); u2[k] = u1[k]; u1[k] = u0[k]; }
            *(u32x4*)(Y + (size_t)(r0 + i) * DM + c) = pack8(y);
            if (i >= 6 && seg < 2048 && (seg & 255) == 255) store8f(outp + ((size_t)(seg >> 8) * 2 + (i - 6)) * DM + c, u0);
        }
    }
}

constexpr int NPH = 15;
__global__ __launch_bounds__(512, 2) void fwd_megakernel(Params p) {
    extern __shared__ __attribute__((aligned(16))) unsigned char shm[];
    LAS unsigned char* lds = (LAS unsigned char*)shm;
    cg::grid_group grid = cg::this_grid();
    const bf16_t* H = (const bf16_t*)(p.ws + WS_H); const bf16_t* Y = (const bf16_t*)(p.ws + WS_Y);
    bf16_t* PROJ = (bf16_t*)(p.ws + WS_PROJ);
#define PH_BEGIN(k) if (p.ph_lo <= (k) && (k) < p.ph_hi) {
#define PH_END(k) if ((k) + 1 < p.ph_hi) xcd_barrier(xb); }
    float* SS = (float*)(p.ws + WS_SS); bf16_t* Hw = (bf16_t*)(p.ws + WS_H);
    volatile LAS unsigned* xst = (volatile LAS unsigned*)(lds + LDS_BYTES - 16);
    if (TIDX == 0) { xst[0] = 0u; xst[1] = 0u; }
    __syncthreads();
    const XcdBarrier xb = xcd_barrier_post((unsigned*)(p.ws + WS_BAR), xst);
    if (p.ph_hi < 0) grid.sync();
    unsigned* HC = (unsigned*)(p.ws + WS_BAR) + 3520;
    const bf16_t* Y0 = (const bf16_t*)(p.ws + WS_Y0);
#define PH_NOBAR(k) }
    PH_BEGIN(0) phase_prep(p, shm); PH_END(0)
    PH_BEGIN(1) { EpiRetIn E{PROJ, (const float*)(p.ws + WS_ROPE), (const float*)(shm + pg8::STAGE_BYTES)}; run_gemm(lds, SS, H, (const bf16_t*)(p.ws + WS_WRI), RIN, DM, E);
                  transpose_set<1>(p, shm, 24); transpose_set<2>(p, shm, 24); transpose_set<3>(p, shm, 24); } PH_END(1)
    PH_BEGIN(2) phase_retention(p, shm); PH_END(2)
    PH_BEGIN(3) phase_gatenorm(p); PH_END(3)
    PH_BEGIN(4) run_resid_gemm(p, -1, lds, Y0, (const bf16_t*)(p.ws + WS_WRO), VD, Hw, SS + (size_t)MROWS * 16, HC, HC + 64); PH_NOBAR(4)
    PH_BEGIN(5) { EpiFfn E{(bf16_t*)(p.ws + WS_Y), (const float*)(shm + pg8::STAGE_BYTES), (float*)(p.ws + WS_O), p.in[I_WFC], p.in[I_BFC], p.in[I_SFFN], p.out + OUT_FFNS}; run_gemm_tail(lds, SS + (size_t)MROWS * 16, HC + 64, H, (const bf16_t*)(p.ws + WS_WFI), 2 * DFF, DM, E); } PH_END(5)
    PH_BEGIN(7) run_resid_gemm(p, 0, lds, Y, (const bf16_t*)(p.ws + WS_WFO), DFF, Hw, SS + (size_t)2 * MROWS * 16, HC + 128, HC + 192); PH_NOBAR(7)
    PH_BEGIN(8) { EpiSc E{PROJ, (const float*)(shm + pg8::STAGE_BYTES)}; run_gemm_tail(lds, SS + (size_t)2 * MROWS * 16, HC + 192, H, (const bf16_t*)(p.ws + WS_WSI), 3 * DM, DM, E); } PH_END(8)
    PH_BEGIN(9) phase_scconv(p); PH_END(9)
    PH_BEGIN(10) run_resid_gemm(p, -1, lds, Y0, (const bf16_t*)(p.ws + WS_WSO), DM, Hw, SS + (size_t)3 * MROWS * 16, HC + 256, HC + 320); PH_NOBAR(10)
    PH_BEGIN(11) { EpiFfn E{(bf16_t*)(p.ws + WS_Y), (const float*)(shm + pg8::STAGE_BYTES), (float*)(p.ws + WS_O), p.in[I_WFC] + 3 * DFF, p.in[I_BFC] + DFF, p.in[I_SFFN] + (size_t)128 * 2 * DFF, p.out + OUT_FFNS + (size_t)128 * 2 * DFF}; run_gemm_tail(lds, SS + (size_t)3 * MROWS * 16, HC + 320, H, (const bf16_t*)(p.ws + WS_WFI) + (size_t)2 * DFF * DM, 2 * DFF, DM, E); } PH_END(11)
    PH_BEGIN(13) run_resid_gemm(p, 1, lds, Y, (const bf16_t*)(p.ws + WS_WFO) + (size_t)DM * DFF, DFF, Hw, SS + (size_t)4 * MROWS * 16, HC + 384, HC + 448); PH_NOBAR(13)
    PH_BEGIN(14) phase_final(p, HC + 448); PH_END(14)
}

extern "C" void kernel_launch(void* const* d_in, const int* in_sizes, int n_in, void* d_out, int out_size, void* d_ws, size_t ws_size, hipStream_t stream) {
    static int grid = 0;
    if (grid == 0) {
        if (n_in != 18 || ws_size < WS_END) { fprintf(stderr, "kernel_launch: unexpected n_in %d or ws_size %zu (< %zu)\n", n_in, ws_size, (size_t)WS_END); grid = -1; return; }
        int dev = 0, cus = 0, per_cu = 0;
        hipGetDevice(&dev); hipDeviceGetAttribute(&cus, hipDeviceAttributeMultiprocessorCount, dev);
        if (hipFuncSetAttribute((const void*)fwd_megakernel, hipFuncAttributeMaxDynamicSharedMemorySize, LDS_BYTES) != hipSuccess) fprintf(stderr, "kernel_launch: hipFuncSetAttribute failed\n");
        if (hipOccupancyMaxActiveBlocksPerMultiprocessor(&per_cu, (const void*)fwd_megakernel, 512, LDS_BYTES) != hipSuccess || per_cu < 1) { fprintf(stderr, "kernel_launch: occupancy query gave %d\n", per_cu); per_cu = 1; }
        (void)hipGetLastError();
        if (cus != 256) fprintf(stderr, "kernel_launch: note: %d CUs reported; the phase schedule is built for 256 workgroups (one per CU)\n", cus);
        grid = 256;
    }
    if (grid < 0) return;
    if (hipMemsetAsync((char*)d_ws + WS_BAR, 0, 16384, stream) != hipSuccess) fprintf(stderr, "kernel_launch: memset of barrier words failed\n");
    Params p{};
    for (int i = 0; i < 18; ++i) p.in[i] = (const float*)d_in[i];
    p.out = (float*)d_out; p.ws = (unsigned char*)d_ws; p.ph_lo = 0; p.ph_hi = NPH;
#if defined(MK_MULTI)
    for (int ph = 0; ph < NPH; ++ph) { p.ph_lo = ph; p.ph_hi = ph + 1; hipLaunchKernelGGL(fwd_megakernel, dim3(grid), dim3(512), LDS_BYTES, stream, p); }
#else
    void* args[] = {&p};
    hipError_t e = hipLaunchCooperativeKernel((const void*)fwd_megakernel, dim3(grid), dim3(512), args, LDS_BYTES, stream);
    if (e != hipSuccess) fprintf(stderr, "cooperative launch failed: %s (grid %d)\n", hipGetErrorString(e), grid);
#endif
}
```

```cpp
#include <hip/hip_runtime.h>
#include <hip/hip_cooperative_groups.h>
#include <cstdio>
#include <cstdint>
namespace cg = cooperative_groups;
__device__ __forceinline__ int launder_tid() { int t = (int)threadIdx.x; asm volatile("" : "+v"(t)); return t; }
#define TIDX launder_tid()

namespace pg8 {
#define PG8_LAS __attribute__((address_space(3)))
typedef unsigned short bf16_t;
typedef short bf16x8 __attribute__((ext_vector_type(8)));
typedef float f32x4 __attribute__((ext_vector_type(4)));
typedef unsigned u32x4 __attribute__((ext_vector_type(4)));
constexpr int BM = 256, BK = 64, HALF = 128, HTB = HALF * BK * 2  , STAGE_BYTES = 8 * HTB, NXCD = 8, WGM = 2;

__host__ __device__ __forceinline__ int lds_byte(int r, int c) { const int st = (r >> 4) * 2 + (c >> 5), rr = r & 15, cc = c & 31, ob = rr * 64 + cc * 2; return st * 1024 + (ob ^ (((ob >> 9) & 1) << 5)); }
__host__ __device__ __forceinline__ void stage_rc(int b, int& R, int& C) { const int st = b / 1024, sb = b % 1024, swz = sb ^ (((sb >> 9) & 1) << 5); R = (st >> 1) * 16 + swz / 64; C = (st & 1) * 32 + (swz % 64) / 2; }
__host__ __device__ __forceinline__ int perm32(int rho) { const int n = rho >> 4, i = rho & 15; return 8 * (i >> 2) + 4 * n + (i & 3); }

struct Unit { int pm, pn, idx; };
struct Gemm { const bf16_t* A; const bf16_t* Bt; int M, N, K; };

struct StaticOrder {
    int nM, nN, nwg, G, c;
    __host__ __device__ void init(int M, int N, int G_, int c_) { nM = M / BM; nN = N / BM; nwg = nM * nN; G = G_; c = c_; }
    __host__ __device__ bool next(int i, Unit& u) const {
        const long L = (long)i * G + c; if (L >= nwg) return false;
        int wgid = (int)L; { const int q = nwg / NXCD, r = nwg % NXCD, xcd = wgid % NXCD, off = wgid / NXCD; wgid = (xcd < r ? xcd * (q + 1) : r * (q + 1) + (xcd - r) * q) + off; }
        const int nig = WGM * nN, gid = wgid / nig, fm = gid * WGM, gsz = (nM - fm) < WGM ? (nM - fm) : WGM;
        u.pm = fm + ((wgid % nig) % gsz); u.pn = (wgid % nig) / gsz; u.idx = i; return true;
    }
    __host__ __device__ bool at(long L, Unit& u) const {
        if (L >= nwg) return false;
        int wgid = (int)L; { const int q = nwg / NXCD, r = nwg % NXCD, xcd = wgid % NXCD, off = wgid / NXCD; wgid = (xcd < r ? xcd * (q + 1) : r * (q + 1) + (xcd - r) * q) + off; }
        const int nig = WGM * nN, gid = wgid / nig, fm = gid * WGM, gsz = (nM - fm) < WGM ? (nM - fm) : WGM;
        u.pm = fm + ((wgid % nig) % gsz); u.pn = (wgid % nig) / gsz; return true;
    }
    __device__ __forceinline__ void a_ready(const Unit&) const {}
    __device__ __forceinline__ void done(const Unit&) const {}
};
__device__ __forceinline__ unsigned cvt_pk_bf16(float lo, float hi) { unsigned r; asm volatile("v_cvt_pk_bf16_f32 %0, %1, %2" : "=v"(r) : "v"(lo), "v"(hi)); return r; }

template <class Epi, class Sched, bool ALIGN_EPI = false, bool SP2 = false>
__device__ __forceinline__ void gemm_phase(PG8_LAS unsigned char* lds, const Gemm g, const Sched& S, const Epi& E) {
    const int tid = TIDX, wid = __builtin_amdgcn_readfirstlane(tid >> 6), lane = tid & 63, wr = wid >> 2, wc = wid & 3, fr = lane & 15, fq = lane >> 4;
    const int K = g.K, nt = K / BK;
    unsigned voffA[2], voffB[2];
#pragma unroll
    for (int i = 0; i < 2; ++i) { int R, C; stage_rc(tid * 16 + i * 8192, R, C); const int Rb = Epi::PERM ? ((R & ~31) + perm32(R & 31)) : R;
        voffA[i] = (unsigned)(R * K + C) * 2u; voffB[i] = (unsigned)(Rb * K + C) * 2u; }
    const size_t kstep = (size_t)(BK * 2);
    const size_t hstep = (size_t)HALF * K * 2;
    const size_t tstep = 2 * hstep;
    const unsigned ldsw = (unsigned)wid * 1024u;
    const int aoff = lds_byte(wr * 64 + fr, fq * 8), boff = lds_byte(wc * 32 + fr, fq * 8);
#define PG8_SA(b, h) (((b) * 2 + (h)) * HTB)
#define PG8_SB(b, h) ((4 + (b) * 2 + (h)) * HTB)
#define PG8_STAGE(bufoff, gbase, voff) do { _Pragma("unroll") for (int _i = 0; _i < 2; ++_i) \
        __builtin_amdgcn_global_load_lds((const unsigned*)((const char*)(gbase) + (voff)[_i]), (PG8_LAS unsigned*)(lds + (bufoff) + ldsw + _i * 8192), 16, 0, 0); } while (0)
#define PG8_LDA(dst, b, h) do { _Pragma("unroll") for (int m = 0; m < 4; ++m) _Pragma("unroll") for (int k = 0; k < 2; ++k) dst[m][k] = *(const PG8_LAS bf16x8*)(lds + PG8_SA(b, h) + aoff + m * 2048 + k * 1024); } while (0)
#define PG8_LDB(dst, b, h) do { _Pragma("unroll") for (int n = 0; n < 2; ++n) _Pragma("unroll") for (int k = 0; k < 2; ++k) dst[n][k] = *(const PG8_LAS bf16x8*)(lds + PG8_SB(b, h) + boff + n * 2048 + k * 1024); } while (0)
#define PG8_MMA(ai, bj, At, Bt) do { __builtin_amdgcn_s_setprio(1); _Pragma("unroll") for (int m = 0; m < 4; ++m) _Pragma("unroll") for (int n = 0; n < 2; ++n) _Pragma("unroll") for (int k = 0; k < 2; ++k) \
        acc[ai][bj][m][n] = __builtin_amdgcn_mfma_f32_16x16x32_bf16(Bt[n][k], At[m][k], acc[ai][bj][m][n], 0, 0, 0); __builtin_amdgcn_s_setprio(0); } while (0)
#define PG8_WAIT_V(n) asm volatile("s_waitcnt vmcnt(" #n ")" ::: "memory")
#define PG8_WAIT_L(n) asm volatile("s_waitcnt lgkmcnt(" #n ")" ::: "memory")
#define PG8_BAR __builtin_amdgcn_s_barrier()
#define PG8_SCHED __builtin_amdgcn_sched_barrier(0)
    Unit cur, nxt; int ui = 0;
    if (!S.next(0, cur)) return;
    f32x4 acc[2][2][4][2];
#pragma unroll
    for (int a = 0; a < 2; ++a)
#pragma unroll
        for (int b = 0; b < 2; ++b)
#pragma unroll
            for (int m = 0; m < 4; ++m)
#pragma unroll
                for (int n = 0; n < 2; ++n) acc[a][b][m][n] = (f32x4){0.f, 0.f, 0.f, 0.f};
    bf16x8 At[4][2], B0[2][2], B1[2][2];
    const char* cA = (const char*)g.A + (size_t)cur.pm * tstep; const char* cB = (const char*)g.Bt + (size_t)cur.pn * tstep;
    S.a_ready(cur);
    if constexpr (SP2) {
        PG8_STAGE(PG8_SB(0, 0), cB, voffB); PG8_STAGE(PG8_SB(0, 1), cB + hstep, voffB); PG8_STAGE(PG8_SA(0, 0), cA, voffA); PG8_STAGE(PG8_SA(0, 1), cA + hstep, voffA);
        if (wr == 1) PG8_BAR;
        PG8_WAIT_V(2); PG8_BAR;
        PG8_STAGE(PG8_SB(1, 0), cB + kstep, voffB); PG8_STAGE(PG8_SA(1, 0), cA + kstep, voffA); PG8_STAGE(PG8_SB(1, 1), cB + hstep + kstep, voffB);
        PG8_WAIT_V(6); PG8_BAR;
    } else {
        PG8_STAGE(PG8_SB(0, 0), cB, voffB); PG8_STAGE(PG8_SA(0, 0), cA, voffA); PG8_STAGE(PG8_SB(0, 1), cB + hstep, voffB); PG8_STAGE(PG8_SA(0, 1), cA + hstep, voffA);
        if (wr == 1) PG8_BAR;
        PG8_WAIT_V(4); PG8_BAR;
        PG8_STAGE(PG8_SB(1, 0), cB + kstep, voffB); PG8_STAGE(PG8_SA(1, 0), cA + kstep, voffA); PG8_STAGE(PG8_SB(1, 1), cB + hstep + kstep, voffB);
        PG8_WAIT_V(6); PG8_BAR;
    }
    for (;;) {
        const bool has_next = S.next(ui + 1, nxt);
        const char* nA = has_next ? (const char*)g.A + (size_t)nxt.pm * tstep : cA; const char* nB = has_next ? (const char*)g.Bt + (size_t)nxt.pn * tstep : cB;
        for (int t = 0; t < nt; t += 2) {
            const bool last = (t == nt - 2);
            const char* a1 = cA + (size_t)(t + 1) * kstep;
            const char* a2 = last ? nA : cA + (size_t)(t + 2) * kstep; const char* b2 = last ? nB : cB + (size_t)(t + 2) * kstep;
            const char* a3 = a2 + kstep; const char* b3 = b2 + kstep;
            if (last && has_next) S.a_ready(nxt);
            if constexpr (SP2) {
            PG8_LDB(B0, 0, 0); PG8_LDB(B1, 0, 1); PG8_SCHED; PG8_LDA(At, 0, 0); PG8_STAGE(PG8_SA(1, 1), a1 + hstep, voffA);
            PG8_WAIT_V(8); PG8_WAIT_L(0); PG8_BAR; PG8_MMA(0, 0, At, B0); PG8_MMA(0, 1, At, B1); PG8_BAR; PG8_SCHED;
            PG8_LDA(At, 0, 1); PG8_STAGE(PG8_SB(0, 0), b2, voffB); PG8_STAGE(PG8_SB(0, 1), b2 + hstep, voffB); PG8_STAGE(PG8_SA(0, 0), a2, voffA);
            PG8_WAIT_V(8); PG8_WAIT_L(0); PG8_BAR; PG8_MMA(1, 0, At, B0); PG8_MMA(1, 1, At, B1); PG8_BAR; PG8_SCHED;
            PG8_LDB(B0, 1, 0); PG8_LDB(B1, 1, 1); PG8_SCHED; PG8_LDA(At, 1, 0); PG8_STAGE(PG8_SA(0, 1), a2 + hstep, voffA);
            PG8_WAIT_V(8); PG8_WAIT_L(0); PG8_BAR; PG8_MMA(0, 0, At, B0); PG8_MMA(0, 1, At, B1); PG8_BAR; PG8_SCHED;
            PG8_LDA(At, 1, 1); PG8_STAGE(PG8_SB(1, 0), b3, voffB); PG8_STAGE(PG8_SB(1, 1), b3 + hstep, voffB); PG8_STAGE(PG8_SA(1, 0), a3, voffA);
            PG8_WAIT_V(8); PG8_WAIT_L(0); PG8_BAR; PG8_MMA(1, 0, At, B0); PG8_MMA(1, 1, At, B1); PG8_BAR; PG8_SCHED;
            } else {
            PG8_LDB(B0, 0, 0); PG8_SCHED; PG8_LDA(At, 0, 0); PG8_STAGE(PG8_SA(1, 1), a1 + hstep, voffA);
            PG8_WAIT_L(8); PG8_BAR; PG8_WAIT_L(0); PG8_MMA(0, 0, At, B0); PG8_BAR; PG8_SCHED;
            PG8_LDB(B1, 0, 1); PG8_STAGE(PG8_SB(0, 0), b2, voffB);
            PG8_BAR; PG8_WAIT_L(0); PG8_MMA(0, 1, At, B1); PG8_BAR;
            PG8_LDA(At, 0, 1); PG8_STAGE(PG8_SA(0, 0), a2, voffA);
            PG8_BAR; PG8_WAIT_L(0); PG8_MMA(1, 0, At, B0); PG8_BAR; PG8_SCHED;
            PG8_STAGE(PG8_SB(0, 1), b2 + hstep, voffB);
            PG8_WAIT_V(6); PG8_BAR; PG8_MMA(1, 1, At, B1); PG8_BAR;
            PG8_LDB(B0, 1, 0); PG8_SCHED; PG8_LDA(At, 1, 0); PG8_STAGE(PG8_SA(0, 1), a2 + hstep, voffA);
            PG8_WAIT_L(8); PG8_BAR; PG8_WAIT_L(0); PG8_MMA(0, 0, At, B0); PG8_BAR; PG8_SCHED;
            PG8_LDB(B1, 1, 1); PG8_STAGE(PG8_SB(1, 0), b3, voffB);
            PG8_BAR; PG8_WAIT_L(0); PG8_MMA(0, 1, At, B1); PG8_BAR;
            PG8_LDA(At, 1, 1); PG8_STAGE(PG8_SA(1, 0), a3, voffA);
            PG8_BAR; PG8_WAIT_L(0); PG8_MMA(1, 0, At, B0); PG8_BAR; PG8_SCHED;
            PG8_STAGE(PG8_SB(1, 1), b3 + hstep, voffB);
            PG8_WAIT_V(6); PG8_BAR; PG8_MMA(1, 1, At, B1); PG8_BAR;
            }
        }
        if constexpr (ALIGN_EPI) { if (wr == 0) PG8_BAR; }
        if constexpr (!Epi::AFTER_DRAIN) { E(acc, cur, wr, wc, fr, fq); S.done(cur); }
        if (!has_next) break;
#pragma unroll
        for (int a = 0; a < 2; ++a)
#pragma unroll
            for (int b = 0; b < 2; ++b)
#pragma unroll
                for (int m = 0; m < 4; ++m)
#pragma unroll
                    for (int n = 0; n < 2; ++n) acc[a][b][m][n] = (f32x4){0.f, 0.f, 0.f, 0.f};
        cur = nxt; cA = nA; cB = nB; ++ui;
        if constexpr (ALIGN_EPI) { if (wr == 1) PG8_BAR; }
    }
    PG8_WAIT_V(0);
    if constexpr (!ALIGN_EPI) { if (wr == 0) PG8_BAR; }
    PG8_BAR;
    if constexpr (Epi::AFTER_DRAIN) { E.fused(acc, cur, wr, wc, fr, fq, lds, wid, lane); S.done(cur); }
#undef PG8_SA
#undef PG8_SB
#undef PG8_STAGE
#undef PG8_LDA
#undef PG8_LDB
#undef PG8_MMA
#undef PG8_WAIT_V
#undef PG8_WAIT_L
#undef PG8_BAR
#undef PG8_SCHED
}
}

#define LAS __attribute__((address_space(3)))
typedef unsigned short bf16_t;
typedef short bf16x8 __attribute__((ext_vector_type(8)));
typedef short s16x4 __attribute__((ext_vector_type(4)));
typedef float f32x4 __attribute__((ext_vector_type(4)));
typedef float f32x2 __attribute__((ext_vector_type(2)));
typedef unsigned u32x4 __attribute__((ext_vector_type(4)));
typedef unsigned u32x2 __attribute__((ext_vector_type(2)));

constexpr int DM = 1024, MROWS = 16640, NPR = 16384, META0 = 16496, SAMP0 = 16512, DFF = 2816, RIN = 6144, VD = 2048;
constexpr int LDS_BYTES = 143360;
constexpr size_t OUT_YP = 0, OUT_YS = 16777216, OUT_RETP = 16908288, OUT_RETS = 21102592, OUT_CONVP = 88211456, OUT_CONVS = 88227840, OUT_FFNP = 88489984, OUT_FFNS = 88580096;
constexpr size_t WS_X = 0;
constexpr size_t WS_H = WS_X + (size_t)MROWS * DM * 4;
constexpr size_t WS_PROJ = WS_H + (size_t)MROWS * DM * 2;
constexpr size_t WS_O = WS_PROJ + (size_t)MROWS * RIN * 2;
constexpr size_t HALO_N = (size_t)260 * 2 * DFF;
constexpr size_t WS_Y = WS_O + (size_t)MROWS * VD * 2;
constexpr size_t WS_Y0 = WS_Y + (size_t)MROWS * DFF * 2;
constexpr size_t WS_STATS = WS_Y0 + (size_t)MROWS * VD * 2;
constexpr size_t WS_SS = WS_STATS + (size_t)MROWS * 32 * 8;
constexpr size_t WS_ROPE = WS_SS + (size_t)5 * MROWS * 16 * 4;
constexpr size_t WS_WRI = WS_ROPE + (size_t)2065 * 128 * 8;
constexpr size_t WS_WRO = WS_WRI + (size_t)RIN * DM * 2;
constexpr size_t WS_WSI = WS_WRO + (size_t)DM * VD * 2;
constexpr size_t WS_WSO = WS_WSI + (size_t)3072 * DM * 2;
constexpr size_t WS_WFI = WS_WSO + (size_t)DM * DM * 2;
constexpr size_t WS_WFO = WS_WFI + (size_t)2 * 2 * DFF * DM * 2;
constexpr size_t WS_BAR = WS_WFO + (size_t)2 * DM * DFF * 2;
constexpr size_t WS_END = WS_BAR + 16384;

struct Params {
    const float* in[18];
    float* out;
    unsigned char* ws;
    int ph_lo, ph_hi;
};
enum { I_XP = 0, I_XS, I_SRET, I_SCONV, I_SFFN, I_META, I_NMIX, I_NFFN, I_NFIN, I_WRI, I_WRO, I_WSI, I_WSC, I_WSO, I_WFI, I_WFC, I_BFC, I_WFO };

__device__ __forceinline__ float bflo(unsigned w) { return __uint_as_float(w << 16); }
__device__ __forceinline__ float bfhi(unsigned w) { return __uint_as_float(w & 0xffff0000u); }
__device__ __forceinline__ unsigned pk2(float lo, float hi) { unsigned r; asm("v_cvt_pk_bf16_f32 %0, %1, %2" : "=v"(r) : "v"(lo), "v"(hi)); return r; }
__device__ __forceinline__ float silu_f(float x) { return x * __builtin_amdgcn_rcpf(1.0f + __expf(-x)); }
__device__ __forceinline__ float wave_sum(float v) {
#pragma unroll
    for (int o = 1; o < 64; o <<= 1) v += __shfl_xor(v, o);
    return v;
}
__device__ __forceinline__ float rstd_of(const float* p16) {
    const f32x4 a = *(const f32x4*)p16, b = *(const f32x4*)(p16 + 4), c = *(const f32x4*)(p16 + 8), d = *(const f32x4*)(p16 + 12);
    const float ss = ((a.x + a.y) + (a.z + a.w)) + ((b.x + b.y) + (b.z + b.w)) + ((c.x + c.y) + (c.z + c.w)) + ((d.x + d.y) + (d.z + d.w));
    return 1.0f / sqrtf(ss * (1.0f / DM) + 1e-6f); }
__device__ __forceinline__ int pos_index(int row) { if (row < NPR) return 16 + (row & 2047); if (row < SAMP0) { const int j = row - META0; return j < 0 ? 0 : j; } return 2064; }
__device__ __forceinline__ void unpack8(const u32x4 w, float (&f)[8]) { f[0] = bflo(w.x); f[1] = bfhi(w.x); f[2] = bflo(w.y); f[3] = bfhi(w.y); f[4] = bflo(w.z); f[5] = bfhi(w.z); f[6] = bflo(w.w); f[7] = bfhi(w.w); }
__device__ __forceinline__ u32x4 pack8(const float (&f)[8]) { u32x4 w; w.x = pk2(f[0], f[1]); w.y = pk2(f[2], f[3]); w.z = pk2(f[4], f[5]); w.w = pk2(f[6], f[7]); return w; }
__device__ __forceinline__ void load8f(const float* p, float (&f)[8]) { const f32x4 a = *(const f32x4*)p, b = *(const f32x4*)(p + 4); f[0] = a.x; f[1] = a.y; f[2] = a.z; f[3] = a.w; f[4] = b.x; f[5] = b.y; f[6] = b.z; f[7] = b.w; }
__device__ __forceinline__ void store8f(float* p, const float (&f)[8]) { *(f32x4*)p = (f32x4){f[0], f[1], f[2], f[3]}; *(f32x4*)(p + 4) = (f32x4){f[4], f[5], f[6], f[7]}; }

#define XB_TMO      128
#define XB_XCNT(j)  (256  + 64 * (j))
#define XB_XSUB(j)  (1280 + 64 * (j))
#define XB_XGEN(j)  (2304 + 64 * (j))
#define XB_TOP      3328
#define XB_TOPGEN   3392
#define XCD_BAR_WORDS 3456
#define XB_SPIN_CAP (1u << 18)

__device__ __forceinline__ unsigned xb_ld(unsigned* p)              { return __hip_atomic_load(p, __ATOMIC_RELAXED, __HIP_MEMORY_SCOPE_AGENT); }
__device__ __forceinline__ unsigned xb_add(unsigned* p, unsigned v) { return __hip_atomic_fetch_add(p, v, __ATOMIC_RELAXED, __HIP_MEMORY_SCOPE_AGENT); }
__device__ __forceinline__ unsigned xb_xcc_id() { return (unsigned)__builtin_amdgcn_s_getreg((3 << 11) | 20) & 0xFu; }
#define XB_SPIN(cond, bar) do { unsigned _sp = 0; while (cond) { __builtin_amdgcn_s_sleep(1); \
    if ((++_sp & 255u) == 0u) { if (xb_ld(&(bar)[XB_TMO])) break; if (_sp > XB_SPIN_CAP) { atomicAdd(&(bar)[XB_TMO], 1u); break; } } } } while (0)

struct XcdBarrier {
    unsigned* bar; unsigned x;
    volatile LAS unsigned* st;
};

__device__ __forceinline__ XcdBarrier xcd_barrier_post(unsigned* bar, volatile LAS unsigned* st) {
    XcdBarrier b; b.bar = bar; b.x = xb_xcc_id(); b.st = st;
    if (TIDX == 0) (void)xb_add(&bar[XB_XCNT(b.x)], 1u);
    return b;
}
__device__ __forceinline__ void xcd_barrier_complete(unsigned* bar, unsigned x, unsigned& nloc, unsigned& nx) {
    const unsigned G = gridDim.x * gridDim.y * gridDim.z;
    unsigned sum, cnt, mine, sp = 0u;
    for (;;) {
        sum = 0u; cnt = 0u; mine = 0u;
#pragma unroll
        for (unsigned j = 0; j < 16; ++j) { const unsigned c = xb_ld(&bar[XB_XCNT(j)]); sum += c; cnt += (c > 0u) ? 1u : 0u; mine = (j == x) ? c : mine; }
        if (sum == G) break;
        __builtin_amdgcn_s_sleep(1);
        if ((++sp & 255u) == 0u) { if (xb_ld(&bar[XB_TMO])) break; if (sp > XB_SPIN_CAP) { atomicAdd(&bar[XB_TMO], 1u); break; } }
    }
    nloc = mine > 0u ? mine : 1u; nx = cnt > 0u ? cnt : 1u;
}

__device__ __forceinline__ void xcd_barrier(const XcdBarrier& b) {
    asm volatile("s_waitcnt vmcnt(0)" ::: "memory");
    __syncthreads();
    if (TIDX == 0) {
        unsigned* bar = b.bar;
        __builtin_amdgcn_s_waitcnt(0);
        unsigned nloc = b.st[0], nx = b.st[1];
        if (nloc == 0u) { xcd_barrier_complete(bar, b.x, nloc, nx); b.st[0] = nloc; b.st[1] = nx; }
        const unsigned old = xb_add(&bar[XB_XSUB(b.x)], 1u);
        const unsigned gen = old / nloc;
        if (old + 1u == (gen + 1u) * nloc) {
            __builtin_amdgcn_fence(__ATOMIC_RELEASE, "agent");
            asm volatile("s_waitcnt vmcnt(0)" ::: "memory");
            const unsigned og = xb_add(&bar[XB_TOP], 1u);
            const unsigned tg = og / nx;
            if (og + 1u == (tg + 1u) * nx) xb_add(&bar[XB_TOPGEN], 1u);
            else XB_SPIN(xb_ld(&bar[XB_TOPGEN]) == tg, bar);
            __builtin_amdgcn_fence(__ATOMIC_ACQUIRE, "agent");
            xb_add(&bar[XB_XGEN(b.x)], 1u);
            asm volatile("s_waitcnt vmcnt(0)" ::: "memory");
        } else {
            XB_SPIN(xb_ld(&bar[XB_XGEN(b.x)]) == gen, bar);
            __builtin_amdgcn_fence(__ATOMIC_ACQUIRE, "agent");
            asm volatile("s_waitcnt vmcnt(0)" ::: "memory");
        }
    }
    __syncthreads();
}

struct EpiRetIn {
    static constexpr bool PERM = true, AFTER_DRAIN = false;
    bf16_t* O; const float* rope; const float* rt;
    __device__ __forceinline__ void operator()(const f32x4 (&acc)[2][2][4][2], const pg8::Unit& u, int wr, int wc, int fr, int fq) const {
        const int row0 = u.pm * 256 + wr * 64 + fr, colt = u.pn * 256 + wc * 32 + 8 * fq;
        const int kind = u.pn < 4 ? 0 : (u.pn < 8 ? 1 : (u.pn < 16 ? 2 : 3));
        const float* rtu = rt + u.idx * 256 + wr * 64 + fr;
#pragma unroll
        for (int ai = 0; ai < 2; ++ai) {
            float rs[4];
#pragma unroll
            for (int m = 0; m < 4; ++m) rs[m] = rtu[ai * 128 + m * 16];
            if (kind <= 1) {
                f32x4 cs[4][2][2];
#pragma unroll
                for (int m = 0; m < 4; ++m) { const float* rp = rope + ((size_t)pos_index(row0 + ai * 128 + m * 16) * 128 + wc * 16 + 4 * fq) * 2;
#pragma unroll
                    for (int bj = 0; bj < 2; ++bj) { cs[m][bj][0] = *(const f32x4*)(rp + bj * 128); cs[m][bj][1] = *(const f32x4*)(rp + bj * 128 + 4); } }
#pragma unroll
                for (int m = 0; m < 4; ++m) {
                    bf16_t* rowp = O + (size_t)(row0 + ai * 128 + m * 16) * RIN + colt;
                    const float sc = kind == 1 ? 0.0625f * rs[m] : rs[m];
#pragma unroll
                    for (int bj = 0; bj < 2; ++bj) {
                        const f32x4 c0 = cs[m][bj][0], c1 = cs[m][bj][1];
                        const f32x4 v0 = acc[ai][bj][m][0] * sc, v1 = acc[ai][bj][m][1] * sc;
                        u32x4 w;
                        w.x = pk2(v0.x * c0.x - v0.y * c0.y, v0.x * c0.y + v0.y * c0.x);
                        w.y = pk2(v0.z * c0.z - v0.w * c0.w, v0.z * c0.w + v0.w * c0.z);
                        w.z = pk2(v1.x * c1.x - v1.y * c1.y, v1.x * c1.y + v1.y * c1.x);
                        w.w = pk2(v1.z * c1.z - v1.w * c1.w, v1.z * c1.w + v1.w * c1.z);
                        *(u32x4*)(rowp + bj * 128) = w;
                    }
                }
            } else {
#pragma unroll
                for (int m = 0; m < 4; ++m) {
                    bf16_t* rowp = O + (size_t)(row0 + ai * 128 + m * 16) * RIN + colt;
#pragma unroll
                    for (int bj = 0; bj < 2; ++bj) {
                        f32x4 v0 = acc[ai][bj][m][0] * rs[m], v1 = acc[ai][bj][m][1] * rs[m];
                        u32x4 w; w.x = pk2(v0.x, v0.y); w.y = pk2(v0.z, v0.w); w.z = pk2(v1.x, v1.y); w.w = pk2(v1.z, v1.w);
                        *(u32x4*)(rowp + bj * 128) = w;
                    }
                }
            }
        }
    }
};
struct EpiBf16 {
    static constexpr bool PERM = true, AFTER_DRAIN = false;
    bf16_t* O; int ldc; const float* rt;
    __device__ __forceinline__ void operator()(const f32x4 (&acc)[2][2][4][2], const pg8::Unit& u, int wr, int wc, int fr, int fq) const {
        const int row0 = u.pm * 256 + wr * 64 + fr, colt = u.pn * 256 + wc * 32 + 8 * fq;
#pragma unroll
        for (int ai = 0; ai < 2; ++ai)
#pragma unroll
            for (int m = 0; m < 4; ++m) {
                bf16_t* rowp = O + (size_t)(row0 + ai * 128 + m * 16) * ldc + colt;
                const float rs = rt[u.idx * 256 + ai * 128 + wr * 64 + m * 16 + fr];
#pragma unroll
                for (int bj = 0; bj < 2; ++bj) {
                    const f32x4 v0 = acc[ai][bj][m][0] * rs, v1 = acc[ai][bj][m][1] * rs;
                    u32x4 w; w.x = pk2(v0.x, v0.y); w.y = pk2(v0.z, v0.w); w.z = pk2(v1.x, v1.y); w.w = pk2(v1.z, v1.w);
                    *(u32x4*)(rowp + bj * 128) = w;
                }
            }
    }
};
struct EpiFfn {
    static constexpr bool PERM = true, AFTER_DRAIN = false;
    bf16_t* Y; const float* rt; float* halo; const float* cw; const float* cb; const float* sin_; float* outs;
    __device__ __forceinline__ void operator()(const f32x4 (&acc)[2][2][4][2], const pg8::Unit& u, int wr, int wc, int fr, int fq) const {
        const int src1 = (fq << 4) | ((fr + 15) & 15), src2 = (fq << 4) | ((fr + 14) & 15);
        const int chb = 128 * u.pn + 32 * wc + 8 * fq;
        const float* rtu = rt + u.idx * 256 + wr * 64 + fr;
        f32x4 cwv[2][4];
#pragma unroll
        for (int n = 0; n < 2; ++n) { const unsigned cho = (unsigned)(chb + 4 * n) * 4u;
            cwv[n][0] = *(const f32x4*)((const char*)cw + cho); cwv[n][1] = *(const f32x4*)((const char*)(cw + DFF) + cho); cwv[n][2] = *(const f32x4*)((const char*)(cw + 2 * DFF) + cho); cwv[n][3] = *(const f32x4*)((const char*)cb + cho); }
#pragma unroll
        for (int ai = 0; ai < 2; ++ai) {
            float rs[4];
#pragma unroll
            for (int m = 0; m < 4; ++m) rs[m] = rtu[ai * 128 + m * 16];
            const bool sample = (u.pm == 64) && (ai == 1);
            const int row0 = u.pm * 256 + ai * 128 + wr * 64 + fr, strip = (u.pm * 256 + ai * 128 + wr * 64) >> 6;
            if (!sample) {
                f32x4 q1[2], q2[2];
#pragma unroll
                for (int n = 0; n < 2; ++n) { q1[n] = (f32x4){0.f, 0.f, 0.f, 0.f}; q2[n] = q1[n]; }
#pragma unroll
                for (int m = 0; m < 4; ++m) {
                    u32x2 wv[2];
#pragma unroll
                    for (int n = 0; n < 2; ++n) {
                        const int ch = chb + 4 * n;
                        const f32x4 up = acc[ai][0][m][n] * rs[m];
                        f32x4 a1, a2, p1, p2;
#pragma unroll
                        for (int t = 0; t < 4; ++t) { a1[t] = __shfl(up[t], src1); a2[t] = __shfl(up[t], src2); p1[t] = fr >= 1 ? a1[t] : q1[n][t]; p2[t] = fr >= 2 ? a2[t] : q2[n][t]; }
                        q1[n] = a1; q2[n] = a2;
                        const f32x4 g = acc[ai][1][m][n] * rs[m];
                        const f32x4 a = cwv[n][0] * p2 + cwv[n][1] * p1 + cwv[n][2] * up + cwv[n][3];
                        wv[n].x = pk2(silu_f(a.x) * g.x, silu_f(a.y) * g.y); wv[n].y = pk2(silu_f(a.z) * g.z, silu_f(a.w) * g.w);
                        if (m == 0 && fr < 2) { const unsigned ho = (unsigned)((strip * 2 + fr) * DFF + ch) * 4u; *(f32x4*)((char*)halo + ho) = up; *(f32x4*)((char*)(halo + HALO_N) + ho) = g; }
                        if (m == 3 && fr >= 14) *(f32x4*)((char*)(halo + 2 * HALO_N) + (unsigned)((strip * 2 + (fr - 14)) * DFF + ch) * 4u) = up;
                    }
                    if (m > 0 || fr >= 2) *(u32x4*)((char*)Y + (unsigned)((row0 + m * 16) * DFF + chb) * 2u) = (u32x4){wv[0].x, wv[0].y, wv[1].x, wv[1].y};
                }
            } else {
#pragma unroll
                for (int m = 0; m < 4; ++m) {
                    const int b = wr * 64 + m * 16 + fr;
                    u32x2 wv[2];
#pragma unroll
                    for (int n = 0; n < 2; ++n) {
                        const int ch = chb + 4 * n;
                        const f32x4 upv = acc[ai][0][m][n] * rs[m], g = acc[ai][1][m][n] * rs[m];
                        const unsigned so = (unsigned)(b * 2 * DFF + ch) * 4u;
                        const f32x4 s0 = *(const f32x4*)((const char*)sin_ + so), s1 = *(const f32x4*)((const char*)(sin_ + DFF) + so);
                        const f32x4 a = cwv[n][0] * s0 + cwv[n][1] * s1 + cwv[n][2] * upv + cwv[n][3];
                        wv[n].x = pk2(silu_f(a.x) * g.x, silu_f(a.y) * g.y); wv[n].y = pk2(silu_f(a.z) * g.z, silu_f(a.w) * g.w);
                        *(f32x4*)((char*)outs + so) = s1; *(f32x4*)((char*)(outs + DFF) + so) = upv;
                    }
                    *(u32x4*)((char*)Y + (unsigned)((SAMP0 + b) * DFF + chb) * 2u) = (u32x4){wv[0].x, wv[0].y, wv[1].x, wv[1].y};
                }
            }
            asm volatile("" ::: "memory");
        }
    }
};
struct EpiSc {
    static constexpr bool PERM = true, AFTER_DRAIN = false;
    bf16_t* O; const float* rt;
    __device__ __forceinline__ void operator()(const f32x4 (&acc)[2][2][4][2], const pg8::Unit& u, int wr, int wc, int fr, int fq) const {
        const int row0 = u.pm * 256 + wr * 64 + fr;
        const float* rtu = rt + u.idx * 256 + wr * 64 + fr;
        if (u.pn < 4) {
            const int colt = u.pn * 256 + wc * 32 + 8 * fq;
#pragma unroll
            for (int ai = 0; ai < 2; ++ai)
#pragma unroll
                for (int m = 0; m < 4; ++m) {
                    bf16_t* rowp = O + (size_t)(row0 + ai * 128 + m * 16) * (2 * DM) + colt;
                    const float rs = rtu[ai * 128 + m * 16];
#pragma unroll
                    for (int bj = 0; bj < 2; ++bj) {
                        const f32x4 v0 = acc[ai][bj][m][0] * rs, v1 = acc[ai][bj][m][1] * rs;
                        u32x4 w; w.x = pk2(v0.x, v0.y); w.y = pk2(v0.z, v0.w); w.z = pk2(v1.x, v1.y); w.w = pk2(v1.z, v1.w);
                        *(u32x4*)(rowp + bj * 128) = w;
                    }
                }
        } else {
            const int ch0 = DM + 128 * (u.pn - 4) + wc * 32 + 8 * fq;
#pragma unroll
            for (int ai = 0; ai < 2; ++ai)
#pragma unroll
                for (int m = 0; m < 4; ++m) {
                    const float rs = rtu[ai * 128 + m * 16], r2 = rs * rs;
                    const f32x4 v0 = acc[ai][0][m][0] * acc[ai][1][m][0] * r2, v1 = acc[ai][0][m][1] * acc[ai][1][m][1] * r2;
                    u32x4 w; w.x = pk2(v0.x, v0.y); w.y = pk2(v0.z, v0.w); w.z = pk2(v1.x, v1.y); w.w = pk2(v1.z, v1.w);
                    *(u32x4*)(O + (size_t)(row0 + ai * 128 + m * 16) * (2 * DM) + ch0) = w;
                }
        }
    }
};
struct EpiResid {
    static constexpr bool PERM = true, AFTER_DRAIN = false;
    bf16_t* H; float* ssn;
    __device__ __forceinline__ void operator()(const f32x4 (&acc)[2][2][4][2], const pg8::Unit& u, int wr, int wc, int fr, int fq) const {
        const int row0 = u.pm * 256 + wr * 64 + fr, col0 = u.pn * 256 + wc * 32 + 8 * fq;
#pragma unroll
        for (int ai = 0; ai < 2; ++ai) {
            u32x4 xv[4][2];
#pragma unroll
            for (int m = 0; m < 4; ++m) { const bf16_t* rowp = H + (size_t)(row0 + ai * 128 + m * 16) * DM + col0;
#pragma unroll
                for (int bj = 0; bj < 2; ++bj) xv[m][bj] = *(const u32x4*)(rowp + bj * 128); }
#pragma unroll
            for (int m = 0; m < 4; ++m) {
                const int row = row0 + ai * 128 + m * 16;
                bf16_t* hp = H + (size_t)row * DM + col0;
                float sq = 0.f;
#pragma unroll
                for (int bj = 0; bj < 2; ++bj) { const u32x4 xw = xv[m][bj];
                    const f32x4 v0 = (f32x4){bflo(xw.x), bfhi(xw.x), bflo(xw.y), bfhi(xw.y)} + acc[ai][bj][m][0], v1 = (f32x4){bflo(xw.z), bfhi(xw.z), bflo(xw.w), bfhi(xw.w)} + acc[ai][bj][m][1];
                    sq += ((v0.x * v0.x + v0.y * v0.y) + (v0.z * v0.z + v0.w * v0.w)) + ((v1.x * v1.x + v1.y * v1.y) + (v1.z * v1.z + v1.w * v1.w));
                    u32x4 w; w.x = pk2(v0.x, v0.y); w.y = pk2(v0.z, v0.w); w.z = pk2(v1.x, v1.y); w.w = pk2(v1.z, v1.w); *(u32x4*)(hp + bj * 128) = w; }
                sq += __shfl_xor(sq, 16); sq += __shfl_xor(sq, 32);
                if (fq == 0) ssn[(size_t)row * 16 + u.pn * 4 + wc] = sq;
            }
            asm volatile("" ::: "memory");
        }
    }
};
__device__ __forceinline__ void ffnfix_strips(const Params& p, int layer, int s_lo, int s_hi) {
    bf16_t* Y = (bf16_t*)(p.ws + WS_Y); const float* HUF = (const float*)(p.ws + WS_O); const float* HGF = HUF + HALO_N; const float* HUL = HUF + 2 * HALO_N;
    const float* cw = p.in[I_WFC] + (size_t)layer * 3 * DFF; const float* cb = p.in[I_BFC] + (size_t)layer * DFF;
    constexpr int CG = DFF / 8;
    const int total = (s_hi - s_lo) * 2 * CG;
    for (int idx = TIDX; idx < total; idx += 512) {
        const int it = idx / CG, c = (idx - it * CG) * 8;
        const int s_ = s_lo + (it >> 1), i = it & 1, sp = (s_ < 256 && (s_ & 31) == 0) ? 257 : (s_ > 0 ? s_ - 1 : 0);
        float u0[8], u1[8], u2[8], gt[8], w0[8], w1[8], w2[8], bb[8], y[8];
        load8f(HUF + ((size_t)s_ * 2 + i) * DFF + c, u0); load8f(HGF + ((size_t)s_ * 2 + i) * DFF + c, gt);
        if (i == 0) { load8f(HUL + ((size_t)sp * 2 + 1) * DFF + c, u1); load8f(HUL + ((size_t)sp * 2 + 0) * DFF + c, u2); }
        else { load8f(HUF + ((size_t)s_ * 2 + 0) * DFF + c, u1); load8f(HUL + ((size_t)sp * 2 + 1) * DFF + c, u2); }
        load8f(cw + c, w0); load8f(cw + DFF + c, w1); load8f(cw + 2 * DFF + c, w2); load8f(cb + c, bb);
#pragma unroll
        for (int k = 0; k < 8; ++k) { const float a = w0[k] * u2[k] + w1[k] * u1[k] + w2[k] * u0[k] + bb[k]; y[k] = silu_f(a) * gt[k]; }
        *(u32x4*)(Y + (size_t)(64 * s_ + i) * DFF + c) = pack8(y);
    }
}
__device__ __forceinline__ void ffn_state_prompt(const Params& p, int layer, int b) {
    const float* HUL = (const float*)(p.ws + WS_O) + 2 * HALO_N; float* outp = p.out + OUT_FFNP + (size_t)layer * 8 * 2 * DFF;
    for (int idx = TIDX; idx < 2 * (DFF / 8); idx += 512) { const int i = idx / (DFF / 8), c = (idx - i * (DFF / 8)) * 8;
        float v[8]; load8f(HUL + ((size_t)(32 * b + 31) * 2 + i) * DFF + c, v); store8f(outp + ((size_t)b * 2 + i) * DFF + c, v); }
}
__device__ __forceinline__ void wg_arrive(unsigned* cnt) {
    asm volatile("s_waitcnt vmcnt(0)" ::: "memory");
    __syncthreads();
    if (TIDX == 0) { __builtin_amdgcn_fence(__ATOMIC_RELEASE, "agent"); asm volatile("s_waitcnt vmcnt(0)" ::: "memory"); (void)xb_add(cnt, 1u); }
}
__device__ __forceinline__ void poll_ge(unsigned* cnt, unsigned target) {
    unsigned sp = 0u;
    while ((unsigned)__builtin_amdgcn_readfirstlane(xb_ld(cnt)) < target) { __builtin_amdgcn_s_sleep(2); if (++sp > (1u << 16)) break; }
    __builtin_amdgcn_fence(__ATOMIC_ACQUIRE, "agent");
    asm volatile("s_waitcnt vmcnt(0)" ::: "memory");
}
__device__ __forceinline__ void wg_wait(unsigned* cnt, unsigned target) {
    if (TIDX < 64) poll_ge(cnt, target);
    __syncthreads();
}
struct OneUnit {
    int pm, pn;
    __device__ __forceinline__ bool next(int i, pg8::Unit& u) const { if (i != 0) return false; u.pm = pm; u.pn = pn; u.idx = 0; return true; }
    __device__ __forceinline__ void a_ready(const pg8::Unit&) const {}
    __device__ __forceinline__ void done(const pg8::Unit&) const {}
};
struct TailOrder {
    pg8::StaticOrder so; int nmain, nN, c; unsigned* cntB; float* rt; const float* ss;
    __device__ __forceinline__ void init(int N, int c_, unsigned* cntB_, float* rt_, const float* ss_) { so.init(NPR, N, 256, c_); nmain = so.nwg; nN = N / 256; c = c_; cntB = cntB_; rt = rt_; ss = ss_; }
    __device__ __forceinline__ bool next(int i, pg8::Unit& u) const {
        const int total = nmain + nN, jf = total >> 8, rem = total & 255;
        long L;
        if (c >= 252) { L = (long)(i + 2) * 256 + c; if (L >= total) return false; }
        else if (i < jf || (i == jf && c < rem)) L = (long)i * 256 + c;
        else if (i == jf && c < rem + 8) { const int hh = c - rem; L = (long)(hh >> 2) * 256 + 252 + (hh & 3); }
        else return false;
        if (L < nmain) so.at(L, u); else { u.pm = 64; u.pn = (int)(L - nmain); }
        u.idx = i; return true;
    }
    __device__ __forceinline__ void a_ready(const pg8::Unit& u) const {
        if (u.pm == 64) {
            if (TIDX < 64) poll_ge(cntB, 4u);
            asm volatile("" ::: "memory"); __builtin_amdgcn_s_barrier(); asm volatile("" ::: "memory");
            if (TIDX < 256) rt[u.idx * 256 + TIDX] = rstd_of(ss + (size_t)(64 * 256 + TIDX) * 16);
        }
    }
    __device__ __forceinline__ void done(const pg8::Unit&) const {}
};
__device__ __forceinline__ void run_resid_gemm(const Params& p, int fix_layer, LAS unsigned char* lds, const bf16_t* A, const bf16_t* Bt, int K, bf16_t* H, float* ssn, unsigned* cntA, unsigned* cntB) {
    EpiResid E{H, ssn};
    { pg8::Gemm g{A, Bt, NPR, DM, K}; pg8::StaticOrder S; S.init(NPR, DM, (int)gridDim.x, (int)blockIdx.x);
      if (fix_layer >= 0) { pg8::Unit u0; if (S.next(0, u0)) ffnfix_strips(p, fix_layer, 4 * u0.pm, 4 * u0.pm + 4); if ((int)blockIdx.x < 8) ffn_state_prompt(p, fix_layer, (int)blockIdx.x);
                            asm volatile("s_waitcnt vmcnt(0)" ::: "memory"); __syncthreads(); }
      pg8::gemm_phase<EpiResid, pg8::StaticOrder, false, true>(lds, g, S, E); }
    wg_arrive(cntA);
    if ((int)blockIdx.x >= 252) {
        if (fix_layer >= 0) { ffnfix_strips(p, fix_layer, 256, 258); asm volatile("s_waitcnt vmcnt(0)" ::: "memory"); __syncthreads(); }
        pg8::Gemm g{A, Bt, MROWS, DM, K}; OneUnit S1{64, (int)blockIdx.x - 252}; pg8::gemm_phase<EpiResid, OneUnit, false, true>(lds, g, S1, E);
        wg_arrive(cntB);
    }
    wg_wait(cntA, gridDim.x);
}
template <class Epi> __device__ __forceinline__ void run_gemm_tail(LAS unsigned char* lds, const float* ss, unsigned* cntB, const bf16_t* A, const bf16_t* Bt, int N, int K, const Epi& E) {
    float* rt = (float*)((unsigned char*)lds + pg8::STAGE_BYTES);
    pg8::Gemm g{A, Bt, MROWS, N, K}; TailOrder S; S.init(N, (int)blockIdx.x, cntB, rt, ss);
    for (int i = 0;; ++i) { pg8::Unit u; if (!S.next(i, u)) break;
        if (u.pm != 64 && TIDX < 256) rt[i * 256 + TIDX] = rstd_of(ss + (size_t)(u.pm * 256 + TIDX) * 16); }
    __syncthreads();
    pg8::gemm_phase<Epi, TailOrder, true, true>(lds, g, S, E);
}
__device__ __forceinline__ void build_rstd_table(float* rt, const pg8::StaticOrder& S, const float* ss) {
    for (int i = 0;; ++i) { pg8::Unit u; if (!S.next(i, u)) break;
        if (TIDX < 256) rt[i * 256 + TIDX] = rstd_of(ss + (size_t)(u.pm * 256 + TIDX) * 16); }
    __syncthreads();
}
template <class Epi> __device__ __forceinline__ void run_gemm(LAS unsigned char* lds, const float* ss, const bf16_t* A, const bf16_t* Bt, int N, int K, const Epi& E) {
    pg8::Gemm g{A, Bt, MROWS, N, K}; pg8::StaticOrder S; S.init(MROWS, N, (int)gridDim.x, (int)blockIdx.x);
    if (ss) build_rstd_table((float*)((unsigned char*)lds + pg8::STAGE_BYTES), S, ss);
    pg8::gemm_phase<Epi, pg8::StaticOrder, true, true>(lds, g, S, E);
}

template <bool FFN_INTERLEAVE = false, bool SC_INTERLEAVE = false> __device__ __forceinline__ void transpose_item(const float* W, const float* g, int K, int N, bf16_t* WT, float* scr, int item, int lane) {
    const int nblk = N / 32, kb = item / nblk, nb = item - kb * nblk, k0 = 64 * kb, n0 = 32 * nb;
    const int d0 = SC_INTERLEAVE ? (n0 < DM ? n0 : (n0 < 2 * DM ? DM + ((n0 - DM) >> 7) * 256 + ((n0 - DM) & 127) : DM + ((n0 - 2 * DM) >> 7) * 256 + 128 + ((n0 - 2 * DM) & 127))) : !FFN_INTERLEAVE ? n0 : (n0 < DFF ? (n0 >> 7) * 256 + (n0 & 127) : ((n0 - DFF) >> 7) * 256 + 128 + ((n0 - DFF) & 127));
#pragma unroll
    for (int i = 0; i < 8; ++i) {
        const int kk = 8 * i + (lane >> 3); const float gg = g ? g[k0 + kk] : 1.0f;
        const f32x4 v = *(const f32x4*)(W + (size_t)(k0 + kk) * N + n0 + (lane & 7) * 4);
        float* d = scr + kk * 33 + (lane & 7) * 4; d[0] = v.x * gg; d[1] = v.y * gg; d[2] = v.z * gg; d[3] = v.w * gg; }
    asm volatile("s_waitcnt lgkmcnt(0)" ::: "memory");
    const int c = lane & 7;
#pragma unroll
    for (int j = 0; j < 4; ++j) { const int n = (lane >> 3) + 8 * j; const float* s = scr + (8 * c) * 33 + n;
        u32x4 o; o.x = pk2(s[0 * 33], s[1 * 33]); o.y = pk2(s[2 * 33], s[3 * 33]); o.z = pk2(s[4 * 33], s[5 * 33]); o.w = pk2(s[6 * 33], s[7 * 33]);
        *(u32x4*)(WT + (size_t)(d0 + n) * K + k0 + 8 * c) = o; }
    asm volatile("s_waitcnt lgkmcnt(0)" ::: "memory");
}
__device__ __forceinline__ void sincos_d(double r, float& c, float& s) {
    const double r2 = r * r;
    double sc = 1.0, ss = 1.0;
#pragma unroll
    for (int k = 14; k >= 1; --k) { sc = 1.0 - sc * r2 * (1.0 / (double)((2 * k - 1) * (2 * k))); ss = 1.0 - ss * r2 * (1.0 / (double)((2 * k) * (2 * k + 1))); }
    c = (float)sc; s = (float)(ss * r);
}
__device__ __forceinline__ void prep_rows(const Params& p) {
    bf16_t* H = (bf16_t*)(p.ws + WS_H); float* SS = (float*)(p.ws + WS_SS);
    const int lane = TIDX & 63, gw = blockIdx.x * 8 + (TIDX >> 6), NW = gridDim.x * 8;
    for (int row0 = gw; row0 < MROWS; row0 += 4 * NW) {
        f32x4 v[4][4];
#pragma unroll
        for (int k = 0; k < 4; ++k) { const int row = row0 + k * NW;
            const float* src = row >= MROWS ? nullptr : (row < NPR ? p.in[I_XP] + (size_t)row * DM : (row >= SAMP0 ? p.in[I_XS] + (size_t)(row - SAMP0) * DM : (row >= META0 ? p.in[I_META] + (size_t)(row - META0) * DM : nullptr)));
#pragma unroll
            for (int j = 0; j < 4; ++j) v[k][j] = src ? *(const f32x4*)(src + lane * 4 + 256 * j) : (f32x4){0.f, 0.f, 0.f, 0.f}; }
#pragma unroll
        for (int k = 0; k < 4; ++k) { const int row = row0 + k * NW; if (row < MROWS) {
            float ss = 0.f;
#pragma unroll
            for (int j = 0; j < 4; ++j) {
                u32x2 w; w.x = pk2(v[k][j].x, v[k][j].y); w.y = pk2(v[k][j].z, v[k][j].w); *(u32x2*)(H + (size_t)row * DM + lane * 4 + 256 * j) = w;
                ss += (v[k][j].x * v[k][j].x + v[k][j].y * v[k][j].y) + (v[k][j].z * v[k][j].z + v[k][j].w * v[k][j].w); }
            ss = wave_sum(ss);
            if (lane < 16) SS[(size_t)row * 16 + lane] = lane == 0 ? ss : 0.f; } }
    }
}
__device__ __forceinline__ void phase_final(const Params& p, unsigned* cntB) {
    const bf16_t* H = (const bf16_t*)(p.ws + WS_H); const float* SS = (const float*)(p.ws + WS_SS) + (size_t)4 * MROWS * 16; const float* g = p.in[I_NFIN];
    {
        const int S = (int)gridDim.x * 512, idx0 = blockIdx.x * 512 + TIDX, c = (idx0 & 127) * 8;
        float gv[8]; load8f(g + c, gv);
        for (int idx = idx0; idx < NPR * 128; idx += 4 * S) {
            u32x4 hv[4]; f32x4 sa[4][4];
#pragma unroll
            for (int k = 0; k < 4; ++k) { const int row = (idx + k * S) >> 7; if (row < NPR) { hv[k] = *(const u32x4*)(H + (size_t)row * DM + c);
#pragma unroll
                for (int q = 0; q < 4; ++q) sa[k][q] = *(const f32x4*)(SS + (size_t)row * 16 + 4 * q); } }
#pragma unroll
            for (int k = 0; k < 4; ++k) { const int row = (idx + k * S) >> 7; if (row < NPR) {
                const float sum = ((sa[k][0].x + sa[k][0].y) + (sa[k][0].z + sa[k][0].w)) + ((sa[k][1].x + sa[k][1].y) + (sa[k][1].z + sa[k][1].w)) + ((sa[k][2].x + sa[k][2].y) + (sa[k][2].z + sa[k][2].w)) + ((sa[k][3].x + sa[k][3].y) + (sa[k][3].z + sa[k][3].w));
                const float rs = 1.0f / sqrtf(sum * (1.0f / DM) + 1e-6f);
                float v[8]; unpack8(hv[k], v);
#pragma unroll
                for (int j = 0; j < 8; ++j) v[j] = v[j] * rs * gv[j];
                store8f(p.out + OUT_YP + (size_t)row * DM + c, v); } }
        }
    }
    wg_wait(cntB, 4u);
    for (int idx = blockIdx.x * 512 + TIDX; idx < 128 * 128; idx += gridDim.x * 512) {
        const int r = idx >> 7, c = (idx & 127) * 8, row = SAMP0 + r;
        const float rs = rstd_of(SS + (size_t)row * 16);
        float v[8], gv[8]; unpack8(*(const u32x4*)(H + (size_t)row * DM + c), v); load8f(g + c, gv);
#pragma unroll
        for (int k = 0; k < 8; ++k) v[k] = v[k] * rs * gv[k];
        store8f(p.out + OUT_YS + (size_t)r * DM + c, v);
    }
}
template <int SET> __device__ __forceinline__ void transpose_set(const Params& p, unsigned char* shm, int first) {
    const int lane = TIDX & 63, wave = TIDX >> 6;
    if ((int)blockIdx.x < first) return;
    const int gw = ((int)blockIdx.x - first) * 8 + wave, NW = ((int)gridDim.x - first) * 8;
    float* scr = (float*)(shm + wave * 8704);
    constexpr int I0 = 16 * 192, I1 = 32 * 32, I2 = 16 * 96, I3 = 16 * 32, I4 = 16 * 176, I5 = 44 * 32;
    constexpr int NIT = SET == 0 ? I0 : (SET == 1 ? I1 + I4 : (SET == 2 ? I5 + I2 + I3 : I4 + I5));
    for (int it = gw; it < NIT; it += NW) {
        int r = it;
        if (SET == 0) { transpose_item(p.in[I_WRI], p.in[I_NMIX], DM, RIN, (bf16_t*)(p.ws + WS_WRI), scr, r, lane); }
        else if (SET == 1) {
            if (r < I1) { transpose_item(p.in[I_WRO], nullptr, VD, DM, (bf16_t*)(p.ws + WS_WRO), scr, r, lane); continue; } r -= I1;
            transpose_item<true>(p.in[I_WFI], p.in[I_NFFN], DM, 2 * DFF, (bf16_t*)(p.ws + WS_WFI), scr, r, lane);
        } else if (SET == 2) {
            if (r < I5) { transpose_item(p.in[I_WFO], nullptr, DFF, DM, (bf16_t*)(p.ws + WS_WFO), scr, r, lane); continue; } r -= I5;
            if (r < I2) { transpose_item<false, true>(p.in[I_WSI], p.in[I_NMIX] + DM, DM, 3072, (bf16_t*)(p.ws + WS_WSI), scr, r, lane); continue; } r -= I2;
            transpose_item(p.in[I_WSO], nullptr, DM, DM, (bf16_t*)(p.ws + WS_WSO), scr, r, lane);
        } else {
            if (r < I4) { transpose_item<true>(p.in[I_WFI] + (size_t)DM * 2 * DFF, p.in[I_NFFN] + DM, DM, 2 * DFF, (bf16_t*)(p.ws + WS_WFI) + (size_t)2 * DFF * DM, scr, r, lane); continue; } r -= I4;
            transpose_item(p.in[I_WFO] + (size_t)DFF * DM, nullptr, DFF, DM, (bf16_t*)(p.ws + WS_WFO) + (size_t)DM * DFF, scr, r, lane);
        }
    }
}
__device__ __forceinline__ void phase_prep(const Params& p, unsigned char* shm) {
    transpose_set<0>(p, shm, 0);
    float* rope = (float*)(p.ws + WS_ROPE);
    for (int i = blockIdx.x * 512 + TIDX; i < 2065 * 128; i += gridDim.x * 512) {
        const int pi = i >> 7, fi = i & 127; const double pos = pi == 2064 ? 16384.0 : (double)pi;
        const double y = -(double)fi * 0.10462765653188542;
        const double nn = rint(y), f = (y - nn) * 0.6931471805599453;
        double e = 1.0;
#pragma unroll
        for (int k = 18; k >= 1; --k) e = 1.0 + e * f * (1.0 / (double)k);
        const double inv = e / (double)(1 << (int)(-nn));
        const double ang = pos * inv; const double kk = rint(ang * 0.15915494309189535); const double rr = ang - kk * 6.283185307179586;
        float c, s; sincos_d(rr, c, s);
        *(f32x2*)(rope + (size_t)i * 2) = (f32x2){c, s};
    }
    prep_rows(p);
}

#define TR_READ2(r0, r1, base, OFF0, OFF1) asm volatile("ds_read_b64_tr_b16 %0, %2 offset:%3\n\tds_read_b64_tr_b16 %1, %2 offset:%4" : "=&v"(r0), "=&v"(r1) : "v"(base), "i"(OFF0), "i"(OFF1) : "memory")
#define MFMA16(a, b, c) __builtin_amdgcn_mfma_f32_16x16x32_bf16((a), (b), (c), 0, 0, 0)
__device__ __forceinline__ bf16x8 cat4(s16x4 a, s16x4 b) { return __builtin_shufflevector(a, b, 0, 1, 2, 3, 4, 5, 6, 7); }

__device__ __forceinline__ void retention_prompt(const Params& p, unsigned char* shm, int item) {
    const int b = item >> 5, h = (item >> 3) & 3, dvb = item & 7;
    const int tid = TIDX, w = __builtin_amdgcn_readfirstlane(tid >> 6), lane = tid & 63, fr = lane & 15, fq = lane >> 4, tq = (lane & 15) >> 2, tp = lane & 3;
    const bf16_t* PROJ = (const bf16_t*)(p.ws + WS_PROJ); bf16_t* O = (bf16_t*)(p.ws + WS_O); f32x2* STATS = (f32x2*)(p.ws + WS_STATS);
    constexpr int KRS = 528, VRS = 160  , OFF_V = 128 * KRS, OFF_VS = OFF_V + 128 * VRS, OFF_ST = OFF_VS + 128 * VRS;
    unsigned char* Kl = shm; unsigned char* Vl = shm + OFF_V; unsigned char* Vs = shm + OFF_VS; unsigned char* Stl = shm + OFF_ST;
    const unsigned lbase = (unsigned)(size_t)shm;
    const float lg2 = h == 0 ? -0.04580368961312479f : (h == 1 ? -0.02272007650008353f : (h == 2 ? -0.011315313227834146f : -0.005646563141142063f));
    const float g128 = __builtin_amdgcn_exp2f(lg2 * 128.0f);
    f32x4 sacc[2][4];
#pragma unroll
    for (int j = 0; j < 2; ++j)
#pragma unroll
        for (int eb = 0; eb < 4; ++eb) sacc[j][eb] = (f32x4){0.f, 0.f, 0.f, 0.f};
    const int nloc = 16 * w + fr;
    const unsigned trV_in = lbase + OFF_V + (4 * fq + tq) * VRS + 8 * tp, trV_up = lbase + OFF_VS + (4 * fq + tq) * VRS + 8 * tp, trK_up = lbase + (4 * fq + tq) * KRS + 64 * w + 8 * tp;
    const unsigned koff = (unsigned)((tid >> 5) * RIN + (tid & 31) * 8) * 2u, voff = (unsigned)((tid >> 3) * RIN + (tid & 7) * 8) * 2u, qoff = (unsigned)(nloc * RIN + fq * 8) * 2u;
    u32x4 kpre[8], vpre[2]; bf16x8 qf[8];
    {
        const char* base = (const char*)(PROJ + (size_t)NPR * RIN);
#pragma unroll
        for (int i = 0; i < 8; ++i) kpre[i] = *(const u32x4*)(base + (size_t)(1024 + h * 256 + i * 16 * RIN) * 2 + koff);
#pragma unroll
        for (int i = 0; i < 2; ++i) vpre[i] = *(const u32x4*)(base + (size_t)(2048 + h * 512 + dvb * 64 + i * 64 * RIN) * 2 + voff);
#pragma unroll
        for (int ks = 0; ks < 8; ++ks) qf[ks] = *(const bf16x8*)(base + (size_t)(h * 256 + ks * 32) * 2 + qoff);
    }
    for (int c = -1; c < 16; ++c) {
        float lg2c = lg2; asm volatile("" : "+v"(lg2c));
        const int rowbase = c < 0 ? NPR : b * 2048 + c * 128;
        const char* nbase = (const char*)(PROJ + (size_t)(b * 2048 + (c + 1) * 128) * RIN);
        __syncthreads();
#pragma unroll
        for (int i = 0; i < 8; ++i) { const int ch = tid + 512 * i, r = ch >> 5, cc = ch & 31; *(u32x4*)(Kl + r * KRS + cc * 16) = kpre[i]; }
#pragma unroll
        for (int i = 0; i < 2; ++i) { const int ch = tid + 512 * i, r = ch >> 3, cc = ch & 7;
            *(u32x4*)(Vl + r * VRS + cc * 16) = vpre[i];
            const float kd = __builtin_amdgcn_exp2f(lg2c * (float)(127 - r));
            float f[8]; unpack8(vpre[i], f);
#pragma unroll
            for (int k = 0; k < 8; ++k) f[k] *= kd;
            *(u32x4*)(Vs + r * VRS + cc * 16) = pack8(f); }
#pragma unroll
        for (int j = 0; j < 2; ++j)
#pragma unroll
            for (int eb = 0; eb < 4; ++eb) { u32x2 wv; wv.x = pk2(sacc[j][eb].x, sacc[j][eb].y); wv.y = pk2(sacc[j][eb].z, sacc[j][eb].w);
                *(u32x2*)(Stl + (16 * eb + fr) * KRS + (16 * (2 * w + j) + 4 * fq) * 2) = wv; }
        if (c < 15) {
#pragma unroll
            for (int i = 0; i < 8; ++i) kpre[i] = *(const u32x4*)(nbase + (size_t)(1024 + h * 256 + i * 16 * RIN) * 2 + koff);
#pragma unroll
            for (int i = 0; i < 2; ++i) vpre[i] = *(const u32x4*)(nbase + (size_t)(2048 + h * 512 + dvb * 64 + i * 64 * RIN) * 2 + voff);
        }
        __syncthreads();
        f32x4 oacc[4];
#pragma unroll
        for (int eb = 0; eb < 4; ++eb) {
            oacc[eb] = (f32x4){0.f, 0.f, 0.f, 0.f};
            if (c >= 0) {
#pragma unroll
            for (int ks = 0; ks < 8; ++ks) { const bf16x8 sf = *(const bf16x8*)(Stl + (16 * eb + fr) * KRS + (ks * 32 + fq * 8) * 2); oacc[eb] = MFMA16(sf, qf[ks], oacc[eb]); }
            }
        }
        const float cd = __builtin_amdgcn_exp2f(lg2c * (float)(nloc + 1));
#pragma unroll
        for (int eb = 0; eb < 4; ++eb) oacc[eb] = oacc[eb] * cd;
        __builtin_amdgcn_sched_barrier(0);
#pragma unroll
        for (int s = 0; s < 4; ++s) {
            if (2 * s <= w && (c >= 0 || s == 3)) {
                f32x4 p0 = (f32x4){0.f, 0.f, 0.f, 0.f}, p1 = (f32x4){0.f, 0.f, 0.f, 0.f};
#pragma unroll
                for (int ks = 0; ks < 8; ++ks) {
                    const bf16x8 k0 = *(const bf16x8*)(Kl + (32 * s + fr) * KRS + (ks * 32 + fq * 8) * 2), k1 = *(const bf16x8*)(Kl + (32 * s + 16 + fr) * KRS + (ks * 32 + fq * 8) * 2);
                    p0 = MFMA16(k0, qf[ks], p0); p1 = MFMA16(k1, qf[ks], p1);
                }
                float v[8];
#pragma unroll
                for (int t = 0; t < 4; ++t) { const int d0 = nloc - (32 * s + 4 * fq + t), d1 = d0 - 16;
                    v[t] = d0 >= 0 ? p0[t] * __builtin_amdgcn_exp2f(lg2c * (float)d0) : 0.f;
                    v[4 + t] = d1 >= 0 ? p1[t] * __builtin_amdgcn_exp2f(lg2c * (float)d1) : 0.f; }
                const u32x4 wv = pack8(v); const bf16x8 pf = __builtin_bit_cast(bf16x8, wv);
                s16x4 r[4][2];
#pragma unroll
                for (int eb = 0; eb < 4; ++eb) {
                    TR_READ2(r[eb][0], r[eb][1], trV_in, 32 * s * VRS + 32 * eb, (32 * s + 16) * VRS + 32 * eb);
                }
                asm volatile("s_waitcnt lgkmcnt(0)" : "+v"(r[0][0]), "+v"(r[0][1]), "+v"(r[1][0]), "+v"(r[1][1]), "+v"(r[2][0]), "+v"(r[2][1]), "+v"(r[3][0]), "+v"(r[3][1]) :: "memory");
#pragma unroll
                for (int eb = 0; eb < 4; ++eb) oacc[eb] = MFMA16(cat4(r[eb][0], r[eb][1]), pf, oacc[eb]);
            }
            __builtin_amdgcn_sched_barrier(0);
        }
        asm volatile("" ::: "memory");
        if (c < 15) {
#pragma unroll
            for (int ks = 0; ks < 8; ++ks) qf[ks] = *(const bf16x8*)(nbase + (size_t)(h * 256 + ks * 32) * 2 + qoff);
        }
        if (c >= 0 || b == 0) {
            float s1 = 0.f, s2 = 0.f;
#pragma unroll
            for (int eb = 0; eb < 4; ++eb) {
                const f32x4 o = oacc[eb];
                s1 += (o.x + o.y) + (o.z + o.w); s2 += (o.x * o.x + o.y * o.y) + (o.z * o.z + o.w * o.w);
                u32x2 wv; wv.x = pk2(o.x, o.y); wv.y = pk2(o.z, o.w);
                *(u32x2*)(O + (size_t)(rowbase + nloc) * VD + h * 512 + dvb * 64 + 16 * eb + 4 * fq) = wv;
            }
            s1 += __shfl_xor(s1, 16); s1 += __shfl_xor(s1, 32); s2 += __shfl_xor(s2, 16); s2 += __shfl_xor(s2, 32);
            if (fq == 0) STATS[((size_t)(rowbase + nloc) * 4 + h) * 8 + dvb] = (f32x2){s1, s2};
        }
#pragma unroll
        for (int j = 0; j < 2; ++j)
#pragma unroll
            for (int eb = 0; eb < 4; ++eb) sacc[j][eb] = sacc[j][eb] * g128;
        {
            s16x4 kr[2][2][2], vr[2][4][2];
#define UPD_ISSUE(bf, s_) do { _Pragma("unroll") for (int j = 0; j < 2; ++j) TR_READ2(kr[bf][j][0], kr[bf][j][1], trK_up, 32 * (s_) * KRS + 32 * j, (32 * (s_) + 16) * KRS + 32 * j); \
                               _Pragma("unroll") for (int eb = 0; eb < 4; ++eb) TR_READ2(vr[bf][eb][0], vr[bf][eb][1], trV_up, 32 * (s_) * VRS + 32 * eb, (32 * (s_) + 16) * VRS + 32 * eb); } while (0)
            UPD_ISSUE(0, 0);
#pragma unroll
            for (int s = 0; s < 4; ++s) {
                const int cb_ = s & 1;
                asm volatile("s_waitcnt lgkmcnt(0)" : "+v"(kr[cb_][0][0]), "+v"(kr[cb_][0][1]), "+v"(kr[cb_][1][0]), "+v"(kr[cb_][1][1]), "+v"(vr[cb_][0][0]), "+v"(vr[cb_][0][1]), "+v"(vr[cb_][1][0]), "+v"(vr[cb_][1][1]), "+v"(vr[cb_][2][0]), "+v"(vr[cb_][2][1]), "+v"(vr[cb_][3][0]), "+v"(vr[cb_][3][1]) :: "memory");
                if (s < 3) UPD_ISSUE(cb_ ^ 1, s + 1);
#pragma unroll
                for (int j = 0; j < 2; ++j)
#pragma unroll
                    for (int eb = 0; eb < 4; ++eb) sacc[j][eb] = MFMA16(cat4(kr[cb_][j][0], kr[cb_][j][1]), cat4(vr[cb_][eb][0], vr[cb_][eb][1]), sacc[j][eb]);
                __builtin_amdgcn_sched_barrier(0);
            }
#undef UPD_ISSUE
        }
    }
    float* RP = p.out + OUT_RETP + (size_t)(b * 4 + h) * 256 * 512;
#pragma unroll
    for (int j = 0; j < 2; ++j)
#pragma unroll
        for (int eb = 0; eb < 4; ++eb) {
            const int d0 = 16 * (2 * w + j) + 4 * fq, e = dvb * 64 + 16 * eb + fr;
            RP[(size_t)(d0 + 0) * 512 + e] = sacc[j][eb].x; RP[(size_t)(d0 + 1) * 512 + e] = sacc[j][eb].y; RP[(size_t)(d0 + 2) * 512 + e] = sacc[j][eb].z; RP[(size_t)(d0 + 3) * 512 + e] = sacc[j][eb].w;
        }
}
__device__ __forceinline__ void retention_sample(const Params& p, unsigned char* shm, int item) {
    const int b = item >> 2, h = item & 3, row = SAMP0 + b, tid = TIDX, lane = tid & 63, w = tid >> 6;
    const bf16_t* PROJ = (const bf16_t*)(p.ws + WS_PROJ); bf16_t* O = (bf16_t*)(p.ws + WS_O); f32x2* STATS = (f32x2*)(p.ws + WS_STATS);
    float* qs = (float*)shm; float* ks = qs + 256; float* red = ks + 256; float* opart = red + 32;
    const float gamma = 1.0f - (h == 0 ? 0.03125f : (h == 1 ? 0.015625f : (h == 2 ? 0.0078125f : 0.00390625f)));
    const bf16_t* prow = PROJ + (size_t)row * RIN;
    __syncthreads();
    if (tid < 256) {
        const float q = __uint_as_float((unsigned)prow[h * 256 + tid] << 16), k = __uint_as_float((unsigned)prow[1024 + h * 256 + tid] << 16);
        qs[tid] = q; ks[tid] = k;
        const float pr = wave_sum(q * k);
        if (lane == 0) red[w] = pr;
    }
    __syncthreads();
    const float qk = (red[0] + red[1]) + (red[2] + red[3]);
    const int e4 = (tid & 127) * 4, dsub = tid >> 7;
    const u32x2 vw = *(const u32x2*)(prow + 2048 + h * 512 + e4);
    const f32x4 v4 = (f32x4){bflo(vw.x), bfhi(vw.x), bflo(vw.y), bfhi(vw.y)};
    const float* Sp = p.in[I_SRET] + (size_t)(b * 4 + h) * 256 * 512 + e4;
    float* Sn = p.out + OUT_RETS + (size_t)(b * 4 + h) * 256 * 512 + e4;
    f32x4 oa = (f32x4){0.f, 0.f, 0.f, 0.f};
    f32x4 cur[16], nxt[16];
#pragma unroll
    for (int j = 0; j < 16; ++j) cur[j] = __builtin_nontemporal_load((const f32x4*)(Sp + (size_t)(dsub + 4 * j) * 512));
#pragma unroll
    for (int bt = 0; bt < 4; ++bt) {
        if (bt < 3) {
#pragma unroll
            for (int j = 0; j < 16; ++j) nxt[j] = __builtin_nontemporal_load((const f32x4*)(Sp + (size_t)(dsub + 4 * (16 * (bt + 1) + j)) * 512));
        }
#pragma unroll
        for (int j = 0; j < 16; ++j) {
            const int d = dsub + 4 * (16 * bt + j);
            const float qd = qs[d], kd = ks[d];
            oa = oa + cur[j] * qd;
            const f32x4 sn = cur[j] * gamma + v4 * kd;
            __builtin_nontemporal_store(sn, (f32x4*)(Sn + (size_t)d * 512));
        }
#pragma unroll
        for (int j = 0; j < 16; ++j) cur[j] = nxt[j];
    }
    *(f32x4*)(opart + dsub * 512 + e4) = oa;
    __syncthreads();
    const float ve = __uint_as_float((unsigned)prow[2048 + h * 512 + tid] << 16);
    const float o = gamma * ((opart[tid] + opart[512 + tid]) + (opart[1024 + tid] + opart[1536 + tid])) + qk * ve;
    O[(size_t)row * VD + h * 512 + tid] = (bf16_t)(pk2(o, 0.f) & 0xffffu);
    const float s1 = wave_sum(o), s2 = wave_sum(o * o);
    if (lane == 0) { red[8 + w] = s1; red[16 + w] = s2; }
    __syncthreads();
    if (tid < 8) {
        float a = 0.f, c = 0.f;
        if (tid == 0) {
#pragma unroll
            for (int i = 0; i < 8; ++i) { a += red[8 + i]; c += red[16 + i]; }
        }
        STATS[((size_t)row * 4 + h) * 8 + tid] = (f32x2){a, c};
    }
}
__device__ __forceinline__ void phase_retention(const Params& p, unsigned char* shm) {
    const bool stream_first = ((blockIdx.x >> 3) & 1) != 0;
    if (stream_first) { for (int item = blockIdx.x; item < 512; item += gridDim.x) retention_sample(p, shm, item); }
    __syncthreads();
    for (int item = blockIdx.x; item < 256; item += gridDim.x) retention_prompt(p, shm, item);
    __syncthreads();
    if (!stream_first) { for (int item = blockIdx.x; item < 512; item += gridDim.x) retention_sample(p, shm, item); }
}
__device__ __forceinline__ void phase_gatenorm(const Params& p) {
    const bf16_t* PROJ = (const bf16_t*)(p.ws + WS_PROJ); const bf16_t* O = (const bf16_t*)(p.ws + WS_O); const float* STATS = (const float*)(p.ws + WS_STATS); bf16_t* Y = (bf16_t*)(p.ws + WS_Y0);
    const int lane = TIDX & 63, gw = blockIdx.x * 8 + (TIDX >> 6), NW = gridDim.x * 8;
    for (int it0 = gw * 4; it0 < MROWS * 4; it0 += NW * 4) {
        u32x4 ow[4], gwv[4]; f32x4 sa[4], sb[4], sc[4], sd[4];
#pragma unroll
        for (int q = 0; q < 4; ++q) { const int it = it0 + q, row = it >> 2, h = it & 3; const float* st = STATS + (size_t)it * 16;
            sa[q] = *(const f32x4*)st; sb[q] = *(const f32x4*)(st + 4); sc[q] = *(const f32x4*)(st + 8); sd[q] = *(const f32x4*)(st + 12);
            ow[q] = *(const u32x4*)(O + (size_t)row * VD + h * 512 + lane * 8); gwv[q] = *(const u32x4*)(PROJ + (size_t)row * RIN + 4096 + h * 512 + lane * 8); }
#pragma unroll
        for (int q = 0; q < 4; ++q) { const int it = it0 + q, row = it >> 2, h = it & 3;
            const float s1 = (sa[q].x + sa[q].z) + (sb[q].x + sb[q].z) + (sc[q].x + sc[q].z) + (sd[q].x + sd[q].z), s2 = (sa[q].y + sa[q].w) + (sb[q].y + sb[q].w) + (sc[q].y + sc[q].w) + (sd[q].y + sd[q].w);
            const float mu = s1 * (1.0f / 512.0f); float var = s2 * (1.0f / 512.0f) - mu * mu; var = var > 0.f ? var : 0.f;
            const float rstd = 1.0f / sqrtf(var + 1e-6f);
            float of[8], gf[8], y[8]; unpack8(ow[q], of); unpack8(gwv[q], gf);
#pragma unroll
            for (int k = 0; k < 8; ++k) y[k] = silu_f(gf[k]) * ((of[k] - mu) * rstd);
            *(u32x4*)(Y + (size_t)row * VD + h * 512 + lane * 8) = pack8(y); }
    }
}
__device__ __forceinline__ void prev_rows(int row, int& p1, int& p2) {
    if (row < NPR) { const int t = row & 2047; p1 = t >= 1 ? row - 1 : SAMP0 - 1; p2 = t >= 2 ? row - 2 : (t == 1 ? SAMP0 - 1 : SAMP0 - 2); }
    else { p1 = row - 1; p2 = row - 2; }
}
__device__ __forceinline__ void seg_rows(int seg, int& r0, int& h1, int& h2) {
    if (seg < 2048) { r0 = seg * 8; if ((r0 & 2047) == 0) { h1 = SAMP0 - 1; h2 = SAMP0 - 2; } else { h1 = r0 - 1; h2 = r0 - 2; } }
    else { r0 = META0 + (seg - 2048) * 8; if (seg == 2048) { h1 = -1; h2 = -1; } else { h1 = r0 - 1; h2 = r0 - 2; } }
}
constexpr int NSEG = 2050;
__device__ __forceinline__ void phase_scconv(const Params& p) {
    const bf16_t* SC = (const bf16_t*)(p.ws + WS_PROJ); bf16_t* Y = (bf16_t*)(p.ws + WS_Y0);
    const float* cw = p.in[I_WSC]; const float* sin_ = p.in[I_SCONV];
    float* outp = p.out + OUT_CONVP; float* outs = p.out + OUT_CONVS;
    constexpr int CG = DM / 8, LD = 2 * DM;
    const int total = (NSEG + 128) * CG;
    for (int idx = blockIdx.x * 512 + TIDX; idx < total; idx += gridDim.x * 512) {
        const int seg = idx / CG, c = (idx - seg * CG) * 8;
        float w0[8], w1[8], w2[8], u1[8], u2[8];
        load8f(cw + c, w0); load8f(cw + DM + c, w1); load8f(cw + 2 * DM + c, w2);
        if (seg >= NSEG) {
            const int b = seg - NSEG, row = SAMP0 + b; float u0[8], bg[8], y[8];
            unpack8(*(const u32x4*)(SC + (size_t)row * LD + c), bg); unpack8(*(const u32x4*)(SC + (size_t)row * LD + DM + c), u0);
            load8f(sin_ + ((size_t)b * 2 + 1) * DM + c, u1); load8f(sin_ + ((size_t)b * 2 + 0) * DM + c, u2);
            store8f(outs + ((size_t)b * 2 + 0) * DM + c, u1); store8f(outs + ((size_t)b * 2 + 1) * DM + c, u0);
#pragma unroll
            for (int k = 0; k < 8; ++k) y[k] = bg[k] * (w0[k] * u2[k] + w1[k] * u1[k] + w2[k] * u0[k]);
            *(u32x4*)(Y + (size_t)row * DM + c) = pack8(y);
            continue;
        }
        int r0, h1, h2; seg_rows(seg, r0, h1, h2);
        u32x4 bw[8], uw[8];
#pragma unroll
        for (int i = 0; i < 8; ++i) { bw[i] = *(const u32x4*)(SC + (size_t)(r0 + i) * LD + c); uw[i] = *(const u32x4*)(SC + (size_t)(r0 + i) * LD + DM + c); }
        if (h1 >= 0) { unpack8(*(const u32x4*)(SC + (size_t)h1 * LD + DM + c), u1); unpack8(*(const u32x4*)(SC + (size_t)h2 * LD + DM + c), u2); }
        else {
#pragma unroll
            for (int k = 0; k < 8; ++k) { u1[k] = 0.f; u2[k] = 0.f; } }
#pragma unroll
        for (int i = 0; i < 8; ++i) {
            float u0[8], bg[8], y[8]; unpack8(bw[i], bg); unpack8(uw[i], u0);
#pragma unroll
            for (int k = 0; k < 8; ++k) { y[k] = bg[k] * (w0[k] * u2[k] + w1[k] * u1[k] + w2[k] * u0[k]); u2[k] = u1[k]; u1[k] = u0[k]; }
            *(u32x4*)(Y + (size_t)(r0 + i) * DM + c) = pack8(y);
            if (i >= 6 && seg < 2048 && (seg & 255) == 255) store8f(outp + ((size_t)(seg >> 8) * 2 + (i - 6)) * DM + c, u0);
        }
    }
}

constexpr int NPH = 15;
__global__ __launch_bounds__(512, 2) void fwd_megakernel(Params p) {
    extern __shared__ __attribute__((aligned(16))) unsigned char shm[];
    LAS unsigned char* lds = (LAS unsigned char*)shm;
    cg::grid_group grid = cg::this_grid();
    const bf16_t* H = (const bf16_t*)(p.ws + WS_H); const bf16_t* Y = (const bf16_t*)(p.ws + WS_Y);
    bf16_t* PROJ = (bf16_t*)(p.ws + WS_PROJ);
#define PH_BEGIN(k) if (p.ph_lo <= (k) && (k) < p.ph_hi) {
#define PH_END(k) if ((k) + 1 < p.ph_hi) xcd_barrier(xb); }
    float* SS = (float*)(p.ws + WS_SS); bf16_t* Hw = (bf16_t*)(p.ws + WS_H);
    volatile LAS unsigned* xst = (volatile LAS unsigned*)(lds + LDS_BYTES - 16);
    if (TIDX == 0) { xst[0] = 0u; xst[1] = 0u; }
    __syncthreads();
    const XcdBarrier xb = xcd_barrier_post((unsigned*)(p.ws + WS_BAR), xst);
    if (p.ph_hi < 0) grid.sync();
    unsigned* HC = (unsigned*)(p.ws + WS_BAR) + 3520;
    const bf16_t* Y0 = (const bf16_t*)(p.ws + WS_Y0);
#define PH_NOBAR(k) }
    PH_BEGIN(0) phase_prep(p, shm); PH_END(0)
    PH_BEGIN(1) { EpiRetIn E{PROJ, (const float*)(p.ws + WS_ROPE), (const float*)(shm + pg8::STAGE_BYTES)}; run_gemm(lds, SS, H, (const bf16_t*)(p.ws + WS_WRI), RIN, DM, E);
                  transpose_set<1>(p, shm, 24); transpose_set<2>(p, shm, 24); transpose_set<3>(p, shm, 24); } PH_END(1)
    PH_BEGIN(2) phase_retention(p, shm); PH_END(2)
    PH_BEGIN(3) phase_gatenorm(p); PH_END(3)
    PH_BEGIN(4) run_resid_gemm(p, -1, lds, Y0, (const bf16_t*)(p.ws + WS_WRO), VD, Hw, SS + (size_t)MROWS * 16, HC, HC + 64); PH_NOBAR(4)
    PH_BEGIN(5) { EpiFfn E{(bf16_t*)(p.ws + WS_Y), (const float*)(shm + pg8::STAGE_BYTES), (float*)(p.ws + WS_O), p.in[I_WFC], p.in[I_BFC], p.in[I_SFFN], p.out + OUT_FFNS}; run_gemm_tail(lds, SS + (size_t)MROWS * 16, HC + 64, H, (const bf16_t*)(p.ws + WS_WFI), 2 * DFF, DM, E); } PH_END(5)
    PH_BEGIN(7) run_resid_gemm(p, 0, lds, Y, (const bf16_t*)(p.ws + WS_WFO), DFF, Hw, SS + (size_t)2 * MROWS * 16, HC + 128, HC + 192); PH_NOBAR(7)
    PH_BEGIN(8) { EpiSc E{PROJ, (const float*)(shm + pg8::STAGE_BYTES)}; run_gemm_tail(lds, SS + (size_t)2 * MROWS * 16, HC + 192, H, (const bf16_t*)(p.ws + WS_WSI), 3 * DM, DM, E); } PH_END(8)
    PH_BEGIN(9) phase_scconv(p); PH_END(9)
    PH_BEGIN(10) run_resid_gemm(p, -1, lds, Y0, (const bf16_t*)(p.ws + WS_WSO), DM, Hw, SS + (size_t)3 * MROWS * 16, HC + 256, HC + 320); PH_NOBAR(10)
    PH_BEGIN(11) { EpiFfn E{(bf16_t*)(p.ws + WS_Y), (const float*)(shm + pg8::STAGE_BYTES), (float*)(p.ws + WS_O), p.in[I_WFC] + 3 * DFF, p.in[I_BFC] + DFF, p.in[I_SFFN] + (size_t)128 * 2 * DFF, p.out + OUT_FFNS + (size_t)128 * 2 * DFF}; run_gemm_tail(lds, SS + (size_t)3 * MROWS * 16, HC + 320, H, (const bf16_t*)(p.ws + WS_WFI) + (size_t)2 * DFF * DM, 2 * DFF, DM, E); } PH_END(11)
    PH_BEGIN(13) run_resid_gemm(p, 1, lds, Y, (const bf16_t*)(p.ws + WS_WFO) + (size_t)DM * DFF, DFF, Hw, SS + (size_t)4 * MROWS * 16, HC + 384, HC + 448); PH_NOBAR(13)
    PH_BEGIN(14) phase_final(p, HC + 448); PH_END(14)
}

extern "C" void kernel_launch(void* const* d_in, const int* in_sizes, int n_in, void* d_out, int out_size, void* d_ws, size_t ws_size, hipStream_t stream) {
    static int grid = 0;
    if (grid == 0) {
        if (n_in != 18 || ws_size < WS_END) { fprintf(stderr, "kernel_launch: unexpected n_in %d or ws_size %zu (< %zu)\n", n_in, ws_size, (size_t)WS_END); grid = -1; return; }
        int dev = 0, cus = 0, per_cu = 0;
        hipGetDevice(&dev); hipDeviceGetAttribute(&cus, hipDeviceAttributeMultiprocessorCount, dev);
        if (hipFuncSetAttribute((const void*)fwd_megakernel, hipFuncAttributeMaxDynamicSharedMemorySize, LDS_BYTES) != hipSuccess) fprintf(stderr, "kernel_launch: hipFuncSetAttribute failed\n");
        if (hipOccupancyMaxActiveBlocksPerMultiprocessor(&per_cu, (const void*)fwd_megakernel, 512, LDS_BYTES) != hipSuccess || per_cu < 1) { fprintf(stderr, "kernel_launch: occupancy query gave %d\n", per_cu); per_cu = 1; }
        (void)hipGetLastError();
        if (cus != 256) fprintf(stderr, "kernel_launch: note: %d CUs reported; the phase schedule is built for 256 workgroups (one per CU)\n", cus);
        grid = 256;
    }
    if (grid < 0) return;
    if (hipMemsetAsync((char*)d_ws + WS_BAR, 0, 16384, stream) != hipSuccess) fprintf(stderr, "kernel_launch: memset of barrier words failed\n");
    Params p{};
    for (int i = 0; i < 18; ++i) p.in[i] = (const float*)d_in[i];
    p.out = (float*)d_out; p.ws = (unsigned char*)d_ws; p.ph_lo = 0; p.ph_hi = NPH;
#if defined(MK_MULTI)
    for (int ph = 0; ph < NPH; ++ph) { p.ph_lo = ph; p.ph_hi = ph + 1; hipLaunchKernelGGL(fwd_megakernel, dim3(grid), dim3(512), LDS_BYTES, stream, p); }
#else
    void* args[] = {&p};
    hipError_t e = hipLaunchCooperativeKernel((const void*)fwd_megakernel, dim3(grid), dim3(512), args, LDS_BYTES, stream);
    if (e != hipSuccess) fprintf(stderr, "cooperative launch failed: %s (grid %d)\n", hipGetErrorString(e), grid);
#endif
}
```
